# Optimizing an MI355X kernel written in HIP

```python
import math
import jax, jax.numpy as jnp
from jax import lax
import numpy as np

D_MODEL = 2048
BATCH = 2
SEQ = 8192
DEPTH = 1

HEAD_DIM = 64
A_Q_HEADS = 16
A_KV_HEADS = 4
A_GROUP = A_Q_HEADS // A_KV_HEADS
A_WINDOW = 128
A_WIDTH = A_Q_HEADS * HEAD_DIM
A_KV_WIDTH = A_KV_HEADS * HEAD_DIM
B_HEADS = 12
B_WIDTH = B_HEADS * HEAD_DIM
B_PATTERNS = ((128, 1), (512, 4), (2048, 16))
BLOCK = 128
IN_SPLITS = (A_WIDTH, A_WIDTH + A_KV_WIDTH, A_WIDTH + 2 * A_KV_WIDTH,
             A_WIDTH + 2 * A_KV_WIDTH + B_WIDTH, A_WIDTH + 2 * A_KV_WIDTH + 2 * B_WIDTH)
IN_COLS = A_WIDTH + 2 * A_KV_WIDTH + 3 * B_WIDTH
N_REL_HEADS = A_Q_HEADS + B_HEADS
REL_BUCKETS = 32
REL_MAX_DIST = 2048
X_HEADS = 4
X_HEAD_DIM = 128
X_WIDTH = X_HEADS * X_HEAD_DIM
MEM_LEN = 256
N_GROUPS = 4
EXP_PER_GROUP = 8
N_EXPERTS = N_GROUPS * EXP_PER_GROUP
TOP_K = 2
D_FF_EXPERT = 512
MOE_BLOCK = 128
EPS = 1e-6
NEG = -1e30

kernel_name = "hybrid_gated_swa_dilated_hmoe"


def rmsnorm(x, g):
    xf = x.astype(jnp.float32)
    y = xf * lax.rsqrt(jnp.mean(xf * xf, axis=-1, keepdims=True) + EPS)
    return (y * g.astype(jnp.float32)).astype(x.dtype)


def t5_bucket(dist):
    max_exact = REL_BUCKETS // 2
    d = jnp.maximum(dist, 0)
    df = jnp.maximum(d, 1).astype(jnp.float32)
    large = max_exact + (jnp.log(df / max_exact) / math.log(REL_MAX_DIST / max_exact)
                         * (REL_BUCKETS - max_exact)).astype(jnp.int32)
    large = jnp.minimum(large, REL_BUCKETS - 1)
    return jnp.where(d < max_exact, d, large)


def banded_attention(q, k, v, bias_table, max_off, step, sinks=None):
    bt, n, hk, g, dh = q.shape
    nb = n // BLOCK
    qb = q.reshape(bt, nb, BLOCK, hk, g, dh)
    pad = ((0, 0), (BLOCK, 0), (0, 0), (0, 0))
    kb = jnp.pad(k, pad).reshape(bt, nb + 1, BLOCK, hk, dh)
    vb = jnp.pad(v, pad).reshape(bt, nb + 1, BLOCK, hk, dh)
    kk = jnp.concatenate([kb[:, :-1], kb[:, 1:]], axis=2)
    vv = jnp.concatenate([vb[:, :-1], vb[:, 1:]], axis=2)
    qi = jnp.arange(BLOCK)[:, None]
    ki = jnp.arange(2 * BLOCK)[None, :]
    dist = qi + BLOCK - ki
    bias = bias_table[t5_bucket(dist * step)]
    bias = jnp.transpose(bias, (2, 3, 0, 1)).astype(jnp.float32)
    key_abs = jnp.arange(nb)[:, None] * BLOCK + ki - BLOCK
    mask = ((dist >= 0) & (dist <= max_off))[None] & (key_abs >= 0)[:, None, :]
    s = jnp.einsum('bnqhgd,bnkhd->bnhgqk', qb, kk).astype(jnp.float32) + bias
    s = jnp.where(mask[None, :, None, None], s, NEG)
    m = jnp.max(s, axis=-1, keepdims=True)
    if sinks is not None:
        sk = sinks.astype(jnp.float32)[None, None, :, :, None, None]
        m = jnp.maximum(m, sk)
    p = jnp.exp(s - m)
    l = jnp.sum(p, axis=-1, keepdims=True)
    if sinks is not None:
        l = l + jnp.exp(sk - m)
    o = jnp.einsum('bnhgqk,bnkhd->bnqhgd', (p / l).astype(v.dtype), vv)
    lse = jnp.transpose((m + jnp.log(l))[..., 0], (0, 1, 4, 2, 3))
    return o.reshape(bt, n, hk, g, dh), lse.reshape(bt, n, hk, g)


def dilated_attention(q, k, v, bias_table):
    b, s, h, dh = q.shape
    outs, lses = [], []
    for w, r in B_PATTERNS:
        span = r * BLOCK
        s_pad = -(-s // span) * span
        n = s_pad // r

        def to_sub(t):
            t = jnp.pad(t, ((0, 0), (0, s_pad - s), (0, 0), (0, 0))).reshape(b, n, r, h, dh)
            return jnp.transpose(t, (0, 2, 1, 3, 4)).reshape(b * r, n, h, dh)

        qs, ks, vs = to_sub(q), to_sub(k), to_sub(v)
        o, lse = banded_attention(qs[:, :, :, None], ks, vs, bias_table[:, :, None], w // r, r)
        o = jnp.transpose(o.reshape(b, r, n, h, dh), (0, 2, 1, 3, 4)).reshape(b, s_pad, h, dh)[:, :s]
        lse = jnp.transpose(lse.reshape(b, r, n, h), (0, 2, 1, 3)).reshape(b, s_pad, h)[:, :s]
        outs.append(o)
        lses.append(lse)
    wts = jax.nn.softmax(jnp.stack(lses, axis=0), axis=0)
    o = jnp.sum(wts[..., None] * jnp.stack(outs, axis=0).astype(jnp.float32), axis=0)
    return o.astype(q.dtype)


def cross_attention(h, mem_n, w_xq, w_xk, w_xv, w_xo):
    b, s, _ = h.shape
    ml = mem_n.shape[1]
    q = (h @ w_xq).reshape(b, s, X_HEADS, X_HEAD_DIM) * (X_HEAD_DIM ** -0.5)
    k = (mem_n @ w_xk).reshape(b, ml, X_HEADS, X_HEAD_DIM)
    v = (mem_n @ w_xv).reshape(b, ml, X_HEADS, X_HEAD_DIM)
    p = jax.nn.softmax(jnp.einsum('bshd,bmhd->bhsm', q, k).astype(jnp.float32), axis=-1)
    o = jnp.einsum('bhsm,bmhd->bshd', p.astype(v.dtype), v).reshape(b, s, X_WIDTH)
    return o @ w_xo


def hier_moe(h, w_rg, w_re, w1, w3, w2):
    b, s, d = h.shape
    t = b * s
    hf = h.reshape(t, d)
    g_logits = (hf @ w_rg).astype(jnp.float32)
    g_prob = jax.nn.softmax(g_logits, axis=-1)
    g_gate, g_idx = lax.top_k(g_prob, 1)
    e_logits = (hf @ w_re).astype(jnp.float32).reshape(t, N_GROUPS, EXP_PER_GROUP)
    e_logits = jnp.take_along_axis(e_logits, g_idx[:, :, None], axis=1)[:, 0]
    top_v, top_i = lax.top_k(e_logits, TOP_K)
    gate = jax.nn.softmax(top_v, axis=-1) * g_gate
    expert = g_idx * EXP_PER_GROUP + top_i

    n_assign = t * TOP_K
    e_flat = expert.reshape(-1)
    tok_flat = jnp.broadcast_to(jnp.arange(t, dtype=jnp.int32)[:, None], (t, TOP_K)).reshape(-1)
    w_flat = gate.reshape(-1)
    order = jnp.argsort(e_flat)
    e_sorted = e_flat[order]
    counts = jnp.bincount(e_flat, length=N_EXPERTS)
    padded = (counts + MOE_BLOCK - 1) // MOE_BLOCK * MOE_BLOCK
    start = jnp.cumsum(counts) - counts
    pend = jnp.cumsum(padded)
    pstart = pend - padded
    dest = pstart[e_sorted] + (jnp.arange(n_assign) - start[e_sorted])
    n_rows = -(-(n_assign + N_EXPERTS * (MOE_BLOCK - 1)) // MOE_BLOCK) * MOE_BLOCK
    n_blocks = n_rows // MOE_BLOCK
    row_tok = jnp.full((n_rows,), t, jnp.int32).at[dest].set(tok_flat[order])
    row_w = jnp.zeros((n_rows,), jnp.float32).at[dest].set(w_flat[order])
    block_e = jnp.minimum(jnp.searchsorted(pend, jnp.arange(n_blocks) * MOE_BLOCK, side='right'),
                          N_EXPERTS - 1)
    h_pad = jnp.concatenate([hf, jnp.zeros((1, d), hf.dtype)], axis=0)
    xb = h_pad[row_tok].reshape(n_blocks, MOE_BLOCK, d)

    def expert_block(args):
        xk, e = args
        return (jax.nn.silu(xk @ w1[e]) * (xk @ w3[e])) @ w2[e]

    yb = lax.map(expert_block, (xb, block_e)).reshape(n_rows, d)
    y = jnp.zeros((t + 1, d), jnp.float32).at[row_tok].add(yb.astype(jnp.float32) * row_w[:, None])
    return y[:t].reshape(b, s, d).astype(h.dtype)


def setup_inputs(seed: int = 0) -> dict:
    key = jax.random.key(seed)
    ks = jax.random.split(key, 24)
    f32 = jnp.float32
    L = DEPTH

    def nrm(k, shape, scale):
        return jax.random.normal(k, shape, f32) * scale

    return {
        "x": nrm(ks[0], (BATCH, SEQ, D_MODEL), 1.0),
        "mem": nrm(ks[1], (BATCH, MEM_LEN, D_MODEL), 1.0),
        "rel_bias": nrm(ks[2], (REL_BUCKETS, N_REL_HEADS), 0.5),
        "g_mix": 1.0 + nrm(ks[3], (L, D_MODEL), 0.02),
        "w_in": nrm(ks[4], (L, D_MODEL, IN_COLS), D_MODEL ** -0.5),
        "sinks_a": nrm(ks[5], (L, A_Q_HEADS), 0.5),
        "w_a_out": nrm(ks[6], (L, A_WIDTH, D_MODEL), A_WIDTH ** -0.5),
        "w_b_out": nrm(ks[7], (L, B_WIDTH, D_MODEL), B_WIDTH ** -0.5),
        "w_gate": nrm(ks[8], (L, D_MODEL, 2 * D_MODEL), D_MODEL ** -0.5),
        "b_gate": nrm(ks[9], (L, 2 * D_MODEL), 0.1),
        "w_o": nrm(ks[10], (L, D_MODEL, D_MODEL), D_MODEL ** -0.5),
        "g_x": 1.0 + nrm(ks[11], (L, D_MODEL), 0.02),
        "g_mem": 1.0 + nrm(ks[12], (L, D_MODEL), 0.02),
        "w_xq": nrm(ks[13], (L, D_MODEL, X_WIDTH), D_MODEL ** -0.5),
        "w_xk": nrm(ks[14], (L, D_MODEL, X_WIDTH), D_MODEL ** -0.5),
        "w_xv": nrm(ks[15], (L, D_MODEL, X_WIDTH), D_MODEL ** -0.5),
        "w_xo": nrm(ks[16], (L, X_WIDTH, D_MODEL), X_WIDTH ** -0.5),
        "g_moe": 1.0 + nrm(ks[17], (L, D_MODEL), 0.02),
        "w_rg": nrm(ks[18], (L, D_MODEL, N_GROUPS), D_MODEL ** -0.5),
        "w_re": nrm(ks[19], (L, D_MODEL, N_EXPERTS), D_MODEL ** -0.5),
        "w1": nrm(ks[20], (L, N_EXPERTS, D_MODEL, D_FF_EXPERT), D_MODEL ** -0.5),
        "w3": nrm(ks[21], (L, N_EXPERTS, D_MODEL, D_FF_EXPERT), D_MODEL ** -0.5),
        "w2": nrm(ks[22], (L, N_EXPERTS, D_FF_EXPERT, D_MODEL), D_FF_EXPERT ** -0.5),
        "g_final": 1.0 + nrm(ks[23], (D_MODEL,), 0.02),
    }


def reference(x, mem, rel_bias, g_mix, w_in, sinks_a, w_a_out, w_b_out, w_gate, b_gate, w_o,
              g_x, g_mem, w_xq, w_xk, w_xv, w_xo, g_moe, w_rg, w_re, w1, w3, w2, g_final):
    b, s, d = x.shape
    scale = HEAD_DIM ** -0.5
    bias_a = rel_bias[:, :A_Q_HEADS].reshape(REL_BUCKETS, A_KV_HEADS, A_GROUP)
    bias_b = rel_bias[:, A_Q_HEADS:]
    for l in range(DEPTH):
        h = rmsnorm(x, g_mix[l])
        qa, ka, va, qb, kb, vb = jnp.split(h @ w_in[l], IN_SPLITS, axis=-1)
        qa = qa.reshape(b, s, A_KV_HEADS, A_GROUP, HEAD_DIM) * scale
        ka = ka.reshape(b, s, A_KV_HEADS, HEAD_DIM)
        va = va.reshape(b, s, A_KV_HEADS, HEAD_DIM)
        oa, _ = banded_attention(qa, ka, va, bias_a, A_WINDOW - 1, 1,
                                 sinks=sinks_a[l].reshape(A_KV_HEADS, A_GROUP))
        ya = oa.reshape(b, s, A_WIDTH) @ w_a_out[l]
        ob = dilated_attention(qb.reshape(b, s, B_HEADS, HEAD_DIM) * scale,
                               kb.reshape(b, s, B_HEADS, HEAD_DIM),
                               vb.reshape(b, s, B_HEADS, HEAD_DIM), bias_b)
        yb = ob.reshape(b, s, B_WIDTH) @ w_b_out[l]
        gates = jax.nn.sigmoid((h @ w_gate[l] + b_gate[l]).astype(jnp.float32)).astype(x.dtype)
        ga, gb = gates[..., :D_MODEL], gates[..., D_MODEL:]
        x = x + (ga * ya + gb * yb) @ w_o[l]
        x = x + cross_attention(rmsnorm(x, g_x[l]), rmsnorm(mem, g_mem[l]),
                                w_xq[l], w_xk[l], w_xv[l], w_xo[l])
        x = x + hier_moe(rmsnorm(x, g_moe[l]), w_rg[l], w_re[l], w1[l], w3[l], w2[l])
    return rmsnorm(x, g_final)
```

```cpp
#include <hip/hip_runtime.h>
#include <cstdio>
#include <cstdint>
namespace pg8 {
#define PG8_LAS __attribute__((address_space(3)))
typedef unsigned short bf16_t;
typedef short bf16x8 __attribute__((ext_vector_type(8)));
typedef float f32x4 __attribute__((ext_vector_type(4)));
typedef unsigned u32x4 __attribute__((ext_vector_type(4)));
constexpr int BM = 256, BK = 64, HALF = 128, HTB = HALF * BK * 2  , STAGE_BYTES = 8 * HTB, NXCD = 8, WGM = 8;

__host__ __device__ __forceinline__ int lds_byte(int r, int c) { const int st = (r >> 4) * 2 + (c >> 5), rr = r & 15, cc = c & 31, ob = rr * 64 + cc * 2; return st * 1024 + (ob ^ (((ob >> 9) & 1) << 5)); }
__host__ __device__ __forceinline__ void stage_rc(int b, int& R, int& C) { const int st = b / 1024, sb = b % 1024, swz = sb ^ (((sb >> 9) & 1) << 5); R = (st >> 1) * 16 + swz / 64; C = (st & 1) * 32 + (swz % 64) / 2; }
__host__ __device__ __forceinline__ int perm32(int rho) { const int n = rho >> 4, i = rho & 15; return 8 * (i >> 2) + 4 * n + (i & 3); }

struct Unit { int pm, pn; };
struct Gemm { const bf16_t* A; const bf16_t* Bt; int M, N, K; };

struct StaticOrder {
    int nM, nN, nwg, G, c;
    __host__ __device__ void init(int M, int N, int G_, int c_) { nM = M / BM; nN = N / BM; nwg = nM * nN; G = G_; c = c_; }
    __host__ __device__ bool next(int i, Unit& u) const {
        const long L = (long)i * G + c; if (L >= nwg) return false;
        int wgid = (int)L; { const int q = nwg / NXCD, r = nwg % NXCD, xcd = wgid % NXCD, off = wgid / NXCD; wgid = (xcd < r ? xcd * (q + 1) : r * (q + 1) + (xcd - r) * q) + off; }
        const int nig = WGM * nN, gid = wgid / nig, fm = gid * WGM, gsz = (nM - fm) < WGM ? (nM - fm) : WGM;
        u.pm = fm + ((wgid % nig) % gsz); u.pn = (wgid % nig) / gsz; return true;
    }
    __device__ __forceinline__ void a_ready(const Unit&) const {}
    __device__ __forceinline__ void done(const Unit&) const {}
};

typedef __bf16 bf16x2_t __attribute__((ext_vector_type(2)));
__device__ __forceinline__ unsigned cvt_pk_bf16(float lo, float hi) { bf16x2_t v = {(__bf16)lo, (__bf16)hi}; return __builtin_bit_cast(unsigned, v); }
template <class Epi, class Sched, bool ALIGN_EPI = false, bool SP2 = false>
__device__ __forceinline__ void gemm_phase(PG8_LAS unsigned char* lds, const Gemm g, const Sched& S, const Epi& E) {
    const int tid = threadIdx.x, wid = __builtin_amdgcn_readfirstlane(tid >> 6), lane = tid & 63, wr = wid >> 2, wc = wid & 3, fr = lane & 15, fq = lane >> 4;
    const int K = g.K, nt = K / BK;
    unsigned voffA[2], voffB[2];
#pragma unroll
    for (int i = 0; i < 2; ++i) { int R, C; stage_rc(tid * 16 + i * 8192, R, C); const int Rb = Epi::PERM ? ((R & ~31) + perm32(R & 31)) : R;
        voffA[i] = (unsigned)(R * K + C) * 2u; voffB[i] = (unsigned)(Rb * K + C) * 2u; }
    const size_t kstep = (size_t)(BK * 2);
    const size_t hstep = (size_t)HALF * K * 2;
    const size_t tstep = 2 * hstep;
    const unsigned ldsw = (unsigned)wid * 1024u;
    const int aoff = lds_byte(wr * 64 + fr, fq * 8), boff = lds_byte(wc * 32 + fr, fq * 8);
#define PG8_SA(b, h) (((b) * 2 + (h)) * HTB)
#define PG8_SB(b, h) ((4 + (b) * 2 + (h)) * HTB)
#define PG8_STAGE(bufoff, gbase, voff) do { _Pragma("unroll") for (int _i = 0; _i < 2; ++_i) \
        __builtin_amdgcn_global_load_lds((const unsigned*)((const char*)(gbase) + (voff)[_i]), (PG8_LAS unsigned*)(lds + (bufoff) + ldsw + _i * 8192), 16, 0, 0); } while (0)
#define PG8_LDA(dst, b, h) do { _Pragma("unroll") for (int m = 0; m < 4; ++m) _Pragma("unroll") for (int k = 0; k < 2; ++k) dst[m][k] = *(const PG8_LAS bf16x8*)(lds + PG8_SA(b, h) + aoff + m * 2048 + k * 1024); } while (0)
#define PG8_LDB(dst, b, h) do { _Pragma("unroll") for (int n = 0; n < 2; ++n) _Pragma("unroll") for (int k = 0; k < 2; ++k) dst[n][k] = *(const PG8_LAS bf16x8*)(lds + PG8_SB(b, h) + boff + n * 2048 + k * 1024); } while (0)
#define PG8_MMA(ai, bj, At, Bt) do { __builtin_amdgcn_s_setprio(1); _Pragma("unroll") for (int m = 0; m < 4; ++m) _Pragma("unroll") for (int n = 0; n < 2; ++n) _Pragma("unroll") for (int k = 0; k < 2; ++k) \
        acc[ai][bj][m][n] = __builtin_amdgcn_mfma_f32_16x16x32_bf16(Bt[n][k], At[m][k], acc[ai][bj][m][n], 0, 0, 0); __builtin_amdgcn_s_setprio(0); } while (0)
#define PG8_WAIT_V(n) asm volatile("s_waitcnt vmcnt(" #n ")" ::: "memory")
#define PG8_WAIT_L(n) asm volatile("s_waitcnt lgkmcnt(" #n ")" ::: "memory")
#define PG8_BAR __builtin_amdgcn_s_barrier()
#define PG8_SCHED __builtin_amdgcn_sched_barrier(0)
    Unit cur, nxt; int ui = 0;
    if (!S.next(0, cur)) return;
    f32x4 acc[2][2][4][2];
#pragma unroll
    for (int a = 0; a < 2; ++a)
#pragma unroll
        for (int b = 0; b < 2; ++b)
#pragma unroll
            for (int m = 0; m < 4; ++m)
#pragma unroll
                for (int n = 0; n < 2; ++n) acc[a][b][m][n] = (f32x4){0.f, 0.f, 0.f, 0.f};
    bf16x8 At[4][2], B0[2][2], B1[2][2];
    const char* cA = (const char*)g.A + (size_t)cur.pm * tstep; const char* cB = (const char*)g.Bt + (size_t)cur.pn * tstep;
    S.a_ready(cur);
    if constexpr (SP2) {
        PG8_STAGE(PG8_SB(0, 0), cB, voffB); PG8_STAGE(PG8_SB(0, 1), cB + hstep, voffB); PG8_STAGE(PG8_SA(0, 0), cA, voffA); PG8_STAGE(PG8_SA(0, 1), cA + hstep, voffA);
        if (wr == 1) PG8_BAR;
        PG8_WAIT_V(2); PG8_BAR;
        PG8_STAGE(PG8_SB(1, 0), cB + kstep, voffB); PG8_STAGE(PG8_SA(1, 0), cA + kstep, voffA); PG8_STAGE(PG8_SB(1, 1), cB + hstep + kstep, voffB);
        PG8_WAIT_V(6); PG8_BAR;
    } else {
        PG8_STAGE(PG8_SB(0, 0), cB, voffB); PG8_STAGE(PG8_SA(0, 0), cA, voffA); PG8_STAGE(PG8_SB(0, 1), cB + hstep, voffB); PG8_STAGE(PG8_SA(0, 1), cA + hstep, voffA);
        if (wr == 1) PG8_BAR;
        PG8_WAIT_V(4); PG8_BAR;
        PG8_STAGE(PG8_SB(1, 0), cB + kstep, voffB); PG8_STAGE(PG8_SA(1, 0), cA + kstep, voffA); PG8_STAGE(PG8_SB(1, 1), cB + hstep + kstep, voffB);
        PG8_WAIT_V(6); PG8_BAR;
    }
    for (;;) {
        const bool has_next = S.next(ui + 1, nxt);
        const char* nA = has_next ? (const char*)g.A + (size_t)nxt.pm * tstep : cA; const char* nB = has_next ? (const char*)g.Bt + (size_t)nxt.pn * tstep : cB;
        for (int t = 0; t < nt; t += 2) {
            const bool last = (t == nt - 2);
            const char* a1 = cA + (size_t)(t + 1) * kstep;
            const char* a2 = last ? nA : cA + (size_t)(t + 2) * kstep; const char* b2 = last ? nB : cB + (size_t)(t + 2) * kstep;
            const char* a3 = a2 + kstep; const char* b3 = b2 + kstep;
            if (last && has_next) S.a_ready(nxt);
            if constexpr (SP2) {
            PG8_LDB(B0, 0, 0); PG8_LDB(B1, 0, 1); PG8_SCHED; PG8_LDA(At, 0, 0); PG8_STAGE(PG8_SA(1, 1), a1 + hstep, voffA);
            PG8_WAIT_V(8); PG8_WAIT_L(0); PG8_BAR; PG8_MMA(0, 0, At, B0); PG8_MMA(0, 1, At, B1); PG8_BAR; PG8_SCHED;
            PG8_LDA(At, 0, 1); PG8_STAGE(PG8_SB(0, 0), b2, voffB); PG8_STAGE(PG8_SB(0, 1), b2 + hstep, voffB); PG8_STAGE(PG8_SA(0, 0), a2, voffA);
            PG8_WAIT_V(8); PG8_WAIT_L(0); PG8_BAR; PG8_MMA(1, 0, At, B0); PG8_MMA(1, 1, At, B1); PG8_BAR; PG8_SCHED;
            PG8_LDB(B0, 1, 0); PG8_LDB(B1, 1, 1); PG8_SCHED; PG8_LDA(At, 1, 0); PG8_STAGE(PG8_SA(0, 1), a2 + hstep, voffA);
            PG8_WAIT_V(8); PG8_WAIT_L(0); PG8_BAR; PG8_MMA(0, 0, At, B0); PG8_MMA(0, 1, At, B1); PG8_BAR; PG8_SCHED;
            PG8_LDA(At, 1, 1); PG8_STAGE(PG8_SB(1, 0), b3, voffB); PG8_STAGE(PG8_SB(1, 1), b3 + hstep, voffB); PG8_STAGE(PG8_SA(1, 0), a3, voffA);
            PG8_WAIT_V(8); PG8_WAIT_L(0); PG8_BAR; PG8_MMA(1, 0, At, B0); PG8_MMA(1, 1, At, B1); PG8_BAR; PG8_SCHED;
            } else {
            PG8_LDB(B0, 0, 0); PG8_SCHED; PG8_LDA(At, 0, 0); PG8_STAGE(PG8_SA(1, 1), a1 + hstep, voffA);
            PG8_WAIT_L(8); PG8_BAR; PG8_WAIT_L(0); PG8_MMA(0, 0, At, B0); PG8_BAR; PG8_SCHED;
            PG8_LDB(B1, 0, 1); PG8_STAGE(PG8_SB(0, 0), b2, voffB);
            PG8_BAR; PG8_WAIT_L(0); PG8_MMA(0, 1, At, B1); PG8_BAR;
            PG8_LDA(At, 0, 1); PG8_STAGE(PG8_SA(0, 0), a2, voffA);
            PG8_BAR; PG8_WAIT_L(0); PG8_MMA(1, 0, At, B0); PG8_BAR; PG8_SCHED;
            PG8_STAGE(PG8_SB(0, 1), b2 + hstep, voffB);
            PG8_WAIT_V(6); PG8_BAR; PG8_MMA(1, 1, At, B1); PG8_BAR;
            PG8_LDB(B0, 1, 0); PG8_SCHED; PG8_LDA(At, 1, 0); PG8_STAGE(PG8_SA(0, 1), a2 + hstep, voffA);
            PG8_WAIT_L(8); PG8_BAR; PG8_WAIT_L(0); PG8_MMA(0, 0, At, B0); PG8_BAR; PG8_SCHED;
            PG8_LDB(B1, 1, 1); PG8_STAGE(PG8_SB(1, 0), b3, voffB);
            PG8_BAR; PG8_WAIT_L(0); PG8_MMA(0, 1, At, B1); PG8_BAR;
            PG8_LDA(At, 1, 1); PG8_STAGE(PG8_SA(1, 0), a3, voffA);
            PG8_BAR; PG8_WAIT_L(0); PG8_MMA(1, 0, At, B0); PG8_BAR; PG8_SCHED;
            PG8_STAGE(PG8_SB(1, 1), b3 + hstep, voffB);
            PG8_WAIT_V(6); PG8_BAR; PG8_MMA(1, 1, At, B1); PG8_BAR;
            }
        }
        if constexpr (ALIGN_EPI) { if (wr == 0) PG8_BAR; }
        if constexpr (!Epi::AFTER_DRAIN) { E(acc, cur, wr, wc, fr, fq); S.done(cur); }
        if (!has_next) break;
#pragma unroll
        for (int a = 0; a < 2; ++a)
#pragma unroll
            for (int b = 0; b < 2; ++b)
#pragma unroll
                for (int m = 0; m < 4; ++m)
#pragma unroll
                    for (int n = 0; n < 2; ++n) acc[a][b][m][n] = (f32x4){0.f, 0.f, 0.f, 0.f};
        cur = nxt; cA = nA; cB = nB; ++ui;
        if constexpr (ALIGN_EPI) { if (wr == 1) PG8_BAR; }
    }
    PG8_WAIT_V(0);
    if constexpr (!ALIGN_EPI) { if (wr == 0) PG8_BAR; }
    PG8_BAR;
    if constexpr (Epi::AFTER_DRAIN) { E.fused(acc, cur, wr, wc, fr, fq, lds, wid, lane); S.done(cur); }
#undef PG8_SA
#undef PG8_SB
#undef PG8_STAGE
#undef PG8_LDA
#undef PG8_LDB
#undef PG8_MMA
#undef PG8_WAIT_V
#undef PG8_WAIT_L
#undef PG8_BAR
#undef PG8_SCHED
}
}

#define GAS __attribute__((address_space(1)))
#define LAS __attribute__((address_space(3)))
typedef unsigned short bf16;
typedef unsigned v4u __attribute__((ext_vector_type(4)));
typedef unsigned v2u __attribute__((ext_vector_type(2)));
typedef float f32x4 __attribute__((ext_vector_type(4)));
typedef float f32x16 __attribute__((ext_vector_type(16)));
typedef short s16x8 __attribute__((ext_vector_type(8)));
typedef short s16x4 __attribute__((ext_vector_type(4)));
typedef GAS unsigned gu32;

constexpr int NWAVES = 8;
constexpr int BATCH = 2, SEQ = 8192, D = 2048, M = BATCH * SEQ;
constexpr int NQKV = 3840, NGATE = 4096, NB1 = NQKV + NGATE;
constexpr int AW = 1024, BW = 768, XW = 512, MEML = 256, NEXP = 32, DFF = 512;
constexpr int C_QA = 0, C_KA = 1024, C_VA = 1280, C_QB = 1536, C_KB = 2304, C_VB = 3072;
constexpr int MAXPANEL = 160;
constexpr float EPS = 1e-6f, LOG2E = 1.4426950408889634f, NEGBIG = -1e30f;
constexpr int TABW = 256;

constexpr size_t MiB = 1u << 20;
constexpr size_t WS_CTL = 0, CTL_ZERO_BYTES = 1 * MiB;
constexpr size_t WS_TAB = 1 * MiB, WS_ROUTE = 2 * MiB, WS_MEMN = 4 * MiB, WS_SSQ = 6 * MiB;
constexpr size_t WS_WA = 8 * MiB, WS_WB = 12 * MiB, WS_WO = 15 * MiB, WS_WXQ = 23 * MiB, WS_WXKV = 25 * MiB, WS_WXO = 29 * MiB;
constexpr size_t WS_W13 = 31 * MiB, WS_W2 = 159 * MiB, WS_X1 = 223 * MiB, WS_QKV = WS_X1, WS_U = 351 * MiB, WS_ACT = 575 * MiB, WS_END = 615 * MiB;
constexpr size_t WS_BT1 = WS_U, WS_H = WS_U + 32 * MiB, WS_GA = WS_U + 96 * MiB, WS_GB = WS_U + 160 * MiB;
constexpr size_t WS_OA = WS_U, WS_OB = WS_U + 32 * MiB, WS_XG = WS_U, WS_QX = WS_U + 64 * MiB, WS_KVX = WS_U + 80 * MiB, WS_OX = WS_U + 82 * MiB;
constexpr size_t WS_HM = WS_U, WS_AS = WS_U + 64 * MiB, WS_Y = WS_AS;
constexpr size_t RT_E = 0, RT_W = 128 * 1024, RT_SLOT = 256 * 1024, RT_DEST = 384 * 1024, RT_RSTD = 512 * 1024, RT_RSORT = 576 * 1024;
constexpr int CW_BAR = 4096, CW_CNT = 16384;

constexpr int RING_OFF = 0, RING_BYTES = 131072, MISC_OFF = RING_BYTES, PEXP_OFF = RING_BYTES + 256, LDS_BYTES = RING_BYTES + 4096;

#define LDS_WAIT() asm volatile("s_waitcnt lgkmcnt(0)" ::: "memory")
#define VM_WAIT() asm volatile("s_waitcnt vmcnt(0)" ::: "memory")
__device__ __forceinline__ unsigned f2bf(float f) { unsigned u = __builtin_bit_cast(unsigned, f); return (u + 0x7fffu + ((u >> 16) & 1u)) >> 16; }
__device__ __forceinline__ unsigned pk2(float lo, float hi) { return f2bf(lo) | (f2bf(hi) << 16); }
__device__ __forceinline__ float bf_lo(unsigned w) { return __builtin_bit_cast(float, w << 16); }
__device__ __forceinline__ float bf_hi(unsigned w) { return __builtin_bit_cast(float, w & 0xffff0000u); }
__device__ __forceinline__ float wave_sum(float v) {
#pragma unroll
    for (int o = 1; o < 64; o <<= 1) v += __shfl_xor(v, o);
    return v;
}
__device__ __forceinline__ float fast_exp2(float x) { return __builtin_amdgcn_exp2f(x); }
__device__ __forceinline__ float fast_rcp(float x) { return __builtin_amdgcn_rcpf(x); }
#define XB_TMO      128
#define XB_XCNT(j)  (256  + 64 * (j))
#define XB_XSUB(j)  (1280 + 64 * (j))
#define XB_XGEN(j)  (2304 + 64 * (j))
#define XB_TOP      3328
#define XB_TOPGEN   3392
#define XCD_BAR_WORDS 3456
#define XB_SPIN_CAP (1u << 18)

__device__ __forceinline__ unsigned xb_ld(unsigned* p)              { return __hip_atomic_load(p, __ATOMIC_RELAXED, __HIP_MEMORY_SCOPE_AGENT); }
__device__ __forceinline__ unsigned xb_add(unsigned* p, unsigned v) { return __hip_atomic_fetch_add(p, v, __ATOMIC_RELAXED, __HIP_MEMORY_SCOPE_AGENT); }
__device__ __forceinline__ unsigned xb_xcc_id() { return (unsigned)__builtin_amdgcn_s_getreg((3 << 11) | 20) & 0xFu; }
#define XB_SPIN(cond, bar) do { unsigned _sp = 0; while (cond) { __builtin_amdgcn_s_sleep(1); \
    if ((++_sp & 255u) == 0u) { if (xb_ld(&(bar)[XB_TMO])) break; if (_sp > XB_SPIN_CAP) { atomicAdd(&(bar)[XB_TMO], 1u); break; } } } } while (0)

struct XcdBarrier {
    unsigned* bar; unsigned x;
    volatile LAS unsigned* st;
};

__device__ __forceinline__ XcdBarrier xcd_barrier_post(unsigned* bar, volatile LAS unsigned* st) {
    XcdBarrier b; b.bar = bar; b.x = xb_xcc_id(); b.st = st;
    if (threadIdx.x == 0) (void)xb_add(&bar[XB_XCNT(b.x)], 1u);
    return b;
}
__device__ __forceinline__ void xcd_barrier_complete(unsigned* bar, unsigned x, unsigned& nloc, unsigned& nx) {
    const unsigned G = gridDim.x * gridDim.y * gridDim.z;
    unsigned sum, cnt, mine, sp = 0u;
    for (;;) {
        sum = 0u; cnt = 0u; mine = 0u;
#pragma unroll
        for (unsigned j = 0; j < 16; ++j) { const unsigned c = xb_ld(&bar[XB_XCNT(j)]); sum += c; cnt += (c > 0u) ? 1u : 0u; mine = (j == x) ? c : mine; }
        if (sum == G) break;
        __builtin_amdgcn_s_sleep(1);
        if ((++sp & 255u) == 0u) { if (xb_ld(&bar[XB_TMO])) break; if (sp > XB_SPIN_CAP) { atomicAdd(&bar[XB_TMO], 1u); break; } }
    }
    nloc = mine > 0u ? mine : 1u; nx = cnt > 0u ? cnt : 1u;
}

__device__ __forceinline__ void xcd_barrier(const XcdBarrier& b) {
    asm volatile("s_waitcnt vmcnt(0)" ::: "memory");
    __syncthreads();
    if (threadIdx.x == 0) {
        unsigned* bar = b.bar;
        __builtin_amdgcn_s_waitcnt(0);
        unsigned nloc = b.st[0], nx = b.st[1];
        if (nloc == 0u) { xcd_barrier_complete(bar, b.x, nloc, nx); b.st[0] = nloc; b.st[1] = nx; }
        const unsigned old = xb_add(&bar[XB_XSUB(b.x)], 1u);
        const unsigned gen = old / nloc;
        if (old + 1u == (gen + 1u) * nloc) {
            __builtin_amdgcn_fence(__ATOMIC_RELEASE, "agent");
            asm volatile("s_waitcnt vmcnt(0)" ::: "memory");
            const unsigned og = xb_add(&bar[XB_TOP], 1u);
            const unsigned tg = og / nx;
            if (og + 1u == (tg + 1u) * nx) xb_add(&bar[XB_TOPGEN], 1u);
            else XB_SPIN(xb_ld(&bar[XB_TOPGEN]) == tg, bar);
            __builtin_amdgcn_fence(__ATOMIC_ACQUIRE, "agent");
            xb_add(&bar[XB_XGEN(b.x)], 1u);
            asm volatile("s_waitcnt vmcnt(0)" ::: "memory");
        } else {
            XB_SPIN(xb_ld(&bar[XB_XGEN(b.x)]) == gen, bar);
            __builtin_amdgcn_fence(__ATOMIC_ACQUIRE, "agent");
            asm volatile("s_waitcnt vmcnt(0)" ::: "memory");
        }
    }
    __syncthreads();
}

#define EPI_ARGS const pg8::f32x4 (&acc)[2][2][4][2], const pg8::Unit& u, int wr, int wc, int fr, int fq
#define EPI_FOR_AI_M _Pragma("unroll") for (int ai = 0; ai < 2; ++ai) _Pragma("unroll") for (int m = 0; m < 4; ++m)
__device__ __forceinline__ v4u pack8(const f32x4 a, const f32x4 b) { v4u w; w.x = pg8::cvt_pk_bf16(a[0], a[1]); w.y = pg8::cvt_pk_bf16(a[2], a[3]); w.z = pg8::cvt_pk_bf16(b[0], b[1]); w.w = pg8::cvt_pk_bf16(b[2], b[3]); return w; }
__device__ __forceinline__ float sigmoidf_fast(float v) { return fast_rcp(1.0f + fast_exp2(-v * LOG2E)); }

struct EpiQKVG {
    static constexpr bool PERM = true, AFTER_DRAIN = false;
    bf16* qkv; bf16* ga; bf16* gb; const float* bgate;
    __device__ __forceinline__ void operator()(EPI_ARGS) const {
        const int row0 = u.pm * 256 + wr * 64 + fr, ct = wc * 32 + 8 * fq;
        if (u.pn < 15) {
            const float sc = (u.pn < 4 || (u.pn >= 6 && u.pn < 9)) ? 0.125f : 1.0f;
            EPI_FOR_AI_M { bf16* rowp = qkv + (size_t)(row0 + ai * 128 + m * 16) * NQKV + u.pn * 256 + ct;
#pragma unroll
                for (int bj = 0; bj < 2; ++bj) *(v4u*)(rowp + bj * 128) = pack8(acc[ai][bj][m][0] * sc, acc[ai][bj][m][1] * sc); }
        } else {
            const int gt = u.pn - 15; bf16* base = (gt < 8) ? ga : gb; const int gc = (gt & 7) * 256 + ct, bc = gt * 256 + ct;
            f32x4 bv[2][2];
#pragma unroll
            for (int bj = 0; bj < 2; ++bj)
#pragma unroll
                for (int n = 0; n < 2; ++n) bv[bj][n] = *(const f32x4*)(bgate + bc + bj * 128 + 4 * n);
            EPI_FOR_AI_M { bf16* rowp = base + (size_t)(row0 + ai * 128 + m * 16) * D + gc;
#pragma unroll
                for (int bj = 0; bj < 2; ++bj) { f32x4 v0 = acc[ai][bj][m][0] + bv[bj][0], v1 = acc[ai][bj][m][1] + bv[bj][1];
#pragma unroll
                    for (int j = 0; j < 4; ++j) { v0[j] = sigmoidf_fast(v0[j]); v1[j] = sigmoidf_fast(v1[j]); }
                    *(v4u*)(rowp + bj * 128) = pack8(v0, v1); } }
        }
    }
};

template <int MODE> struct EpiGate {
    static constexpr bool PERM = true, AFTER_DRAIN = false;
    bf16* mix; const bf16* gb;
    __device__ __forceinline__ void operator()(EPI_ARGS) const {
        const int row0 = u.pm * 256 + wr * 64 + fr, ct = u.pn * 256 + wc * 32 + 8 * fq;
        EPI_FOR_AI_M { const size_t off = (size_t)(row0 + ai * 128 + m * 16) * D + ct;
#pragma unroll
            for (int bj = 0; bj < 2; ++bj) { const v4u t = *(const v4u*)(mix + off + bj * 128); const f32x4 a0 = acc[ai][bj][m][0], a1 = acc[ai][bj][m][1]; f32x4 o0, o1;
                if (MODE == 0) { o0 = (f32x4){bf_lo(t.x) * a0[0], bf_hi(t.x) * a0[1], bf_lo(t.y) * a0[2], bf_hi(t.y) * a0[3]}; o1 = (f32x4){bf_lo(t.z) * a1[0], bf_hi(t.z) * a1[1], bf_lo(t.w) * a1[2], bf_hi(t.w) * a1[3]}; }
                else { const v4u g = *(const v4u*)(gb + off + bj * 128);
                    o0 = (f32x4){bf_lo(t.x) + bf_lo(g.x) * a0[0], bf_hi(t.x) + bf_hi(g.x) * a0[1], bf_lo(t.y) + bf_lo(g.y) * a0[2], bf_hi(t.y) + bf_hi(g.y) * a0[3]};
                    o1 = (f32x4){bf_lo(t.z) + bf_lo(g.z) * a1[0], bf_hi(t.z) + bf_hi(g.z) * a1[1], bf_lo(t.w) + bf_lo(g.w) * a1[2], bf_hi(t.w) + bf_hi(g.w) * a1[3]}; }
                *(v4u*)(mix + off + bj * 128) = pack8(o0, o1); }
            asm volatile("" ::: "memory"); }
    }
};

struct EpiResid {
    static constexpr bool PERM = true, AFTER_DRAIN = false;
    const float* x; float* x1; bf16* xg; const float* gx; float* ssq;
    __device__ __forceinline__ void operator()(EPI_ARGS) const {
        const int row0 = u.pm * 256 + wr * 64 + fr, ct = u.pn * 256 + wc * 32 + 8 * fq;
        f32x4 gv[2][2];
#pragma unroll
        for (int bj = 0; bj < 2; ++bj)
#pragma unroll
            for (int n = 0; n < 2; ++n) gv[bj][n] = *(const f32x4*)(gx + ct + bj * 128 + 4 * n);
        EPI_FOR_AI_M { const int row = row0 + ai * 128 + m * 16; const size_t off = (size_t)row * D + ct; float s = 0.f;
#pragma unroll
            for (int bj = 0; bj < 2; ++bj) { f32x4 v[2];
#pragma unroll
                for (int n = 0; n < 2; ++n) { v[n] = *(const f32x4*)(x + off + bj * 128 + 4 * n) + acc[ai][bj][m][n]; *(f32x4*)(x1 + off + bj * 128 + 4 * n) = v[n];
                    s += (v[n][0] * v[n][0] + v[n][1] * v[n][1]) + (v[n][2] * v[n][2] + v[n][3] * v[n][3]); }
                *(v4u*)(xg + off + bj * 128) = pack8(v[0] * gv[bj][0], v[1] * gv[bj][1]); }
            s += __shfl_xor(s, 16); s += __shfl_xor(s, 32);
            if (fq == 0) ssq[(size_t)row * 32 + u.pn * 4 + wc] = s;
            asm volatile("" ::: "memory"); }
    }
};

struct EpiQx {
    static constexpr bool PERM = true, AFTER_DRAIN = false;
    bf16* qx; const float* ssq; float scale;
    __device__ __forceinline__ void operator()(EPI_ARGS) const {
        const int row0 = u.pm * 256 + wr * 64 + fr, ct = u.pn * 256 + wc * 32 + 8 * fq;
        EPI_FOR_AI_M { const int row = row0 + ai * 128 + m * 16;
            const f32x4 p0 = *(const f32x4*)(ssq + (size_t)row * 32 + fq * 8), p1 = *(const f32x4*)(ssq + (size_t)row * 32 + fq * 8 + 4);
            float s = ((p0[0] + p0[1]) + (p0[2] + p0[3])) + ((p1[0] + p1[1]) + (p1[2] + p1[3]));
            s += __shfl_xor(s, 16); s += __shfl_xor(s, 32);
            const float rs = scale / sqrtf(s * (1.0f / D) + EPS);
            bf16* rowp = qx + (size_t)row * XW + ct;
#pragma unroll
            for (int bj = 0; bj < 2; ++bj) *(v4u*)(rowp + bj * 128) = pack8(acc[ai][bj][m][0] * rs, acc[ai][bj][m][1] * rs); }
    }
};

struct EpiBf {
    static constexpr bool PERM = true, AFTER_DRAIN = false;
    bf16* out; int ldc; int tmod;
    __device__ __forceinline__ void operator()(EPI_ARGS) const {
        const int row0 = u.pm * 256 + wr * 64 + fr, ct = (u.pn % tmod) * 256 + wc * 32 + 8 * fq;
        EPI_FOR_AI_M { bf16* rowp = out + (size_t)(row0 + ai * 128 + m * 16) * ldc + ct;
#pragma unroll
            for (int bj = 0; bj < 2; ++bj) *(v4u*)(rowp + bj * 128) = pack8(acc[ai][bj][m][0], acc[ai][bj][m][1]); }
    }
};

struct EpiResid2 {
    static constexpr bool PERM = true, AFTER_DRAIN = false;
    float* x1;
    __device__ __forceinline__ void operator()(EPI_ARGS) const {
        const int row0 = u.pm * 256 + wr * 64 + fr, ct = u.pn * 256 + wc * 32 + 8 * fq;
        EPI_FOR_AI_M { float* rowp = x1 + (size_t)(row0 + ai * 128 + m * 16) * D + ct;
#pragma unroll
            for (int bj = 0; bj < 2; ++bj)
#pragma unroll
                for (int n = 0; n < 2; ++n) { f32x4* p = (f32x4*)(rowp + bj * 128 + 4 * n); *p = *p + acc[ai][bj][m][n]; }
            asm volatile("" ::: "memory"); }
    }
};

struct EpiSwiGLU {
    static constexpr bool PERM = true, AFTER_DRAIN = false;
    bf16* act; const float* rsort;
    __device__ __forceinline__ void operator()(EPI_ARGS) const {
        const int row0 = u.pm * 256 + wr * 64 + fr, ct = (u.pn & 3) * 128 + wc * 16 + 4 * fq;
        EPI_FOR_AI_M { const int row = row0 + ai * 128 + m * 16; const float rs = rsort[row]; bf16* rowp = act + (size_t)row * DFF + ct;
#pragma unroll
            for (int bj = 0; bj < 2; ++bj) { const f32x4 a = acc[ai][bj][m][0] * rs, b = acc[ai][bj][m][1] * rs;
                const float o0 = a[0] * sigmoidf_fast(a[0]) * a[1], o1 = a[2] * sigmoidf_fast(a[2]) * a[3], o2 = b[0] * sigmoidf_fast(b[0]) * b[1], o3 = b[2] * sigmoidf_fast(b[2]) * b[3];
                v2u w; w.x = pg8::cvt_pk_bf16(o0, o1); w.y = pg8::cvt_pk_bf16(o2, o3);
                *(v2u*)(rowp + bj * 64) = w; } }
    }
};

constexpr int ATT_TAB_OFF = 0;
constexpr int ATT_V_OFF = 8192;
constexpr int ATT_V_WAVE64 = 6144, ATT_V_WAVE128 = 10240;
constexpr int ATT_OB_OFF = ATT_V_OFF + 8 * ATT_V_WAVE64;
constexpr int ATT_LSE_OFF = ATT_OB_OFF + 65536;
static_assert(ATT_LSE_OFF + 2048 <= 131072 && ATT_V_OFF + 8 * ATT_V_WAVE128 <= 131072, "attention LDS map inside the ring region");

template <int DH> struct AttnGeom { static constexpr int VSTRIDE = (DH == 64) ? 192 : 320, CPR = DH / 8, RPI = 64 / CPR, NVI = 32 / RPI, NST = DH / 16, NDT = DH / 32; };


template <int VSTRIDE, int DT>
__device__ __forceinline__ void pv_step(unsigned tr_base, const s16x8 (&pf)[2], f32x16& Od) {
    s16x4 a0, a1, b0, b1;
    asm volatile("ds_read_b64_tr_b16 %0, %4 offset:%5\n\tds_read_b64_tr_b16 %1, %4 offset:%6\n\tds_read_b64_tr_b16 %2, %4 offset:%7\n\tds_read_b64_tr_b16 %3, %4 offset:%8\n\ts_waitcnt lgkmcnt(0)"
                 : "=&v"(a0), "=&v"(a1), "=&v"(b0), "=&v"(b1)
                 : "v"(tr_base), "i"(64 * DT), "i"(64 * DT + 8 * VSTRIDE), "i"(64 * DT + 16 * VSTRIDE), "i"(64 * DT + 24 * VSTRIDE) : "memory");
    const s16x8 vf0 = __builtin_shufflevector(a0, a1, 0, 1, 2, 3, 4, 5, 6, 7), vf1 = __builtin_shufflevector(b0, b1, 0, 1, 2, 3, 4, 5, 6, 7);
    Od = __builtin_amdgcn_mfma_f32_32x32x16_bf16(vf0, pf[0], Od, 0, 0, 0);
    Od = __builtin_amdgcn_mfma_f32_32x32x16_bf16(vf1, pf[1], Od, 0, 0, 0);
}

struct AttnJob {
    const bf16* q; int ldq; long qrow0; int qstride; int qmask;
    const bf16* k; const bf16* v; int ldkv; long krow0; int kstride;
    int i0;
    int u_begin, ntiles;
    float m_init, l_init;
};

template <int DH> struct KVTile { s16x8 k[DH / 16]; v4u v[AttnGeom<DH>::NVI]; };
template <int DH> __device__ __forceinline__ void attn_load_tile(const AttnJob& J, int u0, int lane, KVTile<DH>& T) {
    typedef AttnGeom<DH> G;
    const int q = lane & 31, h = lane >> 5, vr = lane / G::CPR, vc = lane % G::CPR;
    const bf16* kp = J.k + (size_t)(J.krow0 + (long)(u0 + q) * J.kstride) * J.ldkv + 8 * h;
#pragma unroll
    for (int st = 0; st < G::NST; ++st) T.k[st] = *(const s16x8*)(kp + 16 * st);
#pragma unroll
    for (int i = 0; i < G::NVI; ++i) T.v[i] = *(const v4u*)(J.v + (size_t)(J.krow0 + (long)(u0 + vr + G::RPI * i) * J.kstride) * J.ldkv + 8 * vc);
}
template <int DH, bool TAB>
__device__ __forceinline__ void attn_process_tile(const AttnJob& J, int u0, const KVTile<DH>& T, const s16x8 (&qf)[DH / 16], const LAS float* tab, LAS unsigned char* vst, unsigned tr_base, int lane,
                                                  f32x16 (&O)[DH / 32], float& mrun, float& lrun) {
    typedef AttnGeom<DH> G;
    const int q = lane & 31, h = lane >> 5, vr = lane / G::CPR, vc = lane % G::CPR;
    f32x16 S;
#pragma unroll
    for (int i = 0; i < 16; ++i) S[i] = 0.f;
#pragma unroll
    for (int st = 0; st < G::NST; ++st) S = __builtin_amdgcn_mfma_f32_32x32x16_bf16(T.k[st], qf[st], S, 0, 0, 0);
#pragma unroll
    for (int i = 0; i < G::NVI; ++i) *(LAS v4u*)(vst + (vr + G::RPI * i) * G::VSTRIDE + 16 * vc) = T.v[i];
    float sv[16]; float mx = NEGBIG;
    const int dbase = (J.i0 - u0) + q - 4 * h + 32;
#pragma unroll
    for (int i = 0; i < 16; ++i) { const int cr = (i & 3) + 8 * (i >> 2); const float b = TAB ? tab[dbase - cr] : 0.f; sv[i] = S[i] * LOG2E + b; mx = fmaxf(mx, sv[i]); }
    mx = fmaxf(mx, __shfl_xor(mx, 32));
    const float mnew = fmaxf(mrun, mx), alpha = fast_exp2(mrun - mnew); mrun = mnew;
    float ps = 0.f;
#pragma unroll
    for (int i = 0; i < 16; ++i) { sv[i] = fast_exp2(sv[i] - mnew); ps += sv[i]; }
    ps += __shfl_xor(ps, 32);
    lrun = lrun * alpha + ps;
#pragma unroll
    for (int dt = 0; dt < G::NDT; ++dt)
#pragma unroll
        for (int i = 0; i < 16; ++i) O[dt][i] *= alpha;
    s16x8 pf[2];
#pragma unroll
    for (int s = 0; s < 2; ++s) { unsigned w0 = pg8::cvt_pk_bf16(sv[8 * s + 0], sv[8 * s + 1]), w1 = pg8::cvt_pk_bf16(sv[8 * s + 2], sv[8 * s + 3]), w2 = pg8::cvt_pk_bf16(sv[8 * s + 4], sv[8 * s + 5]), w3 = pg8::cvt_pk_bf16(sv[8 * s + 6], sv[8 * s + 7]);
        v4u w = {w0, w1, w2, w3}; pf[s] = __builtin_bit_cast(s16x8, w); }
    LDS_WAIT();
    pv_step<G::VSTRIDE, 0>(tr_base, pf, O[0]); pv_step<G::VSTRIDE, 1>(tr_base, pf, O[1]);
    if constexpr (G::NDT == 4) { pv_step<G::VSTRIDE, 2>(tr_base, pf, O[2]); pv_step<G::VSTRIDE, 3>(tr_base, pf, O[3]); }
}

template <int DH, bool TAB, bool PIPE>
__device__ __forceinline__ void attn_job(const AttnJob& J, const LAS float* tab, LAS unsigned char* vst, int lane, f32x16 (&O)[DH / 32], float& m_out, float& l_out) {
    typedef AttnGeom<DH> G;
    const int q = lane & 31, h = lane >> 5;
    s16x8 qf[G::NST];
    { const bf16* qp = J.q + (size_t)(J.qrow0 + (long)(q & J.qmask) * J.qstride) * J.ldq + 8 * h;
#pragma unroll
      for (int st = 0; st < G::NST; ++st) qf[st] = *(const s16x8*)(qp + 16 * st); }
#pragma unroll
    for (int dt = 0; dt < G::NDT; ++dt)
#pragma unroll
        for (int i = 0; i < 16; ++i) O[dt][i] = 0.f;
    float mrun = J.m_init, lrun = J.l_init;
    const unsigned tr_base = (unsigned)(size_t)vst + (unsigned)((4 * h + ((lane & 15) >> 2)) * G::VSTRIDE + (16 * ((lane >> 4) & 1) + 4 * (lane & 3)) * 2);
    const int nt = J.ntiles, ub = J.u_begin;
    if constexpr (PIPE) {
        KVTile<DH> A, B;
        attn_load_tile<DH>(J, ub, lane, A);
        int t = 0;
        for (;;) {
            { const int tl = (t + 1 < nt) ? t + 1 : nt - 1; attn_load_tile<DH>(J, ub + 32 * tl, lane, B); }
            attn_process_tile<DH, TAB>(J, ub + 32 * t, A, qf, tab, vst, tr_base, lane, O, mrun, lrun); if (++t >= nt) break;
            { const int tl = (t + 1 < nt) ? t + 1 : nt - 1; attn_load_tile<DH>(J, ub + 32 * tl, lane, A); }
            attn_process_tile<DH, TAB>(J, ub + 32 * t, B, qf, tab, vst, tr_base, lane, O, mrun, lrun); if (++t >= nt) break;
        }
    } else {
        for (int t = 0; t < nt; ++t) { KVTile<DH> A; attn_load_tile<DH>(J, ub + 32 * t, lane, A); attn_process_tile<DH, TAB>(J, ub + 32 * t, A, qf, tab, vst, tr_base, lane, O, mrun, lrun); }
    }
    m_out = mrun; l_out = lrun;
}

struct Frame {
    LAS unsigned char* lds;
    volatile LAS unsigned* MISC;
    gu32* ctl;
    unsigned char* ws;
    int tid, lane, wave, vcu, G;
    const float* in[24];
    float* out;
};
enum { I_X = 0, I_MEM, I_RELB, I_GMIX, I_WIN, I_SINK, I_WAOUT, I_WBOUT, I_WGATE, I_BGATE, I_WO, I_GX, I_GMEM, I_WXQ, I_WXK, I_WXV, I_WXO, I_GMOE, I_WRG, I_WRE, I_W1, I_W3, I_W2, I_GFIN };

__device__ __forceinline__ void p0_transpose_item(const float* W, int K, int N, bf16* WT, int row_off, int row_mul, LAS unsigned* scr, int item, int lane) {
    const int nblk = N / 64, kb = item / nblk, nb = item % nblk, k0 = 64 * kb, n0 = 64 * nb;
    const int r4 = lane >> 4, c16 = lane & 15;
    f32x4 v[16];
    const float* src = W + (size_t)(k0 + 2 * r4) * N + n0 + 4 * c16;
#pragma unroll
    for (int i = 0; i < 8; ++i) { v[2 * i] = *(const f32x4*)(src + (size_t)(8 * i) * N); v[2 * i + 1] = *(const f32x4*)(src + (size_t)(8 * i + 1) * N); }
#pragma unroll
    for (int i = 0; i < 8; ++i)
#pragma unroll
        for (int j = 0; j < 4; ++j) scr[(4 * c16 + j) * 33 + 4 * i + r4] = pg8::cvt_pk_bf16(v[2 * i][j], v[2 * i + 1][j]);
    LDS_WAIT(); asm volatile("" ::: "memory");
    const int nr = lane >> 3, c = lane & 7;
#pragma unroll
    for (int jj = 0; jj < 8; ++jj) { const int n = nr + 8 * jj; const LAS unsigned* s = scr + n * 33 + 4 * c;
        v4u o; o.x = s[0]; o.y = s[1]; o.z = s[2]; o.w = s[3];
        *(v4u*)(WT + (size_t)(row_off + (n0 + n) * row_mul) * K + k0 + 8 * c) = o; }
    LDS_WAIT(); asm volatile("" ::: "memory");
}
__device__ __forceinline__ void rms_row_to_bf16(const float* xrow, const float* g, bf16* orow, int lane) {
    const f32x4* xr = (const f32x4*)xrow + lane; const f32x4* gr = (const f32x4*)g + lane;
    f32x4 v[8]; float s = 0.f;
#pragma unroll
    for (int j = 0; j < 8; ++j) { v[j] = xr[64 * j]; s += (v[j][0] * v[j][0] + v[j][1] * v[j][1]) + (v[j][2] * v[j][2] + v[j][3] * v[j][3]); }
    const float rstd = 1.0f / sqrtf(wave_sum(s) * (1.0f / D) + EPS);
    v2u* o8 = (v2u*)orow + lane;
#pragma unroll
    for (int j = 0; j < 8; ++j) { const f32x4 gg = gr[64 * j]; v2u w; w.x = pk2(v[j][0] * rstd * gg[0], v[j][1] * rstd * gg[1]); w.y = pk2(v[j][2] * rstd * gg[2], v[j][3] * rstd * gg[3]); o8[64 * j] = w; }
}
__device__ __forceinline__ int t5_bucket_dev(int d) {
    if (d < 16) return d;
    int large = 16 + (int)(log((double)d / 16.0) / log(128.0) * 16.0);
    return large < 31 ? large : 31;
}
__device__ __forceinline__ void p0_prologue(Frame& F) {
    LAS unsigned* scr = (LAS unsigned*)(F.lds + RING_OFF + F.wave * 16384);
    const int gw = F.vcu * NWAVES + F.wave, NGW = F.G * NWAVES;
    bf16* BT1 = (bf16*)(F.ws + WS_BT1);
    constexpr int I_IN = 32 * 60, I_GT = 32 * 64, I_A = 16 * 32, I_B = 12 * 32, I_O = 32 * 32, I_Q = 32 * 8, I_XO = 8 * 32, I_E13 = 32 * 8, I_E2 = 8 * 32;
    constexpr int NITEMS = I_IN + I_GT + I_A + I_B + I_O + 3 * I_Q + I_XO + 2 * NEXP * I_E13 + NEXP * I_E2;
#ifndef MK_P0_REP_T
#define MK_P0_REP_T 1
#endif
#ifndef MK_P0_REP_N
#define MK_P0_REP_N 1
#endif
    for (int rep = 0; rep < MK_P0_REP_T; ++rep)
    for (int it = gw; it < NITEMS; it += NGW) {
        int r = it;
        if (r < I_IN) { p0_transpose_item(F.in[I_WIN], D, NQKV, BT1, 0, 1, scr, r, F.lane); continue; } r -= I_IN;
        if (r < I_GT) { p0_transpose_item(F.in[I_WGATE], D, NGATE, BT1, NQKV, 1, scr, r, F.lane); continue; } r -= I_GT;
        if (r < I_A) { p0_transpose_item(F.in[I_WAOUT], AW, D, (bf16*)(F.ws + WS_WA), 0, 1, scr, r, F.lane); continue; } r -= I_A;
        if (r < I_B) { p0_transpose_item(F.in[I_WBOUT], BW, D, (bf16*)(F.ws + WS_WB), 0, 1, scr, r, F.lane); continue; } r -= I_B;
        if (r < I_O) { p0_transpose_item(F.in[I_WO], D, D, (bf16*)(F.ws + WS_WO), 0, 1, scr, r, F.lane); continue; } r -= I_O;
        if (r < I_Q) { p0_transpose_item(F.in[I_WXQ], D, XW, (bf16*)(F.ws + WS_WXQ), 0, 1, scr, r, F.lane); continue; } r -= I_Q;
        if (r < I_Q) { p0_transpose_item(F.in[I_WXK], D, XW, (bf16*)(F.ws + WS_WXKV), 0, 1, scr, r, F.lane); continue; } r -= I_Q;
        if (r < I_Q) { p0_transpose_item(F.in[I_WXV], D, XW, (bf16*)(F.ws + WS_WXKV), XW, 1, scr, r, F.lane); continue; } r -= I_Q;
        if (r < I_XO) { p0_transpose_item(F.in[I_WXO], XW, D, (bf16*)(F.ws + WS_WXO), 0, 1, scr, r, F.lane); continue; } r -= I_XO;
        if (r < NEXP * I_E13) { const int e = r / I_E13; p0_transpose_item(F.in[I_W1] + (size_t)e * D * DFF, D, DFF, (bf16*)(F.ws + WS_W13), e * 1024, 2, scr, r % I_E13, F.lane); continue; } r -= NEXP * I_E13;
        if (r < NEXP * I_E13) { const int e = r / I_E13; p0_transpose_item(F.in[I_W3] + (size_t)e * D * DFF, D, DFF, (bf16*)(F.ws + WS_W13), e * 1024 + 1, 2, scr, r % I_E13, F.lane); continue; } r -= NEXP * I_E13;
        { const int e = r / I_E2; p0_transpose_item(F.in[I_W2] + (size_t)e * DFF * D, DFF, D, (bf16*)(F.ws + WS_W2), e * 2048, 1, scr, r % I_E2, F.lane); }
    }
    for (int rep = 0; rep < MK_P0_REP_N; ++rep)
    for (int m = gw; m < M + BATCH * MEML; m += NGW) {
        if (m < M) rms_row_to_bf16(F.in[I_X] + (size_t)m * D, F.in[I_GMIX], (bf16*)(F.ws + WS_H) + (size_t)m * D, F.lane);
        else rms_row_to_bf16(F.in[I_MEM] + (size_t)(m - M) * D, F.in[I_GMEM], (bf16*)(F.ws + WS_MEMN) + (size_t)(m - M) * D, F.lane);
    }
    float* tabA = (float*)(F.ws + WS_TAB); float* tabB = tabA + 16 * TABW;
    const int gt = (F.vcu * NWAVES + F.wave) * 64 + F.lane, NGT = F.G * NWAVES * 64;
    for (int i = gt; i < 16 * TABW + 36 * TABW; i += NGT) {
        if (i < 16 * TABW) { const int hd = i / TABW, d = i % TABW; tabA[i] = (d <= 127) ? F.in[I_RELB][t5_bucket_dev(d) * 28 + hd] * LOG2E : NEGBIG; }
        else { const int j = i - 16 * TABW, p = j / (12 * TABW), hd = (j / TABW) % 12, d = j % TABW; const int r = (p == 0) ? 1 : (p == 1 ? 4 : 16);
            tabB[j] = (d <= 128) ? F.in[I_RELB][t5_bucket_dev(d * r) * 28 + 16 + hd] * LOG2E : NEGBIG; }
    }
}

__device__ __forceinline__ void fill_tab(LAS float* tab, const float* gtab, int maxoff, int lane) {
#pragma unroll
    for (int j = 0; j < 4; ++j) { const int idx = lane + 64 * j, d = idx - 32; tab[idx] = (d >= 0 && d <= maxoff) ? gtab[d] : NEGBIG; }
    LDS_WAIT();
}
template <int NDT> __device__ __forceinline__ void store_o_global(const f32x16 (&O)[NDT], float inv_l, bf16* rowp, int h) {
#pragma unroll
    for (int dt = 0; dt < NDT; ++dt)
#pragma unroll
        for (int g = 0; g < 4; ++g) { v2u w; w.x = pg8::cvt_pk_bf16(O[dt][4 * g] * inv_l, O[dt][4 * g + 1] * inv_l); w.y = pg8::cvt_pk_bf16(O[dt][4 * g + 2] * inv_l, O[dt][4 * g + 3] * inv_l);
            *(v2u*)(rowp + 32 * dt + 8 * g + 4 * h) = w; }
}
__device__ __forceinline__ void p2_attention(Frame& F) {
    const bf16* qkv = (const bf16*)(F.ws + WS_QKV);
    bf16* oa = (bf16*)(F.ws + WS_OA); bf16* ob = (bf16*)(F.ws + WS_OB);
    const float* tabA = (const float*)(F.ws + WS_TAB); const float* tabB = tabA + 16 * TABW;
    LAS float* tab = (LAS float*)(F.lds + ATT_TAB_OFF + F.wave * 1024);
    LAS unsigned char* vst = F.lds + ATT_V_OFF + F.wave * ATT_V_WAVE64;
    LAS unsigned char* OB = F.lds + ATT_OB_OFF; LAS float* LSE = (LAS float*)(F.lds + ATT_LSE_OFF);
    const int lane = F.lane, w = F.wave, q = lane & 31, h = lane >> 5;
    constexpr int NBU = BATCH * 12 * 32, NAU = BATCH * 64 * 4;
    for (int L = F.vcu; L < NBU + NAU; L += F.G) {
        const bool isB = L < NBU;
        int b, hd = 0, t0 = 0, qblk = 0, hk = 0;
        if (isB) { b = L / 384; hd = (L / 32) % 12; t0 = (L % 32) * 256; } else { const int LA = L - NBU; b = LA / 256; qblk = (LA / 4) % 64; hk = LA % 4; }
        const long brow = (long)b * SEQ;
        const int njobs = isB ? 4 : 2;
#pragma unroll 1
        for (int jj = 0; jj < njobs; ++jj) {
            AttnJob J; J.ldq = NQKV; J.ldkv = NQKV;
            int mode, p = 0, qs0 = 0, qsm = 0, nvalid = 32, maxoff = 128; const float* gtab;
            if (isB) {
                J.q = qkv + C_QB + hd * 64; J.k = qkv + C_KB + hd * 64; J.v = qkv + C_VB + hd * 64; J.m_init = NEGBIG; J.l_init = 0.f;
                if (jj == 0) { const int c = w >> 1, n = w & 1; mode = 1; p = 1; J.i0 = t0 / 4 + 32 * n; J.qrow0 = brow + t0 + c + 128 * n; J.qstride = 4; J.qmask = 31; J.krow0 = brow + c; J.kstride = 4;
                    J.u_begin = (J.i0 - 128) > 0 ? (J.i0 - 128) : 0; J.ntiles = (J.i0 + 32 - J.u_begin) / 32; qs0 = c + 128 * n; qsm = 4; }
                else if (jj < 3) { const int c = w + 8 * (jj - 1); mode = 1; p = 2; J.i0 = t0 / 16; J.qrow0 = brow + t0 + c; J.qstride = 16; J.qmask = 15; J.krow0 = brow + c; J.kstride = 16;
                    int ub = (J.i0 - 128) & ~31; if (ub < 0) ub = 0; J.u_begin = ub; J.ntiles = (((J.i0 + 15) & ~31) - ub) / 32 + 1; qs0 = c; qsm = 16; nvalid = 16; }
                else { __syncthreads(); mode = 2; p = 0; J.i0 = t0 + 32 * w; J.qrow0 = brow + J.i0; J.qstride = 1; J.qmask = 31; J.krow0 = brow; J.kstride = 1;
                    J.u_begin = (J.i0 - 128) > 0 ? (J.i0 - 128) : 0; J.ntiles = (J.i0 + 32 - J.u_begin) / 32; }
                gtab = tabB + (p * 12 + hd) * TABW;
            } else {
                const int jid = w + 8 * jj, g = jid >> 2, qt = jid & 3; hd = hk * 4 + g; mode = 0; maxoff = 127;
                J.q = qkv + C_QA + hd * 64; J.k = qkv + C_KA + hk * 64; J.v = qkv + C_VA + hk * 64; J.m_init = F.in[I_SINK][hd] * LOG2E; J.l_init = 1.0f;
                J.i0 = qblk * 128 + 32 * qt; J.qrow0 = brow + J.i0; J.qstride = 1; J.qmask = 31; J.krow0 = brow; J.kstride = 1;
                J.u_begin = (J.i0 - 128) > 0 ? (J.i0 - 128) : 0; J.ntiles = (J.i0 + 32 - J.u_begin) / 32;
                gtab = tabA + hd * TABW;
            }
            fill_tab(tab, gtab, maxoff, lane);
            f32x16 O[2]; float mm, ll;
            attn_job<64, true, true>(J, tab, vst, lane, O, mm, ll);
            if (mode == 0) {
                store_o_global<2>(O, 1.0f / ll, oa + (size_t)(brow + J.i0 + q) * AW + hd * 64, h);
            } else if (mode == 1) {
                if (q < nvalid) {
                    const float inv_l = 1.0f / ll; const int qs = qs0 + qsm * q;
                    LAS unsigned char* op = OB + ((p - 1) * 256 + qs) * 128;
#pragma unroll
                    for (int dt = 0; dt < 2; ++dt)
#pragma unroll
                        for (int g = 0; g < 4; ++g) { v2u wv; wv.x = pg8::cvt_pk_bf16(O[dt][4 * g] * inv_l, O[dt][4 * g + 1] * inv_l); wv.y = pg8::cvt_pk_bf16(O[dt][4 * g + 2] * inv_l, O[dt][4 * g + 3] * inv_l);
                            *(LAS v2u*)(op + (32 * dt + 8 * g + 4 * h) * 2) = wv; }
                    if (h == 0) LSE[(p - 1) * 256 + qs] = mm + __builtin_amdgcn_logf(ll);
                }
            } else {
                const int qs = 32 * w + q;
                const float l0 = mm + __builtin_amdgcn_logf(ll), l1 = LSE[qs], l2 = LSE[256 + qs];
                const float mx = fmaxf(l0, fmaxf(l1, l2)), w0 = fast_exp2(l0 - mx), w1 = fast_exp2(l1 - mx), w2 = fast_exp2(l2 - mx), inv = 1.0f / (w0 + w1 + w2);
                const float c0 = w0 * inv / ll, c1 = w1 * inv, c2 = w2 * inv;
                bf16* rowp = ob + (size_t)(brow + J.i0 + q) * BW + hd * 64;
#pragma unroll
                for (int dt = 0; dt < 2; ++dt)
#pragma unroll
                    for (int g = 0; g < 4; ++g) { const int d = 32 * dt + 8 * g + 4 * h;
                        const v2u a = *(const LAS v2u*)(OB + (qs) * 128 + d * 2), c = *(const LAS v2u*)(OB + (256 + qs) * 128 + d * 2);
                        const float r0 = c0 * O[dt][4 * g] + c1 * bf_lo(a.x) + c2 * bf_lo(c.x), r1 = c0 * O[dt][4 * g + 1] + c1 * bf_hi(a.x) + c2 * bf_hi(c.x);
                        const float r2 = c0 * O[dt][4 * g + 2] + c1 * bf_lo(a.y) + c2 * bf_lo(c.y), r3 = c0 * O[dt][4 * g + 3] + c1 * bf_hi(a.y) + c2 * bf_hi(c.y);
                        v2u wv; wv.x = pg8::cvt_pk_bf16(r0, r1); wv.y = pg8::cvt_pk_bf16(r2, r3); *(v2u*)(rowp + d) = wv; }
            }
        }
        if (isB) __syncthreads();
    }
}

__device__ __forceinline__ void p6_cross_attention(Frame& F) {
    const bf16* qx = (const bf16*)(F.ws + WS_QX); const bf16* kvx = (const bf16*)(F.ws + WS_KVX); bf16* ox = (bf16*)(F.ws + WS_OX);
    LAS unsigned char* vst = F.lds + ATT_V_OFF + F.wave * ATT_V_WAVE128;
    const int lane = F.lane, q = lane & 31, h = lane >> 5;
    for (int jid = F.vcu * NWAVES + F.wave; jid < BATCH * 4 * 256; jid += F.G * NWAVES) {
        const int b = jid / 1024, hd = (jid / 256) % 4, qt = jid % 256;
        AttnJob J; J.q = qx + hd * 128; J.ldq = XW; J.qrow0 = (long)b * SEQ + 32 * qt; J.qstride = 1; J.qmask = 31;
        J.k = kvx + hd * 128; J.v = kvx + XW + hd * 128; J.ldkv = 2 * XW; J.krow0 = (long)b * MEML; J.kstride = 1; J.i0 = 0; J.u_begin = 0; J.ntiles = MEML / 32; J.m_init = NEGBIG; J.l_init = 0.f;
        f32x16 O[4]; float mm, ll;
        attn_job<128, false, false>(J, nullptr, vst, lane, O, mm, ll);
        store_o_global<4>(O, 1.0f / ll, ox + (size_t)(J.qrow0 + q) * XW + hd * 128, h);
    }
}

constexpr int RT_XS_OFF = 0, RT_XS_STRIDE = 257;
constexpr int RT_LG_OFF = 66048;
constexpr int RT_GP_OFF = RT_LG_OFF + 10240;
constexpr int RT_SS_OFF = RT_GP_OFF + 8192;
constexpr int RT_CNT_OFF = RT_SS_OFF + 2048;
__device__ __forceinline__ void p8_router(Frame& F) {
    const float* x2 = (const float*)(F.ws + WS_X1); bf16* hm = (bf16*)(F.ws + WS_HM);
    const float* gm = F.in[I_GMOE]; const float* wrg = F.in[I_WRG]; const float* wre = F.in[I_WRE];
    int* tok_e = (int*)(F.ws + WS_ROUTE + RT_E); float* tok_w = (float*)(F.ws + WS_ROUTE + RT_W); int* tok_slot = (int*)(F.ws + WS_ROUTE + RT_SLOT); float* rstd2 = (float*)(F.ws + WS_ROUTE + RT_RSTD);
    unsigned* gcnt = (unsigned*)(F.ctl + CW_CNT);
    LAS float* xs = (LAS float*)(F.lds + RT_XS_OFF); LAS float* lg = (LAS float*)(F.lds + RT_LG_OFF); LAS float* gp = (LAS float*)(F.lds + RT_GP_OFF); LAS float* ssp = (LAS float*)(F.lds + RT_SS_OFF);
    LAS int* cnt = (LAS int*)(F.lds + RT_CNT_OFF); LAS int* cbase = cnt + 32;
    const int tid = F.tid, lane = F.lane, w = F.wave;
    for (int blk = F.vcu; blk < M / 64; blk += F.G) {
        const int r0 = blk * 64;
        float ae[4] = {0.f, 0.f, 0.f, 0.f}, ag[4] = {0.f, 0.f, 0.f, 0.f}; float ssq[8];
#pragma unroll
        for (int i = 0; i < 8; ++i) ssq[i] = 0.f;
        if (tid < 32) cnt[tid] = 0;
#pragma unroll 1
        for (int ch = 0; ch < 8; ++ch) {
            __syncthreads();
            const f32x4 gv = *(const f32x4*)(gm + 256 * ch + 4 * lane);
#pragma unroll
            for (int i = 0; i < 8; ++i) { const int row = w + 8 * i; const size_t goff = (size_t)(r0 + row) * D + 256 * ch + 4 * lane;
                const f32x4 v = *(const f32x4*)(x2 + goff); ssq[i] += (v[0] * v[0] + v[1] * v[1]) + (v[2] * v[2] + v[3] * v[3]);
                const f32x4 vg = v * gv; LAS float* d = xs + row * RT_XS_STRIDE + 4 * lane; d[0] = vg[0]; d[1] = vg[1]; d[2] = vg[2]; d[3] = vg[3];
                v2u pk; pk.x = pk2(vg[0], vg[1]); pk.y = pk2(vg[2], vg[3]); *(v2u*)(hm + goff) = pk; }
            __syncthreads();
            const LAS float* xr = xs + lane * RT_XS_STRIDE;
            const float* wr_ = wre + (size_t)(256 * ch) * 32 + 4 * w; const float* wg_ = wrg + (size_t)(256 * ch) * 4;
            if (ch == w) {
#pragma unroll 4
                for (int k = 0; k < 256; ++k) { const float xv = xr[k]; const f32x4 we = *(const f32x4*)(wr_ + k * 32), wgv = *(const f32x4*)(wg_ + k * 4);
                    ae[0] += xv * we[0]; ae[1] += xv * we[1]; ae[2] += xv * we[2]; ae[3] += xv * we[3]; ag[0] += xv * wgv[0]; ag[1] += xv * wgv[1]; ag[2] += xv * wgv[2]; ag[3] += xv * wgv[3]; }
            } else {
#pragma unroll 4
                for (int k = 0; k < 256; ++k) { const float xv = xr[k]; const f32x4 we = *(const f32x4*)(wr_ + k * 32);
                    ae[0] += xv * we[0]; ae[1] += xv * we[1]; ae[2] += xv * we[2]; ae[3] += xv * we[3]; }
            }
        }
#pragma unroll
        for (int j = 0; j < 4; ++j) { lg[lane * 40 + 4 * w + j] = ae[j]; gp[(w * 64 + lane) * 4 + j] = ag[j]; }
#pragma unroll
        for (int i = 0; i < 8; ++i) { const float s = wave_sum(ssq[i]); if (lane == 0) ssp[(w + 8 * i)] = s; }
        __syncthreads();
        int e0 = 0, e1 = 0; float gw0 = 0.f, gw1 = 0.f;
        if (tid < 64) {
            const int row = tid; const float rs = 1.0f / sqrtf(ssp[row] * (1.0f / D) + EPS);
            float gl[4];
#pragma unroll
            for (int j = 0; j < 4; ++j) { float s = 0.f;
#pragma unroll
                for (int ww = 0; ww < 8; ++ww) s += gp[(ww * 64 + row) * 4 + j];
                gl[j] = s * rs; }
            int gi = 0; float gmx = gl[0];
#pragma unroll
            for (int j = 1; j < 4; ++j) if (gl[j] > gmx) { gmx = gl[j]; gi = j; }
            float gden = 0.f;
#pragma unroll
            for (int j = 0; j < 4; ++j) gden += expf(gl[j] - gmx);
            const float ggate = 1.0f / gden;
            float el[8];
#pragma unroll
            for (int j = 0; j < 8; ++j) el[j] = lg[row * 40 + gi * 8 + j] * rs;
            int i0 = 0; float v0 = el[0];
#pragma unroll
            for (int j = 1; j < 8; ++j) if (el[j] > v0) { v0 = el[j]; i0 = j; }
            int i1 = -1; float v1 = -3.0e38f;
#pragma unroll
            for (int j = 0; j < 8; ++j) if (j != i0 && el[j] > v1) { v1 = el[j]; i1 = j; }
            const float p1 = expf(v1 - v0), den = 1.0f + p1;
            gw0 = ggate / den; gw1 = ggate * p1 / den; e0 = gi * 8 + i0; e1 = gi * 8 + i1;
            rstd2[r0 + row] = rs;
        }
        int s0 = 0, s1 = 0;
        if (tid < 64) { s0 = __hip_atomic_fetch_add(&cnt[e0], 1, __ATOMIC_RELAXED, __HIP_MEMORY_SCOPE_WORKGROUP); s1 = __hip_atomic_fetch_add(&cnt[e1], 1, __ATOMIC_RELAXED, __HIP_MEMORY_SCOPE_WORKGROUP); }
        __syncthreads();
        if (tid < 32) cbase[tid] = (int)__hip_atomic_fetch_add(&gcnt[tid], (unsigned)cnt[tid], __ATOMIC_RELAXED, __HIP_MEMORY_SCOPE_AGENT);
        __syncthreads();
        if (tid < 64) { const int t = r0 + tid;
            tok_e[2 * t] = e0; tok_e[2 * t + 1] = e1; tok_w[2 * t] = gw0; tok_w[2 * t + 1] = gw1; tok_slot[2 * t] = cbase[e0] + s0; tok_slot[2 * t + 1] = cbase[e1] + s1; }
    }
}

__device__ __forceinline__ int build_panels(Frame& F, LAS int* pexp, LAS int* pstart) {
    if (F.tid == 0) {
        const unsigned* gcnt = (const unsigned*)(F.ctl + CW_CNT); int row = 0, np = 0;
        for (int e = 0; e < NEXP; ++e) { const int c = (int)__hip_atomic_load(gcnt + e, __ATOMIC_RELAXED, __HIP_MEMORY_SCOPE_AGENT); pstart[e] = row; const int npan = (c + 255) / 256;
            for (int j = 0; j < npan; ++j) pexp[np + j] = e; np += npan; row += npan * 256; }
        pstart[NEXP] = np;
    }
    __syncthreads();
    return pstart[NEXP];
}

__device__ __forceinline__ void p9_gather(Frame& F) {
    LAS int* pexp = (LAS int*)(F.lds + PEXP_OFF); LAS int* pstart = pexp + MAXPANEL;
    build_panels(F, pexp, pstart);
    const int* tok_e = (const int*)(F.ws + WS_ROUTE + RT_E); const int* tok_slot = (const int*)(F.ws + WS_ROUTE + RT_SLOT); int* tok_dest = (int*)(F.ws + WS_ROUTE + RT_DEST);
    const float* rstd2 = (const float*)(F.ws + WS_ROUTE + RT_RSTD); float* rsort = (float*)(F.ws + WS_ROUTE + RT_RSORT);
    const bf16* hm = (const bf16*)(F.ws + WS_HM); bf16* as = (bf16*)(F.ws + WS_AS);
    for (int a = F.vcu * NWAVES + F.wave; a < 2 * M; a += F.G * NWAVES) {
        const int t = a >> 1, e = tok_e[a], dest = pstart[e] + tok_slot[a];
        if (F.lane == 0) { tok_dest[a] = dest; rsort[dest] = rstd2[t]; }
        const v4u* src = (const v4u*)(hm + (size_t)t * D) + F.lane; v4u* dst = (v4u*)(as + (size_t)dest * D) + F.lane;
#pragma unroll
        for (int j = 0; j < 4; ++j) dst[64 * j] = src[64 * j];
    }
}

struct MoeOrder {
    int npanel, ntile, G, c; const LAS int* pexp;
    __device__ __forceinline__ bool next(int i, pg8::Unit& u) const { const long L = (long)i * G + c; if (L >= (long)npanel * ntile) return false; const int pm = (int)(L / ntile), j = (int)(L % ntile); u.pm = pm; u.pn = pexp[pm] * ntile + j; return true; }
    __device__ __forceinline__ void a_ready(const pg8::Unit&) const {}
    __device__ __forceinline__ void done(const pg8::Unit&) const {}
};

template <bool MOE> __device__ __forceinline__ void p12_final(Frame& F, const float* x2, const bf16* tap = nullptr, int tap_ld = 0, int tap_cols = 0) { const bf16* y = (const bf16*)(F.ws + WS_Y);
    const int* tok_dest = (const int*)(F.ws + WS_ROUTE + RT_DEST); const float* tok_w = (const float*)(F.ws + WS_ROUTE + RT_W);
    const float* gf = F.in[I_GFIN];
    for (int t = F.vcu * NWAVES + F.wave; t < M; t += F.G * NWAVES) {
        int d0 = 0, d1 = 0; float w0 = 0.f, w1 = 0.f; if (MOE) { d0 = tok_dest[2 * t]; d1 = tok_dest[2 * t + 1]; w0 = tok_w[2 * t]; w1 = tok_w[2 * t + 1]; }
        const f32x4* xr = (const f32x4*)(x2 + (size_t)t * D) + F.lane; const v2u* y0 = (const v2u*)(y + (size_t)d0 * D) + F.lane; const v2u* y1 = (const v2u*)(y + (size_t)d1 * D) + F.lane;
        f32x4 v[8]; float s = 0.f;
#pragma unroll
        for (int j = 0; j < 8; ++j) { f32x4 xv = xr[64 * j]; if (MOE) { const v2u a = y0[64 * j], b = y1[64 * j];
            xv[0] += w0 * bf_lo(a.x) + w1 * bf_lo(b.x); xv[1] += w0 * bf_hi(a.x) + w1 * bf_hi(b.x); xv[2] += w0 * bf_lo(a.y) + w1 * bf_lo(b.y); xv[3] += w0 * bf_hi(a.y) + w1 * bf_hi(b.y); }
            if (tap) { const int col = 4 * (F.lane + 64 * j); if (col < tap_cols) { const v2u a = *(const v2u*)(tap + (size_t)t * tap_ld + col); xv[0] += bf_lo(a.x); xv[1] += bf_hi(a.x); xv[2] += bf_lo(a.y); xv[3] += bf_hi(a.y); } }
            v[j] = xv; s += (xv[0] * xv[0] + xv[1] * xv[1]) + (xv[2] * xv[2] + xv[3] * xv[3]); }
        const float rstd = 1.0f / sqrtf(wave_sum(s) * (1.0f / D) + EPS);
        f32x4* orow = (f32x4*)(F.out + (size_t)t * D) + F.lane; const f32x4* gr = (const f32x4*)gf + F.lane;
#pragma unroll
        for (int j = 0; j < 8; ++j) orow[64 * j] = v[j] * rstd * gr[64 * j];
    }
}

#ifndef MK_PER_PHASE
#define MK_PER_PHASE 0
#endif
#ifndef MK_STOP_AFTER
#define MK_STOP_AFTER 11
#endif
#ifndef MK_REPEAT_MASK
#define MK_REPEAT_MASK 0
#endif
#ifndef MK_RT_PROBE
#define MK_RT_PROBE 0
#endif
#if MK_RT_PROBE
#define MK_REPS(k) (1 + ((rep_mask >> (k)) & 1))
#else
#define MK_REPS(k) (1 + ((MK_REPEAT_MASK >> (k)) & 1))
#endif
constexpr int NPHASE = 13;
struct Args { const float* in[24]; float* out; unsigned char* ws; int ph_lo, ph_hi, rep_mask, pad; };
static_assert(sizeof(Args) == 26 * 8 + 16, "Args has no padding");

__global__ void __launch_bounds__(NWAVES * 64, 2) mega_fwd(Args args) {
    extern __shared__ __attribute__((aligned(16))) unsigned char lds[];
    Frame F;
    F.lds = (LAS unsigned char*)lds;
    F.MISC = (volatile LAS unsigned*)(F.lds + MISC_OFF);
    F.tid = threadIdx.x; F.lane = F.tid & 63; F.wave = __builtin_amdgcn_readfirstlane(F.tid >> 6);
    F.G = gridDim.x; { const int bx = blockIdx.x; F.vcu = (F.G % 8 == 0) ? (bx % 8) * (F.G / 8) + bx / 8 : bx; }
    F.ws = args.ws; F.ctl = (gu32*)(args.ws + WS_CTL); F.out = args.out;
#pragma unroll
    for (int i = 0; i < 24; ++i) F.in[i] = args.in[i];
    if (F.tid < 64) F.MISC[F.tid] = 0u;
    __syncthreads();
    const int lo = args.ph_lo, hi = args.ph_hi; const int rep_mask = __builtin_amdgcn_readfirstlane(args.rep_mask); (void)rep_mask;
    XcdBarrier bar; bar.bar = (unsigned*)(F.ctl + CW_BAR); bar.x = 0; bar.st = nullptr;
    if (hi - lo > 1) bar = xcd_barrier_post((unsigned*)(F.ctl + CW_BAR), F.MISC + 8);
#define IN(k) (lo <= (k) && (k) < hi && ((k) <= MK_STOP_AFTER || (k) == 12))
#define INR(k) (lo <= (k) && (k) < hi)
#define SEAM(k) do { if (INR(k) && INR((k) + 1) && (k) <= MK_STOP_AFTER) xcd_barrier(bar); } while (0)
    LAS unsigned char* ring = F.lds + RING_OFF;
    LAS int* pexp = (LAS int*)(F.lds + PEXP_OFF); LAS int* pstart = pexp + MAXPANEL;

    for (int rep_ = 0; rep_ < MK_REPS(0); ++rep_) { if (rep_) xcd_barrier(bar); if (IN(0)) { p0_prologue(F); } } SEAM(0);

    for (int rep_ = 0; rep_ < MK_REPS(1); ++rep_) { if (rep_) xcd_barrier(bar); if (IN(1)) {
        pg8::Gemm g{(const bf16*)(F.ws + WS_H), (const bf16*)(F.ws + WS_BT1), M, NB1, D}; pg8::StaticOrder S; S.init(M, NB1, F.G, (int)blockIdx.x);
        EpiQKVG E{(bf16*)(F.ws + WS_QKV), (bf16*)(F.ws + WS_GA), (bf16*)(F.ws + WS_GB), F.in[I_BGATE]};
        pg8::gemm_phase<EpiQKVG, pg8::StaticOrder, true, true>(ring, g, S, E);
    } } SEAM(1);

    for (int rep_ = 0; rep_ < MK_REPS(2); ++rep_) { if (rep_) xcd_barrier(bar); if (IN(2)) { p2_attention(F); } } SEAM(2);

    for (int rep_ = 0; rep_ < MK_REPS(3); ++rep_) { if (rep_) xcd_barrier(bar); if (IN(3)) {
        { pg8::Gemm g{(const bf16*)(F.ws + WS_OA), (const bf16*)(F.ws + WS_WA), M, D, AW}; pg8::StaticOrder S; S.init(M, D, F.G, (int)blockIdx.x);
          EpiGate<0> E{(bf16*)(F.ws + WS_GA), (const bf16*)(F.ws + WS_GB)};
          pg8::gemm_phase<EpiGate<0>, pg8::StaticOrder, true, true>(ring, g, S, E); }
        VM_WAIT();
        { pg8::Gemm g{(const bf16*)(F.ws + WS_OB), (const bf16*)(F.ws + WS_WB), M, D, BW}; pg8::StaticOrder S; S.init(M, D, F.G, (int)blockIdx.x);
          EpiGate<1> E{(bf16*)(F.ws + WS_GA), (const bf16*)(F.ws + WS_GB)};
          pg8::gemm_phase<EpiGate<1>, pg8::StaticOrder, true, true>(ring, g, S, E); }
    } } SEAM(3);

    for (int rep_ = 0; rep_ < MK_REPS(4); ++rep_) { if (rep_) xcd_barrier(bar); if (IN(4)) {
        pg8::Gemm g{(const bf16*)(F.ws + WS_GA), (const bf16*)(F.ws + WS_WO), M, D, D}; pg8::StaticOrder S; S.init(M, D, F.G, (int)blockIdx.x);
        EpiResid E{F.in[I_X], (float*)(F.ws + WS_X1), (bf16*)(F.ws + WS_XG), F.in[I_GX], (float*)(F.ws + WS_SSQ)};
        pg8::gemm_phase<EpiResid, pg8::StaticOrder, true, true>(ring, g, S, E);
    } } SEAM(4);

    for (int rep_ = 0; rep_ < MK_REPS(5); ++rep_) { if (rep_) xcd_barrier(bar); if (IN(5)) {
        if (blockIdx.x < 128) {
            pg8::Gemm g{(const bf16*)(F.ws + WS_XG), (const bf16*)(F.ws + WS_WXQ), M, XW, D}; pg8::StaticOrder S; S.init(M, XW, 128, (int)blockIdx.x);
            EpiQx E{(bf16*)(F.ws + WS_QX), (const float*)(F.ws + WS_SSQ), 0.08838834764831845f};
            pg8::gemm_phase<EpiQx, pg8::StaticOrder, true, true>(ring, g, S, E);
        } else if (blockIdx.x < 136) {
            pg8::Gemm g{(const bf16*)(F.ws + WS_MEMN), (const bf16*)(F.ws + WS_WXKV), BATCH * MEML, 2 * XW, D}; pg8::StaticOrder S; S.init(BATCH * MEML, 2 * XW, 8, (int)blockIdx.x - 128);
            EpiBf E{(bf16*)(F.ws + WS_KVX), 2 * XW, 1024};
            pg8::gemm_phase<EpiBf, pg8::StaticOrder, true, true>(ring, g, S, E);
        }
    } } SEAM(5);

    for (int rep_ = 0; rep_ < MK_REPS(6); ++rep_) { if (rep_) xcd_barrier(bar); if (IN(6)) { p6_cross_attention(F); } } SEAM(6);

    for (int rep_ = 0; rep_ < MK_REPS(7); ++rep_) { if (rep_) xcd_barrier(bar); if (IN(7)) {
        pg8::Gemm g{(const bf16*)(F.ws + WS_OX), (const bf16*)(F.ws + WS_WXO), M, D, XW}; pg8::StaticOrder S; S.init(M, D, F.G, (int)blockIdx.x);
        EpiResid2 E{(float*)(F.ws + WS_X1)};
        pg8::gemm_phase<EpiResid2, pg8::StaticOrder, true, true>(ring, g, S, E);
    } } SEAM(7);

    for (int rep_ = 0; rep_ < MK_REPS(8); ++rep_) { if (rep_) xcd_barrier(bar); if (IN(8)) { p8_router(F); } } SEAM(8);
    for (int rep_ = 0; rep_ < MK_REPS(9); ++rep_) { if (rep_) xcd_barrier(bar); if (IN(9)) { p9_gather(F); } } SEAM(9);

    for (int rep_ = 0; rep_ < MK_REPS(10); ++rep_) { if (rep_) xcd_barrier(bar); if (IN(10)) {
        const int np = build_panels(F, pexp, pstart);
        pg8::Gemm g{(const bf16*)(F.ws + WS_AS), (const bf16*)(F.ws + WS_W13), MAXPANEL * 256, NEXP * 1024, D}; MoeOrder S{np, 4, F.G, F.vcu, pexp};
        EpiSwiGLU E{(bf16*)(F.ws + WS_ACT), (const float*)(F.ws + WS_ROUTE + RT_RSORT)};
        pg8::gemm_phase<EpiSwiGLU, MoeOrder, true, true>(ring, g, S, E);
    } } SEAM(10);

    for (int rep_ = 0; rep_ < MK_REPS(11); ++rep_) { if (rep_) xcd_barrier(bar); if (IN(11)) {
        const int np = build_panels(F, pexp, pstart);
        pg8::Gemm g{(const bf16*)(F.ws + WS_ACT), (const bf16*)(F.ws + WS_W2), MAXPANEL * 256, NEXP * 2048, DFF}; MoeOrder S{np, 8, F.G, F.vcu, pexp};
        EpiBf E{(bf16*)(F.ws + WS_Y), D, 8};
        pg8::gemm_phase<EpiBf, MoeOrder, true, true>(ring, g, S, E);
    } } SEAM(11);

#ifdef MK_TAP
    for (int rep_ = 0; rep_ < MK_REPS(12); ++rep_) { if (rep_) xcd_barrier(bar); if (IN(12)) { p12_final<false>(F, F.in[I_X], (const bf16*)(F.ws + (MK_TAP_OFF)), MK_TAP_LD, MK_TAP_COLS); } }
#else
    for (int rep_ = 0; rep_ < MK_REPS(12); ++rep_) { if (rep_) xcd_barrier(bar); if (IN(12)) { p12_final<(MK_STOP_AFTER >= 11)>(F, (MK_STOP_AFTER >= 4) ? (const float*)(F.ws + WS_X1) : F.in[I_X]); } }
#endif
#undef IN
#undef INR
#undef SEAM
}

extern "C" void kernel_launch(void* const* d_in, const int* in_sizes, int n_in, void* d_out, int out_size, void* d_ws, size_t ws_size, hipStream_t stream) {
    static int grid = 0;
    if (grid == 0) {
        if (n_in != 24 || in_sizes[0] != M * D || out_size != M * D || ws_size < WS_END) { fprintf(stderr, "kernel_launch: unexpected shapes or workspace (%d inputs, ws %zu, need %zu); nothing launched\n", n_in, ws_size, (size_t)WS_END); grid = -1; return; }
        int dev = 0, cus = 0, per_cu = 0;
        if (hipGetDevice(&dev) != hipSuccess || hipDeviceGetAttribute(&cus, hipDeviceAttributeMultiprocessorCount, dev) != hipSuccess) { grid = -1; return; }
        if (hipFuncSetAttribute((const void*)mega_fwd, hipFuncAttributeMaxDynamicSharedMemorySize, LDS_BYTES) != hipSuccess) { fprintf(stderr, "kernel_launch: hipFuncSetAttribute failed\n"); grid = -1; return; }
        if (hipOccupancyMaxActiveBlocksPerMultiprocessor(&per_cu, (const void*)mega_fwd, NWAVES * 64, LDS_BYTES) != hipSuccess || per_cu < 1) { fprintf(stderr, "kernel_launch: occupancy query reports %d workgroups per CU\n", per_cu); }
        (void)hipGetLastError();
        grid = cus;
    }
    if (grid < 0) return;
    if (hipMemsetAsync((char*)d_ws + WS_CTL, 0, CTL_ZERO_BYTES, stream) != hipSuccess) return;
    Args a{};
    for (int i = 0; i < 24; ++i) a.in[i] = (const float*)d_in[i];
    a.out = (float*)d_out; a.ws = (unsigned char*)d_ws; a.rep_mask = MK_REPEAT_MASK; a.pad = 0;
#if MK_PER_PHASE
    for (int p = 0; p < NPHASE; ++p) { if (p > MK_STOP_AFTER && p != 12) continue; a.ph_lo = p; a.ph_hi = p + 1; hipLaunchKernelGGL(mega_fwd, dim3(grid), dim3(NWAVES * 64), LDS_BYTES, stream, a); }
#else
    a.ph_lo = 0; a.ph_hi = NPHASE;
    hipLaunchKernelGGL(mega_fwd, dim3(grid), dim3(NWAVES * 64), LDS_BYTES, stream, a);
#endif
}
```

```cpp
#include <hip/hip_runtime.h>
#include <cstdio>
#include <cstdint>
namespace pg8 {
#define PG8_LAS __attribute__((address_space(3)))
typedef unsigned short bf16_t;
typedef short bf16x8 __attribute__((ext_vector_type(8)));
typedef float f32x4 __attribute__((ext_vector_type(4)));
typedef unsigned u32x4 __attribute__((ext_vector_type(4)));
constexpr int BM = 256, BK = 64, HALF = 128, HTB = HALF * BK * 2  , STAGE_BYTES = 8 * HTB, NXCD = 8, WGM = 8;

__host__ __device__ __forceinline__ int lds_byte(int r, int c) { const int st = (r >> 4) * 2 + (c >> 5), rr = r & 15, cc = c & 31, ob = rr * 64 + cc * 2; return st * 1024 + (ob ^ (((ob >> 9) & 1) << 5)); }
__host__ __device__ __forceinline__ void stage_rc(int b, int& R, int& C) { const int st = b / 1024, sb = b % 1024, swz = sb ^ (((sb >> 9) & 1) << 5); R = (st >> 1) * 16 + swz / 64; C = (st & 1) * 32 + (swz % 64) / 2; }
__host__ __device__ __forceinline__ int perm32(int rho) { const int n = rho >> 4, i = rho & 15; return 8 * (i >> 2) + 4 * n + (i & 3); }

struct Unit { int pm, pn; };
struct Gemm { const bf16_t* A; const bf16_t* Bt; int M, N, K; };

struct StaticOrder {
    int nM, nN, nwg, G, c;
    __host__ __device__ void init(int M, int N, int G_, int c_) { nM = M / BM; nN = N / BM; nwg = nM * nN; G = G_; c = c_; }
    __host__ __device__ __forceinline__ bool next(int i, Unit& u) const {
        const long L = (long)i * G + c; if (L >= nwg) return false;
        int wgid = (int)L; { const int q = nwg / NXCD, r = nwg % NXCD, xcd = wgid % NXCD, off = wgid / NXCD; wgid = (xcd < r ? xcd * (q + 1) : r * (q + 1) + (xcd - r) * q) + off; }
        const int nig = WGM * nN, gid = wgid / nig, fm = gid * WGM, gsz = (nM - fm) < WGM ? (nM - fm) : WGM;
        u.pm = fm + ((wgid % nig) % gsz); u.pn = (wgid % nig) / gsz; return true;
    }
    __device__ __forceinline__ void a_ready(const Unit&) const {}
    __device__ __forceinline__ void done(const Unit&) const {}
};

typedef __bf16 bf16x2_t __attribute__((ext_vector_type(2)));
__device__ __forceinline__ unsigned cvt_pk_bf16(float lo, float hi) { bf16x2_t v = {(__bf16)lo, (__bf16)hi}; return __builtin_bit_cast(unsigned, v); }
template <class Epi, class Sched, bool ALIGN_EPI = false, bool SP2 = false, int GATHER = 0  , bool FP8 = false, int LDA = 0  , int LDB = 0  >
__device__ __forceinline__ void gemm_phase(PG8_LAS unsigned char* lds, const Gemm g, const Sched& S, const Epi& E, const int* gidx = nullptr) {
    int tid_o = threadIdx.x; asm volatile("" : "+v"(tid_o));
    const int tid = tid_o, wid = __builtin_amdgcn_readfirstlane(tid >> 6), lane = tid & 63, wr = wid >> 2, wc = wid & 3, fr = lane & 15, fq = lane >> 4;
    const int K = g.K, nt = K / BK;
    unsigned voffA[2], voffB[2]; unsigned vAc[2][2] = {{0u, 0u}, {0u, 0u}};
#pragma unroll
    for (int i = 0; i < 2; ++i) { int R, C; stage_rc(tid * 16 + i * 8192, R, C); const int Rb = Epi::PERM ? ((R & ~31) + perm32(R & 31)) : R;
        voffA[i] = (unsigned)(R * (LDA ? LDA : K) + C) * 2u; voffB[i] = (unsigned)(Rb * (LDB ? LDB : K) + C) * 2u; }
    const size_t kstep = (size_t)(BK * 2);
    const size_t hstep = (size_t)HALF * K * 2;
    const size_t tstep = 2 * hstep;
    const size_t hstepA = LDA ? (size_t)HALF * LDA * 2 : hstep, tstepA = 2 * hstepA;
    const size_t hstepB = LDB ? (size_t)HALF * LDB * 2 : hstep, tstepB = 2 * hstepB;
    const unsigned ldsw = (unsigned)wid * 1024u;
    const int aoff = lds_byte(wr * 64 + fr, fq * 8), boff = lds_byte(wc * 32 + fr, fq * 8);
#define PG8_SA(b, h) (((b) * 2 + (h)) * HTB)
#define PG8_SB(b, h) ((4 + (b) * 2 + (h)) * HTB)
#define PG8_STAGE(bufoff, gbase, voff) do { _Pragma("unroll") for (int _i = 0; _i < 2; ++_i) \
        __builtin_amdgcn_global_load_lds((const unsigned*)((const char*)(gbase) + (voff)[_i]), (PG8_LAS unsigned*)(lds + (bufoff) + ldsw + _i * 8192), 16, 0, 0); } while (0)
#define PG8_STAGE_A(bufoff, gbase, half, usenext) do { if constexpr (GATHER != 0) { PG8_STAGE(bufoff, gbase, vAc[half]); } \
        else { PG8_STAGE(bufoff, (gbase) + ((half) ? hstepA : (size_t)0), voffA); } } while (0)
#define PG8_GIDX(dst, unit) do { _Pragma("unroll") for (int h_ = 0; h_ < 2; ++h_) _Pragma("unroll") for (int i_ = 0; i_ < 2; ++i_) { int R_, C_; stage_rc(tid * 16 + i_ * 8192, R_, C_); const int row_ = (unit).pm * BM + h_ * HALF + R_; dst[h_][i_] = (unsigned)((GATHER == 2 ? row_ : gidx[row_]) * K + C_) * 2u; } } while (0)
#define PG8_LDA(dst, b, h) do { _Pragma("unroll") for (int m = 0; m < 4; ++m) _Pragma("unroll") for (int k = 0; k < 2; ++k) dst[m][k] = *(const PG8_LAS bf16x8*)(lds + PG8_SA(b, h) + aoff + m * 2048 + k * 1024); } while (0)
#define PG8_LDB(dst, b, h) do { _Pragma("unroll") for (int n = 0; n < 2; ++n) _Pragma("unroll") for (int k = 0; k < 2; ++k) dst[n][k] = *(const PG8_LAS bf16x8*)(lds + PG8_SB(b, h) + boff + n * 2048 + k * 1024); } while (0)
#define PG8_MMA(ai, bj, At, Bt) do { __builtin_amdgcn_s_setprio(1); _Pragma("unroll") for (int m = 0; m < 4; ++m) _Pragma("unroll") for (int n = 0; n < 2; ++n) { \
        if constexpr (FP8) { typedef int v4i_ __attribute__((ext_vector_type(4))); typedef int v8i_ __attribute__((ext_vector_type(8))); \
            const v8i_ b8_ = __builtin_shufflevector(__builtin_bit_cast(v4i_, Bt[n][0]), __builtin_bit_cast(v4i_, Bt[n][1]), 0, 1, 2, 3, 4, 5, 6, 7); \
            const v8i_ a8_ = __builtin_shufflevector(__builtin_bit_cast(v4i_, At[m][0]), __builtin_bit_cast(v4i_, At[m][1]), 0, 1, 2, 3, 4, 5, 6, 7); \
            acc[ai][bj][m][n] = __builtin_amdgcn_mfma_scale_f32_16x16x128_f8f6f4(b8_, a8_, acc[ai][bj][m][n], 0, 0, 0, 0, 0, 0); } \
        else { _Pragma("unroll") for (int k = 0; k < 2; ++k) acc[ai][bj][m][n] = __builtin_amdgcn_mfma_f32_16x16x32_bf16(Bt[n][k], At[m][k], acc[ai][bj][m][n], 0, 0, 0); } } \
        __builtin_amdgcn_s_setprio(0); } while (0)
#define PG8_WAIT_V(n) asm volatile("s_waitcnt vmcnt(" #n ")" ::: "memory")
#define PG8_WAIT_L(n) asm volatile("s_waitcnt lgkmcnt(" #n ")" ::: "memory")
#define PG8_BAR __builtin_amdgcn_s_barrier()
#define PG8_SCHED __builtin_amdgcn_sched_barrier(0)
    Unit cur, nxt; int ui = 0;
    if (!S.next(0, cur)) return;
    f32x4 acc[2][2][4][2];
#pragma unroll
    for (int a = 0; a < 2; ++a)
#pragma unroll
        for (int b = 0; b < 2; ++b)
#pragma unroll
            for (int m = 0; m < 4; ++m)
#pragma unroll
                for (int n = 0; n < 2; ++n) acc[a][b][m][n] = (f32x4){0.f, 0.f, 0.f, 0.f};
    bf16x8 At[4][2], B0[2][2], B1[2][2];
    const char* cA = (const char*)g.A + (GATHER != 0 ? (size_t)0 : (size_t)cur.pm * tstepA); const char* cB = (const char*)g.Bt + (size_t)cur.pn * tstepB;
    S.a_ready(cur);
    if constexpr (GATHER != 0) PG8_GIDX(vAc, cur);
    if constexpr (SP2) {
        PG8_STAGE(PG8_SB(0, 0), cB, voffB); PG8_STAGE(PG8_SB(0, 1), cB + hstepB, voffB); PG8_STAGE_A(PG8_SA(0, 0), cA, 0, false); PG8_STAGE_A(PG8_SA(0, 1), cA, 1, false);
        if (wr == 1) PG8_BAR;
        PG8_WAIT_V(2); PG8_BAR;
        PG8_STAGE(PG8_SB(1, 0), cB + kstep, voffB); PG8_STAGE_A(PG8_SA(1, 0), cA + kstep, 0, false); PG8_STAGE(PG8_SB(1, 1), cB + hstepB + kstep, voffB);
        PG8_WAIT_V(6); PG8_BAR;
    } else {
        PG8_STAGE(PG8_SB(0, 0), cB, voffB); PG8_STAGE_A(PG8_SA(0, 0), cA, 0, false); PG8_STAGE(PG8_SB(0, 1), cB + hstepB, voffB); PG8_STAGE_A(PG8_SA(0, 1), cA, 1, false);
        if (wr == 1) PG8_BAR;
        PG8_WAIT_V(4); PG8_BAR;
        PG8_STAGE(PG8_SB(1, 0), cB + kstep, voffB); PG8_STAGE_A(PG8_SA(1, 0), cA + kstep, 0, false); PG8_STAGE(PG8_SB(1, 1), cB + hstepB + kstep, voffB);
        PG8_WAIT_V(6); PG8_BAR;
    }
    for (;;) {
        const bool has_next = S.next(ui + 1, nxt);
        const char* nA = has_next ? (const char*)g.A + (GATHER != 0 ? (size_t)0 : (size_t)nxt.pm * tstepA) : cA; const char* nB = has_next ? (const char*)g.Bt + (size_t)nxt.pn * tstepB : cB;
#pragma unroll 1
        for (int t = 0; t < nt; t += 2) {
            const bool last = (t == nt - 2);
            const char* a1 = cA + (size_t)(t + 1) * kstep;
            const char* a2 = last ? nA : cA + (size_t)(t + 2) * kstep; const char* b2 = last ? nB : cB + (size_t)(t + 2) * kstep;
            const char* a3 = a2 + kstep; const char* b3 = b2 + kstep;
            if constexpr (Epi::HAS_MID) { if (t == Epi::MID_T) E.mid(acc, cur, wr, wc, fr, fq); }
            if (last && has_next) S.a_ready(nxt);
            if constexpr (SP2) {
            PG8_LDB(B0, 0, 0); PG8_LDB(B1, 0, 1); PG8_SCHED; PG8_LDA(At, 0, 0); PG8_STAGE_A(PG8_SA(1, 1), a1, 1, false);
            if constexpr (GATHER != 0) { if (last && has_next) PG8_GIDX(vAc, nxt); }
            PG8_WAIT_V(8); PG8_WAIT_L(0); PG8_BAR; PG8_MMA(0, 0, At, B0); PG8_MMA(0, 1, At, B1); PG8_BAR; PG8_SCHED;
            PG8_LDA(At, 0, 1); PG8_STAGE(PG8_SB(0, 0), b2, voffB); PG8_STAGE(PG8_SB(0, 1), b2 + hstepB, voffB); PG8_STAGE_A(PG8_SA(0, 0), a2, 0, last);
            PG8_WAIT_V(8); PG8_WAIT_L(0); PG8_BAR; PG8_MMA(1, 0, At, B0); PG8_MMA(1, 1, At, B1); PG8_BAR; PG8_SCHED;
            PG8_LDB(B0, 1, 0); PG8_LDB(B1, 1, 1); PG8_SCHED; PG8_LDA(At, 1, 0); PG8_STAGE_A(PG8_SA(0, 1), a2, 1, last);
            PG8_WAIT_V(8); PG8_WAIT_L(0); PG8_BAR; PG8_MMA(0, 0, At, B0); PG8_MMA(0, 1, At, B1); PG8_BAR; PG8_SCHED;
            PG8_LDA(At, 1, 1); PG8_STAGE(PG8_SB(1, 0), b3, voffB); PG8_STAGE(PG8_SB(1, 1), b3 + hstepB, voffB); PG8_STAGE_A(PG8_SA(1, 0), a3, 0, last);
            PG8_WAIT_V(8); PG8_WAIT_L(0); PG8_BAR; PG8_MMA(1, 0, At, B0); PG8_MMA(1, 1, At, B1); PG8_BAR; PG8_SCHED;
            } else {
            PG8_LDB(B0, 0, 0); PG8_SCHED; PG8_LDA(At, 0, 0); PG8_STAGE_A(PG8_SA(1, 1), a1, 1, false);
            PG8_WAIT_L(8); PG8_BAR; PG8_WAIT_L(0); PG8_MMA(0, 0, At, B0); PG8_BAR; PG8_SCHED;
            PG8_LDB(B1, 0, 1); PG8_STAGE(PG8_SB(0, 0), b2, voffB);
            PG8_BAR; PG8_WAIT_L(0); PG8_MMA(0, 1, At, B1); PG8_BAR;
            PG8_LDA(At, 0, 1); PG8_STAGE_A(PG8_SA(0, 0), a2, 0, last);
            PG8_BAR; PG8_WAIT_L(0); PG8_MMA(1, 0, At, B0); PG8_BAR; PG8_SCHED;
            PG8_STAGE(PG8_SB(0, 1), b2 + hstepB, voffB);
            PG8_WAIT_V(6); PG8_BAR; PG8_MMA(1, 1, At, B1); PG8_BAR;
            PG8_LDB(B0, 1, 0); PG8_SCHED; PG8_LDA(At, 1, 0); PG8_STAGE_A(PG8_SA(0, 1), a2, 1, last);
            PG8_WAIT_L(8); PG8_BAR; PG8_WAIT_L(0); PG8_MMA(0, 0, At, B0); PG8_BAR; PG8_SCHED;
            PG8_LDB(B1, 1, 1); PG8_STAGE(PG8_SB(1, 0), b3, voffB);
            PG8_BAR; PG8_WAIT_L(0); PG8_MMA(0, 1, At, B1); PG8_BAR;
            PG8_LDA(At, 1, 1); PG8_STAGE_A(PG8_SA(1, 0), a3, 0, last);
            PG8_BAR; PG8_WAIT_L(0); PG8_MMA(1, 0, At, B0); PG8_BAR; PG8_SCHED;
            PG8_STAGE(PG8_SB(1, 1), b3 + hstepB, voffB);
            PG8_WAIT_V(6); PG8_BAR; PG8_MMA(1, 1, At, B1); PG8_BAR;
            }
        }
        if constexpr (ALIGN_EPI) { if (wr == 0) PG8_BAR; }
        if constexpr (!Epi::AFTER_DRAIN) { E(acc, cur, wr, wc, fr, fq); S.done(cur); }
        if (!has_next) break;
#pragma unroll
        for (int a = 0; a < 2; ++a)
#pragma unroll
            for (int b = 0; b < 2; ++b)
#pragma unroll
                for (int m = 0; m < 4; ++m)
#pragma unroll
                    for (int n = 0; n < 2; ++n) acc[a][b][m][n] = (f32x4){0.f, 0.f, 0.f, 0.f};
        cur = nxt; cA = nA; cB = nB; ++ui;
        if constexpr (ALIGN_EPI) { if (wr == 1) PG8_BAR; }
    }
    PG8_WAIT_V(0);
    if constexpr (!ALIGN_EPI) { if (wr == 0) PG8_BAR; }
    PG8_BAR;
    if constexpr (Epi::AFTER_DRAIN) { E.fused(acc, cur, wr, wc, fr, fq, lds, wid, lane); S.done(cur); }
#undef PG8_SA
#undef PG8_SB
#undef PG8_STAGE
#undef PG8_STAGE_A
#undef PG8_GIDX
#undef PG8_LDA
#undef PG8_LDB
#undef PG8_MMA
#undef PG8_WAIT_V
#undef PG8_WAIT_L
#undef PG8_BAR
#undef PG8_SCHED
}
}

#define GAS __attribute__((address_space(1)))
#define LAS __attribute__((address_space(3)))
typedef unsigned short bf16;
typedef unsigned v4u __attribute__((ext_vector_type(4)));
typedef unsigned v2u __attribute__((ext_vector_type(2)));
typedef float f32x4 __attribute__((ext_vector_type(4)));
typedef float f32x16 __attribute__((ext_vector_type(16)));
typedef short s16x8 __attribute__((ext_vector_type(8)));
typedef short s16x4 __attribute__((ext_vector_type(4)));
typedef GAS unsigned gu32;

constexpr int NWAVES = 8;
constexpr int BATCH = 2, SEQ = 8192, D = 2048, M = BATCH * SEQ;
constexpr int NQKV = 3840, NGATE = 4096, NB1 = NQKV + NGATE;
constexpr int AW = 1024, BW = 768, XW = 512, MEML = 256, NEXP = 32, DFF = 512;
constexpr int C_QA = 0, C_KA = 1024, C_VA = 1280, C_QB = 1536, C_KB = 2304, C_VB = 3072;
constexpr int MAXPANEL = 160;
constexpr float EPS = 1e-6f, LOG2E = 1.4426950408889634f, NEGBIG = -1e30f;
constexpr int TABW = 256;

constexpr size_t MiB = 1u << 20;
constexpr size_t WS_CTL = 0, CTL_ZERO_BYTES = 128 * 1024;
constexpr size_t WS_TAB = 1 * MiB, WS_ROUTE = 2 * MiB, WS_MEMN = 4 * MiB, WS_SSQ = 6 * MiB;
constexpr size_t WS_WA = 8 * MiB, WS_WB = 12 * MiB, WS_WO = 15 * MiB, WS_WXQ = 23 * MiB, WS_WXKV = 25 * MiB, WS_WXO = 29 * MiB;
constexpr size_t WS_W13 = 31 * MiB, WS_W2 = 159 * MiB, WS_X1 = 223 * MiB, WS_QKV = WS_X1, WS_U = 351 * MiB, WS_ACT = 575 * MiB, WS_END = 615 * MiB;
constexpr size_t WS_BT1 = WS_U, WS_H = WS_U + 32 * MiB, WS_GA = WS_U + 96 * MiB, WS_GB = WS_U + 160 * MiB;
constexpr size_t WS_OA = WS_U, WS_OB = WS_U + 32 * MiB, WS_XG = WS_U, WS_QX = WS_U + 64 * MiB, WS_KVX = WS_U + 80 * MiB, WS_OX = WS_U + 82 * MiB;
constexpr size_t WS_MIX8 = WS_U + 64 * MiB;
constexpr size_t WS_HM = WS_U, WS_AS = WS_U + 64 * MiB, WS_Y = WS_AS;
constexpr size_t WS_KVP = WS_U + 32 * MiB, WS_QX2 = WS_U + 40 * MiB;
constexpr size_t WS_ATT2 = WS_U + 32 * MiB; constexpr size_t ATT2_UNIT = 65536 + 2048;
constexpr size_t WS_W3 = WS_WB;
constexpr size_t WS_PART = WS_U + 64 * MiB;
constexpr size_t RT_E = 0, RT_W = 128 * 1024, RT_SLOT = 256 * 1024, RT_DEST = 384 * 1024, RT_RSTD = 512 * 1024, RT_RSORT = 576 * 1024, RT_ROWTOK = 768 * 1024;
constexpr int CW_BAR = 4096, CW_CNT = 16384;

constexpr int RING_OFF = 0, RING_BYTES = 131072, LDS_BYTES = 163840, MISC_OFF = LDS_BYTES - 2048, PEXP_OFF = MISC_OFF + 256;

#define LDS_WAIT() asm volatile("s_waitcnt lgkmcnt(0)" ::: "memory")
#define VM_WAIT() asm volatile("s_waitcnt vmcnt(0)" ::: "memory")
__device__ __forceinline__ unsigned f2bf(float f) { unsigned u = __builtin_bit_cast(unsigned, f); return (u + 0x7fffu + ((u >> 16) & 1u)) >> 16; }
__device__ __forceinline__ unsigned pk2(float lo, float hi) { return f2bf(lo) | (f2bf(hi) << 16); }
__device__ __forceinline__ float bf_lo(unsigned w) { return __builtin_bit_cast(float, w << 16); }
__device__ __forceinline__ float bf_hi(unsigned w) { return __builtin_bit_cast(float, w & 0xffff0000u); }
__device__ __forceinline__ float wave_sum(float v) {
#pragma unroll
    for (int o = 1; o < 64; o <<= 1) v += __shfl_xor(v, o);
    return v;
}
__device__ __forceinline__ float fast_exp2(float x) { return __builtin_amdgcn_exp2f(x); }
__device__ __forceinline__ float fast_rcp(float x) { return __builtin_amdgcn_rcpf(x); }

struct Args { const float* in[24]; float* out; unsigned char* ws; int ph_lo, ph_hi, rep_mask, pad; };
static_assert(sizeof(Args) == 26 * 8 + 16, "Args has no padding");
#define XB_TMO      128
#define XB_XCNT(j)  (256  + 64 * (j))
#define XB_XSUB(j)  (1280 + 64 * (j))
#define XB_XGEN(j)  (2304 + 64 * (j))
#define XB_TOP      3328
#define XB_TOPGEN   3392
#define XCD_BAR_WORDS 3456
#define XB_SPIN_CAP (1u << 18)

__device__ __forceinline__ unsigned xb_ld(unsigned* p)              { return __hip_atomic_load(p, __ATOMIC_RELAXED, __HIP_MEMORY_SCOPE_AGENT); }
__device__ __forceinline__ unsigned xb_add(unsigned* p, unsigned v) { return __hip_atomic_fetch_add(p, v, __ATOMIC_RELAXED, __HIP_MEMORY_SCOPE_AGENT); }
__device__ __forceinline__ unsigned xb_xcc_id() { return (unsigned)__builtin_amdgcn_s_getreg((3 << 11) | 20) & 0xFu; }
#define XB_SPIN(cond, bar) do { unsigned _sp = 0; while (cond) { __builtin_amdgcn_s_sleep(1); \
    if ((++_sp & 255u) == 0u) { if (xb_ld(&(bar)[XB_TMO])) break; if (_sp > XB_SPIN_CAP) { atomicAdd(&(bar)[XB_TMO], 1u); break; } } } } while (0)

struct XcdBarrier {
    unsigned* bar; unsigned x;
    volatile LAS unsigned* st;
};

__device__ __forceinline__ XcdBarrier xcd_barrier_post(unsigned* bar, volatile LAS unsigned* st) {
    XcdBarrier b; b.bar = bar; b.x = xb_xcc_id(); b.st = st;
    if (threadIdx.x == 0) (void)xb_add(&bar[XB_XCNT(b.x)], 1u);
    return b;
}
__device__ __forceinline__ void xcd_barrier_complete(unsigned* bar, unsigned x, unsigned& nloc, unsigned& nx) {
    const unsigned G = gridDim.x * gridDim.y * gridDim.z;
    unsigned sum, cnt, mine, sp = 0u;
    for (;;) {
        sum = 0u; cnt = 0u; mine = 0u;
#pragma unroll
        for (unsigned j = 0; j < 16; ++j) { const unsigned c = xb_ld(&bar[XB_XCNT(j)]); sum += c; cnt += (c > 0u) ? 1u : 0u; mine = (j == x) ? c : mine; }
        if (sum == G) break;
        __builtin_amdgcn_s_sleep(1);
        if ((++sp & 255u) == 0u) { if (xb_ld(&bar[XB_TMO])) break; if (sp > XB_SPIN_CAP) { atomicAdd(&bar[XB_TMO], 1u); break; } }
    }
    nloc = mine > 0u ? mine : 1u; nx = cnt > 0u ? cnt : 1u;
}

__device__ __forceinline__ void xcd_barrier(const XcdBarrier& b) {
    asm volatile("s_waitcnt vmcnt(0)" ::: "memory");
    __syncthreads();
    if (threadIdx.x == 0) {
        unsigned* bar = b.bar;
        __builtin_amdgcn_s_waitcnt(0);
        unsigned nloc = b.st[0], nx = b.st[1];
        if (nloc == 0u) { xcd_barrier_complete(bar, b.x, nloc, nx); b.st[0] = nloc; b.st[1] = nx; }
        const unsigned old = xb_add(&bar[XB_XSUB(b.x)], 1u);
        const unsigned gen = old / nloc;
        if (old + 1u == (gen + 1u) * nloc) {
            __builtin_amdgcn_fence(__ATOMIC_RELEASE, "agent");
            asm volatile("s_waitcnt vmcnt(0)" ::: "memory");
            const unsigned og = xb_add(&bar[XB_TOP], 1u);
            const unsigned tg = og / nx;
            if (og + 1u == (tg + 1u) * nx) xb_add(&bar[XB_TOPGEN], 1u);
            else XB_SPIN(xb_ld(&bar[XB_TOPGEN]) == tg, bar);
            __builtin_amdgcn_fence(__ATOMIC_ACQUIRE, "agent");
            xb_add(&bar[XB_XGEN(b.x)], 1u);
            asm volatile("s_waitcnt vmcnt(0)" ::: "memory");
        } else {
            XB_SPIN(xb_ld(&bar[XB_XGEN(b.x)]) == gen, bar);
            __builtin_amdgcn_fence(__ATOMIC_ACQUIRE, "agent");
            asm volatile("s_waitcnt vmcnt(0)" ::: "memory");
        }
    }
    __syncthreads();
}

#define EPI_ARGS const pg8::f32x4 (&acc)[2][2][4][2], const pg8::Unit& u, int wr, int wc, int fr, int fq
#define EPI_FOR_AI_M _Pragma("unroll") for (int ai = 0; ai < 2; ++ai) _Pragma("unroll") for (int m = 0; m < 4; ++m)
__device__ __forceinline__ v4u pack8(const f32x4 a, const f32x4 b) { v4u w; w.x = pg8::cvt_pk_bf16(a[0], a[1]); w.y = pg8::cvt_pk_bf16(a[2], a[3]); w.z = pg8::cvt_pk_bf16(b[0], b[1]); w.w = pg8::cvt_pk_bf16(b[2], b[3]); return w; }
__device__ __forceinline__ float sigmoidf_fast(float v) { return fast_rcp(1.0f + fast_exp2(-v * LOG2E)); }

__device__ __forceinline__ unsigned cvt4_fp8(float a, float b, float c, float d) { int p = __builtin_amdgcn_cvt_pk_fp8_f32(a, b, 0, false); p = __builtin_amdgcn_cvt_pk_fp8_f32(c, d, p, true); return (unsigned)p; }

constexpr float W2_SCALE = 16.0f, ACT_SCALE = 4.0f, W13_SCALE = 32.0f, W1_SCALE = 32.0f, WO_SCALE = 32.0f, MIX_SCALE = 16.0f, WXQ_SCALE = 32.0f;
struct EpiQKVG {
    static constexpr bool PERM = true, AFTER_DRAIN = false, HAS_MID = false; static constexpr int MID_T = 0;
    bf16* qkv; bf16* ga; bf16* gb; const float* bgate;
    __device__ __forceinline__ void operator()(EPI_ARGS) const {
        const int row0 = u.pm * 256 + wr * 64 + fr, ct = wc * 32 + 8 * fq;
        if (u.pn < 15) {
            const float sc = ((u.pn < 4 || (u.pn >= 6 && u.pn < 9)) ? 0.125f * LOG2E : 1.0f) * (1.0f / W1_SCALE);
            EPI_FOR_AI_M { bf16* rowp = qkv + (size_t)(row0 + ai * 128 + m * 16) * NQKV + u.pn * 256 + ct;
#pragma unroll
                for (int bj = 0; bj < 2; ++bj) *(v4u*)(rowp + bj * 128) = pack8(acc[ai][bj][m][0] * sc, acc[ai][bj][m][1] * sc); }
        } else {
            const int gt = u.pn - 15; bf16* base = (gt < 8) ? ga : gb; const int gc = (gt & 7) * 256 + ct, bc = gt * 256 + ct;
            _Pragma("unroll") for (int bj = 0; bj < 2; ++bj) { const f32x4 b0 = *(const f32x4*)(bgate + bc + bj * 128), b1 = *(const f32x4*)(bgate + bc + bj * 128 + 4);
                EPI_FOR_AI_M { bf16* rowp = base + (size_t)(row0 + ai * 128 + m * 16) * D + gc;
                    f32x4 v0 = acc[ai][bj][m][0] * (1.0f / W1_SCALE) + b0, v1 = acc[ai][bj][m][1] * (1.0f / W1_SCALE) + b1;
#pragma unroll
                    for (int j = 0; j < 4; ++j) { v0[j] = sigmoidf_fast(v0[j]); v1[j] = sigmoidf_fast(v1[j]); }
                    *(v4u*)(rowp + bj * 128) = pack8(v0, v1); } }
        }
    }
};

constexpr float OAB_SCALE = 16.0f, WAB_SCALE = 32.0f;
#define EPI_ROWSTEP(off, aim) do { off += (size_t)16 * D; if (((aim) & 3) == 3) off += (size_t)64 * D; } while (0)
#ifndef EPI_MIX_MID_AHEAD
#define EPI_MIX_MID_AHEAD 1
#endif
#ifndef EPI_MIX_AHEAD
#define EPI_MIX_AHEAD 1
#endif
struct EpiMix {
    static constexpr bool PERM = true, AFTER_DRAIN = false, HAS_MID = true; static constexpr int MID_T = 8;
    static constexpr int NM = EPI_MIX_MID_AHEAD, NA = EPI_MIX_AHEAD;
    const bf16* ga; const bf16* gb; unsigned char* mix8;
    __device__ __forceinline__ void mid(pg8::f32x4 (&acc)[2][2][4][2], const pg8::Unit& u, int wr, int wc, int fr, int fq) const {
        size_t offl = (size_t)(u.pm * 256 + wr * 64 + fr) * D + u.pn * 256 + wc * 32 + 8 * fq;
        asm volatile("" : "+v"(offl));
        v4u na[NM][2], nb[NM][2];
#pragma unroll
        for (int a = 0; a < NM; ++a) { if (a) EPI_ROWSTEP(offl, a - 1); na[a][0] = *(const v4u*)(ga + offl); na[a][1] = *(const v4u*)(ga + offl + 128); nb[a][0] = *(const v4u*)(gb + offl); nb[a][1] = *(const v4u*)(gb + offl + 128); }
#pragma unroll
        for (int aim = 0; aim < 8; ++aim) { const int ai = aim >> 2, m = aim & 3;
            const v4u ca[2] = {na[0][0], na[0][1]}, cb[2] = {nb[0][0], nb[0][1]};
#pragma unroll
            for (int a = 0; a + 1 < NM; ++a) { na[a][0] = na[a + 1][0]; na[a][1] = na[a + 1][1]; nb[a][0] = nb[a + 1][0]; nb[a][1] = nb[a + 1][1]; }
            if (aim + NM < 8) { EPI_ROWSTEP(offl, aim + NM - 1); na[NM - 1][0] = *(const v4u*)(ga + offl); na[NM - 1][1] = *(const v4u*)(ga + offl + 128); nb[NM - 1][0] = *(const v4u*)(gb + offl); nb[NM - 1][1] = *(const v4u*)(gb + offl + 128); }
            asm volatile("" : "+v"(offl) :: "memory");
#pragma unroll
            for (int bj = 0; bj < 2; ++bj) { const v4u a = ca[bj], b = cb[bj];
                const f32x4 r0 = {bf_lo(a.x) * fast_rcp(bf_lo(b.x)), bf_hi(a.x) * fast_rcp(bf_hi(b.x)), bf_lo(a.y) * fast_rcp(bf_lo(b.y)), bf_hi(a.y) * fast_rcp(bf_hi(b.y))};
                const f32x4 r1 = {bf_lo(a.z) * fast_rcp(bf_lo(b.z)), bf_hi(a.z) * fast_rcp(bf_hi(b.z)), bf_lo(a.w) * fast_rcp(bf_lo(b.w)), bf_hi(a.w) * fast_rcp(bf_hi(b.w))};
                acc[ai][bj][m][0] = acc[ai][bj][m][0] * r0; acc[ai][bj][m][1] = acc[ai][bj][m][1] * r1; } }
    }
    __device__ __forceinline__ void operator()(EPI_ARGS) const {
        size_t off = (size_t)(u.pm * 256 + wr * 64 + fr) * D + u.pn * 256 + wc * 32 + 8 * fq, offl = off;
        asm volatile("" : "+v"(off)); asm volatile("" : "+v"(offl));
        constexpr float sc = MIX_SCALE / (OAB_SCALE * WAB_SCALE);
        v4u nb[NA][2];
#pragma unroll
        for (int a = 0; a < NA; ++a) { if (a) EPI_ROWSTEP(offl, a - 1); nb[a][0] = *(const v4u*)(gb + offl); nb[a][1] = *(const v4u*)(gb + offl + 128); }
#pragma unroll
        for (int aim = 0; aim < 8; ++aim) { const int ai = aim >> 2, m = aim & 3;
            const v4u cb[2] = {nb[0][0], nb[0][1]}; const size_t offc = off;
#pragma unroll
            for (int a = 0; a + 1 < NA; ++a) { nb[a][0] = nb[a + 1][0]; nb[a][1] = nb[a + 1][1]; }
            EPI_ROWSTEP(off, aim);
            if (aim + NA < 8) { EPI_ROWSTEP(offl, aim + NA - 1); nb[NA - 1][0] = *(const v4u*)(gb + offl); nb[NA - 1][1] = *(const v4u*)(gb + offl + 128); }
            asm volatile("" : "+v"(off), "+v"(offl) :: "memory");
#pragma unroll
            for (int bj = 0; bj < 2; ++bj) { const v4u b = cb[bj]; const f32x4 a0 = acc[ai][bj][m][0] * sc, a1 = acc[ai][bj][m][1] * sc;
                v2u w8; w8.x = cvt4_fp8(a0[0] * bf_lo(b.x), a0[1] * bf_hi(b.x), a0[2] * bf_lo(b.y), a0[3] * bf_hi(b.y)); w8.y = cvt4_fp8(a1[0] * bf_lo(b.z), a1[1] * bf_hi(b.z), a1[2] * bf_lo(b.w), a1[3] * bf_hi(b.w));
                *(v2u*)(mix8 + offc + bj * 128) = w8; } }
    }
};

#ifndef EPI_RESID_AHEAD
#define EPI_RESID_AHEAD 3
#endif
struct EpiResid {
    static constexpr bool PERM = true, AFTER_DRAIN = false, HAS_MID = false; static constexpr int MID_T = 0;
    static constexpr int NA = EPI_RESID_AHEAD;
    const float* x; bf16* x1; float* ssq;
    __device__ __forceinline__ void operator()(EPI_ARGS) const {
        const int ct = u.pn * 256 + wc * 32 + 8 * fq; int row = u.pm * 256 + wr * 64 + fr;
        size_t off = (size_t)row * D + ct, offl = off;
        asm volatile("" : "+v"(off)); asm volatile("" : "+v"(offl));
#define EPI_LDX(dst) do { dst[0] = *(const f32x4*)(x + offl); dst[1] = *(const f32x4*)(x + offl + 4); dst[2] = *(const f32x4*)(x + offl + 128); dst[3] = *(const f32x4*)(x + offl + 132); } while (0)
        f32x4 nx[NA][4];
#pragma unroll
        for (int a = 0; a < NA; ++a) { if (a) EPI_ROWSTEP(offl, a - 1); EPI_LDX(nx[a]); }
#pragma unroll
        for (int aim = 0; aim < 8; ++aim) { const int ai = aim >> 2, m = aim & 3;
            const f32x4 cx[4] = {nx[0][0], nx[0][1], nx[0][2], nx[0][3]}; const size_t offc = off; const int rowc = row;
#pragma unroll
            for (int a = 0; a + 1 < NA; ++a)
#pragma unroll
                for (int q = 0; q < 4; ++q) nx[a][q] = nx[a + 1][q];
            EPI_ROWSTEP(off, aim); row += 16; if (m == 3) row += 64;
            if (aim + NA < 8) { EPI_ROWSTEP(offl, aim + NA - 1); EPI_LDX(nx[NA - 1]); }
            asm volatile("" : "+v"(off), "+v"(offl) :: "memory");
            float s = 0.f;
#pragma unroll
            for (int bj = 0; bj < 2; ++bj) {
                const f32x4 v0 = cx[2 * bj] + acc[ai][bj][m][0] * (1.0f / (MIX_SCALE * WO_SCALE)), v1 = cx[2 * bj + 1] + acc[ai][bj][m][1] * (1.0f / (MIX_SCALE * WO_SCALE));
                *(v4u*)(x1 + offc + bj * 128) = pack8(v0, v1);
                s += ((v0[0] * v0[0] + v0[1] * v0[1]) + (v0[2] * v0[2] + v0[3] * v0[3])) + ((v1[0] * v1[0] + v1[1] * v1[1]) + (v1[2] * v1[2] + v1[3] * v1[3]));
            }
            s += __shfl_xor(s, 16); s += __shfl_xor(s, 32);
            if (fq == 0) ssq[(size_t)rowc * 32 + u.pn * 4 + wc] = s; }
#undef EPI_LDX
    }
};

struct EpiQx {
    static constexpr bool PERM = true, AFTER_DRAIN = false, HAS_MID = false; static constexpr int MID_T = 0;
    bf16* qx; const float* ssq; float scale;
    __device__ __forceinline__ void operator()(EPI_ARGS) const {
        int row = u.pm * 256 + wr * 64 + fr; const int ct = u.pn * 256 + wc * 32 + 8 * fq;
        asm volatile("" : "+v"(row));
#pragma unroll
        for (int ai = 0; ai < 2; ++ai) {
#pragma unroll
            for (int m = 0; m < 4; ++m) {
                const f32x4 p0 = *(const f32x4*)(ssq + (size_t)row * 32 + fq * 8), p1 = *(const f32x4*)(ssq + (size_t)row * 32 + fq * 8 + 4);
                float s = ((p0[0] + p0[1]) + (p0[2] + p0[3])) + ((p1[0] + p1[1]) + (p1[2] + p1[3]));
                s += __shfl_xor(s, 16); s += __shfl_xor(s, 32);
                const float rs = scale / sqrtf(s * (1.0f / D) + EPS);
                bf16* rowp = qx + (size_t)row * XW + ct;
#pragma unroll
                for (int bj = 0; bj < 2; ++bj) *(v4u*)(rowp + bj * 128) = pack8(acc[ai][bj][m][0] * rs, acc[ai][bj][m][1] * rs);
                row += 16; asm volatile("" : "+v"(row) :: "memory"); }
            row += 64; }
    }
};

struct EpiBf {
    static constexpr bool PERM = true, AFTER_DRAIN = false, HAS_MID = false; static constexpr int MID_T = 0;
    bf16* out; int ldc; int tmod; float sc;
    __device__ __forceinline__ void operator()(EPI_ARGS) const {
        const int row0 = u.pm * 256 + wr * 64 + fr, ct = (u.pn % tmod) * 256 + wc * 32 + 8 * fq;
        EPI_FOR_AI_M { bf16* rowp = out + (size_t)(row0 + ai * 128 + m * 16) * ldc + ct;
#pragma unroll
            for (int bj = 0; bj < 2; ++bj) *(v4u*)(rowp + bj * 128) = pack8(acc[ai][bj][m][0] * sc, acc[ai][bj][m][1] * sc); }
    }
};

struct EpiF8 {
    static constexpr bool PERM = true, AFTER_DRAIN = false, HAS_MID = false; static constexpr int MID_T = 0;
    unsigned char* out; int ldc; int tmod; float sc;
    __device__ __forceinline__ void operator()(EPI_ARGS) const {
        const int row0 = u.pm * 256 + wr * 64 + fr, ct = (u.pn % tmod) * 256 + wc * 32 + 8 * fq;
        EPI_FOR_AI_M { unsigned char* rowp = out + (size_t)(row0 + ai * 128 + m * 16) * ldc + ct;
#pragma unroll
            for (int bj = 0; bj < 2; ++bj) { const f32x4 a0 = acc[ai][bj][m][0] * sc, a1 = acc[ai][bj][m][1] * sc; v2u w8; w8.x = cvt4_fp8(a0[0], a0[1], a0[2], a0[3]); w8.y = cvt4_fp8(a1[0], a1[1], a1[2], a1[3]);
                *(v2u*)(rowp + bj * 128) = w8; } }
    }
};

#ifndef EPI_RESID2_AHEAD
#define EPI_RESID2_AHEAD 1
#endif
struct EpiResid2 {
    static constexpr bool PERM = true, AFTER_DRAIN = false, HAS_MID = false; static constexpr int MID_T = 0;
    bf16* x1; unsigned char* hm; const float* gm; float* ssq;
    __device__ __forceinline__ void operator()(EPI_ARGS) const {
        const int ct = u.pn * 256 + wc * 32 + 8 * fq; int row = u.pm * 256 + wr * 64 + fr;
        size_t off = (size_t)row * D + ct;
        asm volatile("" : "+v"(off));
        const f32x4 gv[2][2] = {{*(const f32x4*)(gm + ct), *(const f32x4*)(gm + ct + 4)}, {*(const f32x4*)(gm + ct + 128), *(const f32x4*)(gm + ct + 132)}};
        v4u nt[2];
        nt[0] = *(const v4u*)(x1 + off); nt[1] = *(const v4u*)(x1 + off + 128);
#pragma unroll
        for (int aim = 0; aim < 8; ++aim) { const int ai = aim >> 2, m = aim & 3;
            const v4u ctv[2] = {nt[0], nt[1]}; const size_t offc = off; const int rowc = row;
            EPI_ROWSTEP(off, aim); row += 16; if (m == 3) row += 64;
            if (aim < 7) { nt[0] = *(const v4u*)(x1 + off); nt[1] = *(const v4u*)(x1 + off + 128); }
            asm volatile("" : "+v"(off) :: "memory");
            float s = 0.f;
#pragma unroll
            for (int bj = 0; bj < 2; ++bj) { const v4u t = ctv[bj]; const f32x4 a0 = acc[ai][bj][m][0], a1 = acc[ai][bj][m][1];
                const f32x4 o0 = {bf_lo(t.x) + a0[0], bf_hi(t.x) + a0[1], bf_lo(t.y) + a0[2], bf_hi(t.y) + a0[3]}, o1 = {bf_lo(t.z) + a1[0], bf_hi(t.z) + a1[1], bf_lo(t.w) + a1[2], bf_hi(t.w) + a1[3]};
                *(v4u*)(x1 + offc + bj * 128) = pack8(o0, o1);
                const f32x4 h0 = o0 * gv[bj][0], h1 = o1 * gv[bj][1];
                v2u w8; w8.x = cvt4_fp8(h0[0], h0[1], h0[2], h0[3]); w8.y = cvt4_fp8(h1[0], h1[1], h1[2], h1[3]);
                *(v2u*)(hm + offc + bj * 128) = w8;
                s += ((o0[0] * o0[0] + o0[1] * o0[1]) + (o0[2] * o0[2] + o0[3] * o0[3])) + ((o1[0] * o1[0] + o1[1] * o1[1]) + (o1[2] * o1[2] + o1[3] * o1[3])); }
            s += __shfl_xor(s, 16); s += __shfl_xor(s, 32);
            if (fq == 0) ssq[(size_t)rowc * 32 + u.pn * 4 + wc] = s; }
    }
};
struct EpiLogit {
    static constexpr bool PERM = true, AFTER_DRAIN = false, HAS_MID = false; static constexpr int MID_T = 0;
    float* part;
    __device__ __forceinline__ void operator()(EPI_ARGS) const {
        const int c0 = wc * 8 + 2 * fq;
        EPI_FOR_AI_M { const int row = u.pm * 256 + wr * 64 + fr + ai * 128 + m * 16;
            { const f32x4 a = acc[ai][0][m][0], b = acc[ai][0][m][1]; v2u st; st.x = __builtin_bit_cast(unsigned, (a[0] + a[1]) + (a[2] + a[3])); st.y = __builtin_bit_cast(unsigned, (b[0] + b[1]) + (b[2] + b[3]));
              *(v2u*)(part + (size_t)row * 36 + c0) = st; }
            if (wc == 0 && fq < 2) { const f32x4 a = acc[ai][1][m][0], b = acc[ai][1][m][1]; v2u st; st.x = __builtin_bit_cast(unsigned, (a[0] + a[1]) + (a[2] + a[3])); st.y = __builtin_bit_cast(unsigned, (b[0] + b[1]) + (b[2] + b[3]));
              *(v2u*)(part + (size_t)row * 36 + 32 + c0) = st; } }
    }
};

struct EpiF32 {
    static constexpr bool PERM = true, AFTER_DRAIN = false, HAS_MID = false; static constexpr int MID_T = 0;
    float* c; int ldc;
    __device__ __forceinline__ void operator()(EPI_ARGS) const {
        const int ct = u.pn * 256 + wc * 32 + 8 * fq;
        EPI_FOR_AI_M { float* rp = c + (size_t)(u.pm * 256 + wr * 64 + fr + ai * 128 + m * 16) * ldc + ct;
#pragma unroll
            for (int bj = 0; bj < 2; ++bj) { *(f32x4*)(rp + bj * 128) = acc[ai][bj][m][0]; *(f32x4*)(rp + bj * 128 + 4) = acc[ai][bj][m][1]; } }
    }
};
struct EpiSwiGLU {
    static constexpr bool PERM = true, AFTER_DRAIN = false, HAS_MID = false; static constexpr int MID_T = 0;
    unsigned char* act; const float* rsort;
    __device__ __forceinline__ void operator()(EPI_ARGS) const {
        const int row0 = u.pm * 256 + wr * 64 + fr, ct = (u.pn & 3) * 128 + wc * 16 + 4 * fq;
        EPI_FOR_AI_M { const int row = row0 + ai * 128 + m * 16; const float rs = rsort[row] * (1.0f / W13_SCALE); unsigned char* rowp = act + (size_t)row * DFF + ct;
#pragma unroll
            for (int bj = 0; bj < 2; ++bj) { const f32x4 a = acc[ai][bj][m][0] * rs, b = acc[ai][bj][m][1] * rs;
                const float o0 = a[0] * sigmoidf_fast(a[0]) * a[1], o1 = a[2] * sigmoidf_fast(a[2]) * a[3], o2 = b[0] * sigmoidf_fast(b[0]) * b[1], o3 = b[2] * sigmoidf_fast(b[2]) * b[3];
                *(unsigned*)(rowp + bj * 64) = cvt4_fp8(o0 * ACT_SCALE, o1 * ACT_SCALE, o2 * ACT_SCALE, o3 * ACT_SCALE); } }
    }
};

constexpr int ATT_TAB_OFF = 0;
constexpr int ATT_V_OFF = 8192;
constexpr int ATT_V_WAVE64 = 6144, ATT_V_WAVE128 = 10240;
constexpr int ATT_K_WAVE64 = 32 * 144, ATT_K_WAVE128 = 32 * 272;
constexpr int ATT_K_OFF64 = ATT_V_OFF + 8 * ATT_V_WAVE64, ATT_K_OFF128 = ATT_V_OFF + 8 * ATT_V_WAVE128;
constexpr int ATT_OB_OFF = ATT_K_OFF64 + 8 * ATT_K_WAVE64;
constexpr int ATT_LSE_OFF = ATT_OB_OFF + 65536;
static_assert(ATT_LSE_OFF + 2048 <= 161792 && ATT_K_OFF128 + 8 * ATT_K_WAVE128 <= 161792, "attention LDS map below the control words");

template <int DH> struct AttnGeom { static constexpr int KSTRIDE = 2 * DH + 16, VSTRIDE = (DH == 64) ? 192 : 320, CPR = DH / 8, RPI = 64 / CPR, NVI = 32 / RPI, NST = DH / 16, NDT = DH / 32; };


template <int VSTRIDE, int DT>
__device__ __forceinline__ void pv_step(unsigned tr_base, const s16x8 (&pf)[2], f32x16& Od) {
    s16x4 a0, a1, b0, b1;
    asm volatile("ds_read_b64_tr_b16 %0, %4 offset:%5\n\tds_read_b64_tr_b16 %1, %4 offset:%6\n\tds_read_b64_tr_b16 %2, %4 offset:%7\n\tds_read_b64_tr_b16 %3, %4 offset:%8\n\ts_waitcnt lgkmcnt(0)"
                 : "=&v"(a0), "=&v"(a1), "=&v"(b0), "=&v"(b1)
                 : "v"(tr_base), "i"(64 * DT), "i"(64 * DT + 8 * VSTRIDE), "i"(64 * DT + 16 * VSTRIDE), "i"(64 * DT + 24 * VSTRIDE) : "memory");
    const s16x8 vf0 = __builtin_shufflevector(a0, a1, 0, 1, 2, 3, 4, 5, 6, 7), vf1 = __builtin_shufflevector(b0, b1, 0, 1, 2, 3, 4, 5, 6, 7);
    Od = __builtin_amdgcn_mfma_f32_32x32x16_bf16(vf0, pf[0], Od, 0, 0, 0);
    Od = __builtin_amdgcn_mfma_f32_32x32x16_bf16(vf1, pf[1], Od, 0, 0, 0);
}

template <int VSTRIDE, int DT>
__device__ __forceinline__ void pv_step2(unsigned tr_base, const s16x8 (&pf)[2], f32x16& Od0, f32x16& Od1) {
    s16x4 a0, a1, b0, b1, c0, c1, d0, d1;
    asm volatile("ds_read_b64_tr_b16 %0, %8 offset:%9\n\tds_read_b64_tr_b16 %1, %8 offset:%10\n\tds_read_b64_tr_b16 %2, %8 offset:%11\n\tds_read_b64_tr_b16 %3, %8 offset:%12\n\t"
                 "ds_read_b64_tr_b16 %4, %8 offset:%13\n\tds_read_b64_tr_b16 %5, %8 offset:%14\n\tds_read_b64_tr_b16 %6, %8 offset:%15\n\tds_read_b64_tr_b16 %7, %8 offset:%16\n\ts_waitcnt lgkmcnt(0)"
                 : "=&v"(a0), "=&v"(a1), "=&v"(b0), "=&v"(b1), "=&v"(c0), "=&v"(c1), "=&v"(d0), "=&v"(d1)
                 : "v"(tr_base), "i"(64 * DT), "i"(64 * DT + 8 * VSTRIDE), "i"(64 * DT + 16 * VSTRIDE), "i"(64 * DT + 24 * VSTRIDE),
                   "i"(64 * DT + 64), "i"(64 * DT + 64 + 8 * VSTRIDE), "i"(64 * DT + 64 + 16 * VSTRIDE), "i"(64 * DT + 64 + 24 * VSTRIDE) : "memory");
    const s16x8 v00 = __builtin_shufflevector(a0, a1, 0, 1, 2, 3, 4, 5, 6, 7), v01 = __builtin_shufflevector(b0, b1, 0, 1, 2, 3, 4, 5, 6, 7);
    const s16x8 v10 = __builtin_shufflevector(c0, c1, 0, 1, 2, 3, 4, 5, 6, 7), v11 = __builtin_shufflevector(d0, d1, 0, 1, 2, 3, 4, 5, 6, 7);
    Od0 = __builtin_amdgcn_mfma_f32_32x32x16_bf16(v00, pf[0], Od0, 0, 0, 0);
    Od1 = __builtin_amdgcn_mfma_f32_32x32x16_bf16(v10, pf[0], Od1, 0, 0, 0);
    Od0 = __builtin_amdgcn_mfma_f32_32x32x16_bf16(v01, pf[1], Od0, 0, 0, 0);
    Od1 = __builtin_amdgcn_mfma_f32_32x32x16_bf16(v11, pf[1], Od1, 0, 0, 0);
}

struct AttnJob {
    const bf16* q; int ldq; long qrow0; int qstride; int qmask;
    const bf16* q2;
    const bf16* k; const bf16* v; int ldkv; long krow0; int kstride;
    int i0;
    int u_begin, ntiles;
    float m_init, l_init;
};

template <int DH> struct KVTile { v4u k[AttnGeom<DH>::NVI]; v4u v[AttnGeom<DH>::NVI]; };
template <int DH> struct KVPtr { const bf16* k[AttnGeom<DH>::NVI]; const bf16* v[AttnGeom<DH>::NVI]; long step; };
template <int DH> __device__ __forceinline__ void attn_ptr_init(const AttnJob& J, int lane, KVPtr<DH>& P) {
    typedef AttnGeom<DH> G;
    const int q = lane & 31, h = lane >> 5, vr = lane / G::CPR, vc = lane % G::CPR;
#pragma unroll
    for (int i = 0; i < G::NVI; ++i) P.k[i] = J.k + (size_t)(J.krow0 + (long)(J.u_begin + vr + G::RPI * i) * J.kstride) * J.ldkv + 8 * vc;
#pragma unroll
    for (int i = 0; i < G::NVI; ++i) P.v[i] = J.v + (size_t)(J.krow0 + (long)(J.u_begin + vr + G::RPI * i) * J.kstride) * J.ldkv + 8 * vc;
    P.step = (long)32 * J.kstride * J.ldkv;
}
template <int DH> __device__ __forceinline__ void attn_load_k(KVPtr<DH>& P, KVTile<DH>& T) {
    typedef AttnGeom<DH> G;
#pragma unroll
    for (int i = 0; i < G::NVI; ++i) T.k[i] = *(const v4u*)(P.k[i]);
#pragma unroll
    for (int i = 0; i < G::NVI; ++i) P.k[i] += P.step;
}
template <int DH> __device__ __forceinline__ void attn_load_v(KVPtr<DH>& P, KVTile<DH>& T) {
    typedef AttnGeom<DH> G;
#pragma unroll
    for (int i = 0; i < G::NVI; ++i) T.v[i] = *(const v4u*)(P.v[i]);
#pragma unroll
    for (int i = 0; i < G::NVI; ++i) P.v[i] += P.step;
}
template <int DH> __device__ __forceinline__ void attn_load_tile(KVPtr<DH>& P, KVTile<DH>& T) { attn_load_k<DH>(P, T); attn_load_v<DH>(P, T); }
constexpr float ATT_THR = 6.0f;

template <int DH, bool TAB>
__device__ __forceinline__ void attn_qk(const AttnJob& J, int u0, const KVTile<DH>& T, const s16x8 (&qf)[DH / 16], const LAS float* tab, LAS unsigned char* kst, int lane, float mrun, f32x16& S) {
    typedef AttnGeom<DH> G;
    const int q = lane & 31, h = lane >> 5, vr = lane / G::CPR, vc = lane % G::CPR;
#pragma unroll
    for (int i = 0; i < G::NVI; ++i) *(LAS v4u*)(kst + (vr + G::RPI * i) * G::KSTRIDE + 16 * vc) = T.k[i];
    const int dbase = (J.i0 - u0) + q - 4 * h + 32;
#pragma unroll
    for (int i = 0; i < 16; ++i) { const int cr = (i & 3) + 8 * (i >> 2); S[i] = (TAB ? tab[dbase - cr] : 0.f) - mrun; }
    s16x8 kf[G::NST];
#pragma unroll
    for (int st = 0; st < G::NST; ++st) kf[st] = *(const LAS s16x8*)(kst + q * G::KSTRIDE + 32 * st + 16 * h);
#pragma unroll
    for (int st = 0; st < G::NST; ++st) S = __builtin_amdgcn_mfma_f32_32x32x16_bf16(kf[st], qf[st], S, 0, 0, 0);
}
template <int DH>
__device__ __forceinline__ void attn_softmax_pv(const KVTile<DH>& T, f32x16& S, f32x16& Sn, bool has_next, LAS unsigned char* vst, unsigned tr_base, int lane,
                                                f32x16 (&O)[DH / 32], float& mrun, float& lrun) {
    typedef AttnGeom<DH> G;
    const int vr = lane / G::CPR, vc = lane % G::CPR;
#pragma unroll
    for (int i = 0; i < G::NVI; ++i) *(LAS v4u*)(vst + (vr + G::RPI * i) * G::VSTRIDE + 16 * vc) = T.v[i];
    float mx = S[0];
#pragma unroll
    for (int i = 1; i < 16; ++i) mx = fmaxf(mx, S[i]);
    if (!__all(mx <= ATT_THR)) {
        mx = fmaxf(mx, __shfl_xor(mx, 32));
        const float d = fmaxf(mx, 0.f), alpha = fast_exp2(-d);
        mrun += d; lrun *= alpha;
#pragma unroll
        for (int dt = 0; dt < G::NDT; ++dt)
#pragma unroll
            for (int i = 0; i < 16; ++i) O[dt][i] *= alpha;
#pragma unroll
        for (int i = 0; i < 16; ++i) S[i] -= d;
        if (has_next) {
#pragma unroll
            for (int i = 0; i < 16; ++i) Sn[i] -= d; }
    }
    float ps = 0.f;
#pragma unroll
    for (int i = 0; i < 16; ++i) { S[i] = fast_exp2(S[i]); ps += S[i]; }
    lrun += ps;
    s16x8 pf[2];
#pragma unroll
    for (int s = 0; s < 2; ++s) { unsigned w0 = pg8::cvt_pk_bf16(S[8 * s + 0], S[8 * s + 1]), w1 = pg8::cvt_pk_bf16(S[8 * s + 2], S[8 * s + 3]), w2 = pg8::cvt_pk_bf16(S[8 * s + 4], S[8 * s + 5]), w3 = pg8::cvt_pk_bf16(S[8 * s + 6], S[8 * s + 7]);
        v4u w = {w0, w1, w2, w3}; pf[s] = __builtin_bit_cast(s16x8, w); }
    LDS_WAIT();
    pv_step2<G::VSTRIDE, 0>(tr_base, pf, O[0], O[1]);
    if constexpr (G::NDT == 4) pv_step2<G::VSTRIDE, 2>(tr_base, pf, O[2], O[3]);
}

__device__ __forceinline__ void attn_fill_tab(LAS float* tab, const float* gtab, int maxoff, int lane) {
#pragma unroll
    for (int j = 0; j < 4; ++j) { const int idx = lane + 64 * j, d = idx - 32; tab[idx] = (d >= 0 && d <= maxoff) ? gtab[d] : NEGBIG; }
    LDS_WAIT();
}
template <int DH, bool TAB, bool PIPE, bool QSUM = false>
__device__ __forceinline__ void attn_job(const AttnJob& J, LAS float* tab, const float* gtab, int maxoff, LAS unsigned char* vst, LAS unsigned char* kst, int lane, f32x16 (&O)[DH / 32], float& m_out, float& l_out) {
    typedef AttnGeom<DH> G;
    const int q = lane & 31, h = lane >> 5;
    s16x8 qf[G::NST];
    { const bf16* qp = J.q + (size_t)(J.qrow0 + (long)(q & J.qmask) * J.qstride) * J.ldq + 8 * h;
#pragma unroll
      for (int st = 0; st < G::NST; ++st) qf[st] = *(const s16x8*)(qp + 16 * st);
      if constexpr (QSUM) { const bf16* qp2 = J.q2 + (size_t)(J.qrow0 + (long)(q & J.qmask) * J.qstride) * J.ldq + 8 * h;
#pragma unroll
          for (int st = 0; st < G::NST; ++st) { const v4u a = __builtin_bit_cast(v4u, qf[st]), b = *(const v4u*)(qp2 + 16 * st); v4u r;
              r.x = pg8::cvt_pk_bf16(bf_lo(a.x) + bf_lo(b.x), bf_hi(a.x) + bf_hi(b.x)); r.y = pg8::cvt_pk_bf16(bf_lo(a.y) + bf_lo(b.y), bf_hi(a.y) + bf_hi(b.y));
              r.z = pg8::cvt_pk_bf16(bf_lo(a.z) + bf_lo(b.z), bf_hi(a.z) + bf_hi(b.z)); r.w = pg8::cvt_pk_bf16(bf_lo(a.w) + bf_lo(b.w), bf_hi(a.w) + bf_hi(b.w));
              qf[st] = __builtin_bit_cast(s16x8, r); } } }
#pragma unroll
    for (int dt = 0; dt < G::NDT; ++dt)
#pragma unroll
        for (int i = 0; i < 16; ++i) O[dt][i] = 0.f;
    float mrun = J.m_init, lrun = (lane < 32) ? J.l_init : 0.f;
    const unsigned tr_base = (unsigned)(size_t)vst + (unsigned)((4 * h + ((lane & 15) >> 2)) * G::VSTRIDE + (16 * ((lane >> 4) & 1) + 4 * (lane & 3)) * 2);
    const int nt = J.ntiles, ub = J.u_begin;
    KVPtr<DH> P; attn_ptr_init<DH>(J, lane, P);
    if constexpr (PIPE) {
        KVTile<DH> A, B; f32x16 S0, S1;
        attn_load_tile<DH>(P, A);
        if constexpr (TAB) attn_fill_tab(tab, gtab, maxoff, lane);
        if (1 < nt) attn_load_tile<DH>(P, B);
        attn_qk<DH, TAB>(J, ub, A, qf, tab, kst, lane, mrun, S0);
        int t = 0;
        for (;;) {
            if (t + 2 < nt) attn_load_k<DH>(P, A);
            const bool n1 = t + 1 < nt;
            if (n1) attn_qk<DH, TAB>(J, ub + 32 * (t + 1), B, qf, tab, kst, lane, mrun, S1);
            attn_softmax_pv<DH>(A, S0, S1, n1, vst, tr_base, lane, O, mrun, lrun);
            if (t + 2 < nt) attn_load_v<DH>(P, A);
            if (++t >= nt) break;
            if (t + 2 < nt) attn_load_k<DH>(P, B);
            const bool n2 = t + 1 < nt;
            if (n2) attn_qk<DH, TAB>(J, ub + 32 * (t + 1), A, qf, tab, kst, lane, mrun, S0);
            attn_softmax_pv<DH>(B, S1, S0, n2, vst, tr_base, lane, O, mrun, lrun);
            if (t + 2 < nt) attn_load_v<DH>(P, B);
            if (++t >= nt) break;
        }
    } else {
        if constexpr (TAB) attn_fill_tab(tab, gtab, maxoff, lane);
        for (int t = 0; t < nt; ++t) { KVTile<DH> A; f32x16 S0, Sx; attn_load_tile<DH>(P, A); attn_qk<DH, TAB>(J, ub + 32 * t, A, qf, tab, kst, lane, mrun, S0); attn_softmax_pv<DH>(A, S0, Sx, false, vst, tr_base, lane, O, mrun, lrun); }
    }
    m_out = mrun; l_out = lrun + __shfl_xor(lrun, 32);
}


struct Frame {
    LAS unsigned char* lds;
    volatile LAS unsigned* MISC;
    gu32* ctl;
    unsigned char* ws;
    int tid, lane, wave, vcu, G;
    float* out;
};
__device__ __forceinline__ const float* frame_in(const Frame& F, int i) { const unsigned lo = __builtin_amdgcn_readfirstlane(F.MISC[16 + 2 * i]), hi = __builtin_amdgcn_readfirstlane(F.MISC[17 + 2 * i]); return (const float*)(((unsigned long long)hi << 32) | lo); }
#define FIN(i) frame_in(F, (i))
enum { I_X = 0, I_MEM, I_RELB, I_GMIX, I_WIN, I_SINK, I_WAOUT, I_WBOUT, I_WGATE, I_BGATE, I_WO, I_GX, I_GMEM, I_WXQ, I_WXK, I_WXV, I_WXO, I_GMOE, I_WRG, I_WRE, I_W1, I_W3, I_W2, I_GFIN };

__device__ __forceinline__ void p0_transpose_item(const float* W, int K, int N, bf16* WT, int row_off, int row_mul, LAS unsigned* scr, int item, int lane, const float* rowscale = nullptr) {
    const int nblk = N / 64, kb = item / nblk, nb = item % nblk, k0 = 64 * kb, n0 = 64 * nb;
    const int r4 = lane >> 4, c16 = lane & 15;
    f32x4 v[16];
    const float* src = W + (size_t)(k0 + 2 * r4) * N + n0 + 4 * c16;
#pragma unroll
    for (int i = 0; i < 8; ++i) { v[2 * i] = *(const f32x4*)(src + (size_t)(8 * i) * N); v[2 * i + 1] = *(const f32x4*)(src + (size_t)(8 * i + 1) * N); }
    if (rowscale) {
#pragma unroll
        for (int i = 0; i < 8; ++i) { v[2 * i] *= rowscale[k0 + 2 * r4 + 8 * i]; v[2 * i + 1] *= rowscale[k0 + 2 * r4 + 8 * i + 1]; } }
#pragma unroll
    for (int i = 0; i < 8; ++i)
#pragma unroll
        for (int j = 0; j < 4; ++j) scr[(4 * c16 + j) * 33 + 4 * i + r4] = pg8::cvt_pk_bf16(v[2 * i][j], v[2 * i + 1][j]);
    LDS_WAIT(); asm volatile("" ::: "memory");
    const int nr = lane >> 3, c = lane & 7;
#pragma unroll
    for (int jj = 0; jj < 8; ++jj) { const int n = nr + 8 * jj; const LAS unsigned* s = scr + n * 33 + 4 * c;
        v4u o; o.x = s[0]; o.y = s[1]; o.z = s[2]; o.w = s[3];
        *(v4u*)(WT + (size_t)(row_off + (n0 + n) * row_mul) * K + k0 + 8 * c) = o; }
    LDS_WAIT(); asm volatile("" ::: "memory");
}
template <bool DEEP = false>
__device__ __forceinline__ void p0_transpose_item_fp8(const float* W, int K, int N, unsigned char* WT, int row_off, int row_mul, float scale, LAS unsigned* scr, int item, int lane, int pitch = 0, int kbase = 0) {
    if (pitch == 0) pitch = K;
    const int nblk = N / 64, kb = item / nblk, nb = item % nblk, k0 = 128 * kb, n0 = 64 * nb;
    const int r4 = lane >> 4, c16 = lane & 15;
    if constexpr (DEEP) {
        f32x4 v[2][4][4];
#pragma unroll
        for (int pass = 0; pass < 2; ++pass) { const float* src = W + (size_t)(k0 + 64 * pass + 4 * r4) * N + n0 + 4 * c16;
#pragma unroll
            for (int i = 0; i < 4; ++i)
#pragma unroll
                for (int kk = 0; kk < 4; ++kk) v[pass][i][kk] = __builtin_nontemporal_load((const f32x4*)(src + (size_t)(16 * i + kk) * N)); }
#pragma unroll
        for (int pass = 0; pass < 2; ++pass)
#pragma unroll
            for (int i = 0; i < 4; ++i)
#pragma unroll
                for (int j = 0; j < 4; ++j) scr[(4 * c16 + j) * 33 + 16 * pass + 4 * i + r4] = cvt4_fp8(v[pass][i][0][j] * scale, v[pass][i][1][j] * scale, v[pass][i][2][j] * scale, v[pass][i][3][j] * scale);
    } else {
#pragma unroll
    for (int pass = 0; pass < 2; ++pass) {
        f32x4 v[4][4];
        const float* src = W + (size_t)(k0 + 64 * pass + 4 * r4) * N + n0 + 4 * c16;
#pragma unroll
        for (int i = 0; i < 4; ++i)
#pragma unroll
            for (int kk = 0; kk < 4; ++kk) v[i][kk] = *(const f32x4*)(src + (size_t)(16 * i + kk) * N);
#pragma unroll
        for (int i = 0; i < 4; ++i)
#pragma unroll
            for (int j = 0; j < 4; ++j) scr[(4 * c16 + j) * 33 + 16 * pass + 4 * i + r4] = cvt4_fp8(v[i][0][j] * scale, v[i][1][j] * scale, v[i][2][j] * scale, v[i][3][j] * scale);
    }
    }
    LDS_WAIT(); asm volatile("" ::: "memory");
    const int nr = lane >> 3, c = lane & 7;
#pragma unroll
    for (int jj = 0; jj < 8; ++jj) { const int n = nr + 8 * jj; const LAS unsigned* s = scr + n * 33 + 4 * c;
        v4u o; o.x = s[0]; o.y = s[1]; o.z = s[2]; o.w = s[3];
        *(v4u*)(WT + (size_t)(row_off + (n0 + n) * row_mul) * pitch + kbase + k0 + 16 * c) = o; }
    LDS_WAIT(); asm volatile("" ::: "memory");
}
__device__ __forceinline__ void rms_row_to_bf16(const float* xrow, const float* g, bf16* orow, int lane) {
    const f32x4* xr = (const f32x4*)xrow + lane; const f32x4* gr = (const f32x4*)g + lane;
    f32x4 v[8]; float s = 0.f;
#pragma unroll
    for (int j = 0; j < 8; ++j) { v[j] = xr[64 * j]; s += (v[j][0] * v[j][0] + v[j][1] * v[j][1]) + (v[j][2] * v[j][2] + v[j][3] * v[j][3]); }
    const float rstd = 1.0f / sqrtf(wave_sum(s) * (1.0f / D) + EPS);
    v2u* o8 = (v2u*)orow + lane;
#pragma unroll
    for (int j = 0; j < 8; ++j) { const f32x4 gg = gr[64 * j]; v2u w; w.x = pk2(v[j][0] * rstd * gg[0], v[j][1] * rstd * gg[1]); w.y = pk2(v[j][2] * rstd * gg[2], v[j][3] * rstd * gg[3]); o8[64 * j] = w; }
}
__device__ __forceinline__ void rms_row_to_fp8(const float* xrow, const float* g, unsigned char* orow, int lane) {
    const f32x4* xr = (const f32x4*)xrow + lane; const f32x4* gr = (const f32x4*)g + lane;
    f32x4 v[8]; float s = 0.f;
#pragma unroll
    for (int j = 0; j < 8; ++j) { v[j] = xr[64 * j]; s += (v[j][0] * v[j][0] + v[j][1] * v[j][1]) + (v[j][2] * v[j][2] + v[j][3] * v[j][3]); }
    const float rstd = 1.0f / sqrtf(wave_sum(s) * (1.0f / D) + EPS);
    unsigned* o4 = (unsigned*)orow + lane;
#pragma unroll
    for (int j = 0; j < 8; ++j) { const f32x4 gg = gr[64 * j]; o4[64 * j] = cvt4_fp8(v[j][0] * rstd * gg[0], v[j][1] * rstd * gg[1], v[j][2] * rstd * gg[2], v[j][3] * rstd * gg[3]); }
}
__device__ __forceinline__ int t5_bucket_dev(int d) {
    if (d < 16) return d;
    int large = 16 + (int)(log((double)d / 16.0) / log(128.0) * 16.0);
    return large < 31 ? large : 31;
}
constexpr int I_IN = 16 * 60, I_GT = 16 * 64, I_A = 8 * 32, I_B = 6 * 32, I_O = 16 * 32, I_Q = 32 * 8, I_XO = 8 * 32, I_E13 = 16 * 8, I_E2 = 4 * 32;
template <int PART> __device__ __forceinline__ void p0_convert_rest(Frame& F, int wgi, int nwg) {
    int lane_o = F.lane; asm volatile("" : "+v"(lane_o));
    LAS unsigned* scr = (LAS unsigned*)(F.lds + RING_OFF + F.wave * 16384);
    const int gw = wgi * NWAVES + F.wave, NGW = nwg * NWAVES;
    constexpr int NITEMS = PART == 0 ? I_A + I_B + I_O : 3 * I_Q + I_XO;
#pragma unroll 1
    for (int it = gw; it < NITEMS; it += NGW) {
        int r = it;
        if constexpr (PART == 0) {
            if (r < I_A) { p0_transpose_item_fp8(FIN(I_WAOUT), AW, D, F.ws + WS_WA, 0, 1, WAB_SCALE, scr, r, lane_o, AW + BW, 0); continue; } r -= I_A;
            if (r < I_B) { p0_transpose_item_fp8(FIN(I_WBOUT), BW, D, F.ws + WS_WA, 0, 1, WAB_SCALE, scr, r, lane_o, AW + BW, AW); continue; } r -= I_B;
            p0_transpose_item_fp8(FIN(I_WO), D, D, F.ws + WS_WO, 0, 1, WO_SCALE, scr, r, lane_o);
        } else {
            if (r < I_Q) { p0_transpose_item(FIN(I_WXQ), D, XW, (bf16*)(F.ws + WS_WXQ), 0, 1, scr, r, lane_o, FIN(I_GX)); continue; } r -= I_Q;
            if (r < I_Q) { p0_transpose_item(FIN(I_WXK), D, XW, (bf16*)(F.ws + WS_WXKV), 0, 1, scr, r, lane_o); continue; } r -= I_Q;
            if (r < I_Q) { p0_transpose_item(FIN(I_WXV), D, XW, (bf16*)(F.ws + WS_WXKV), XW, 1, scr, r, lane_o); continue; } r -= I_Q;
            p0_transpose_item(FIN(I_WXO), XW, D, (bf16*)(F.ws + WS_WXO), 0, 1, scr, r, lane_o);
        }
    }
}
constexpr int N_W13 = 2 * NEXP * I_E13, N_WEXP = N_W13 + NEXP * I_E2;
template <bool DEEP = false> __device__ __forceinline__ void convert_w(Frame& F, int lo, int hi, int wsl, int nws) {
    int lane_o = F.lane; asm volatile("" : "+v"(lane_o));
    LAS unsigned* scr = (LAS unsigned*)(F.lds + RING_OFF + F.wave * 16384);
#pragma unroll 1
    for (int it = lo + wsl; it < hi; it += nws) {
        if (it < N_W13) { const int mat = it >= NEXP * I_E13 ? 1 : 0, r = it - mat * NEXP * I_E13, e = r / I_E13;
            p0_transpose_item_fp8<DEEP>(FIN(mat ? I_W3 : I_W1) + (size_t)e * D * DFF, D, DFF, F.ws + WS_W13, e * 1024 + mat, 2, W13_SCALE, scr, r % I_E13, lane_o); }
        else { const int r = it - N_W13, e = r / I_E2; p0_transpose_item_fp8<DEEP>(FIN(I_W2) + (size_t)e * DFF * D, DFF, D, F.ws + WS_W2, e * 2048, 1, W2_SCALE, scr, r % I_E2, lane_o); }
    }
}
__device__ __forceinline__ void p0_prologue(Frame& F) {
    LAS unsigned* scr = (LAS unsigned*)(F.lds + RING_OFF + F.wave * 16384);
    const int gw = F.vcu * NWAVES + F.wave, NGW = F.G * NWAVES;
    for (int it = gw; it < I_IN + I_GT; it += NGW) {
        if (it < I_IN) p0_transpose_item_fp8(FIN(I_WIN), D, NQKV, F.ws + WS_BT1, 0, 1, W1_SCALE, scr, it, F.lane);
        else p0_transpose_item_fp8(FIN(I_WGATE), D, NGATE, F.ws + WS_BT1, NQKV, 1, W1_SCALE, scr, it - I_IN, F.lane);
    }
    for (int m = gw; m < M + BATCH * MEML; m += NGW) {
        if (m < M) rms_row_to_fp8(FIN(I_X) + (size_t)m * D, FIN(I_GMIX), F.ws + WS_H + (size_t)m * D, F.lane);
        else rms_row_to_bf16(FIN(I_MEM) + (size_t)(m - M) * D, FIN(I_GMEM), (bf16*)(F.ws + WS_MEMN) + (size_t)(m - M) * D, F.lane);
    }
    { bf16* w3 = (bf16*)(F.ws + WS_W3); const float* wre = FIN(I_WRE); const float* wrg = FIN(I_WRG); const float* gmo = FIN(I_GMOE);
      for (int i = (F.vcu * NWAVES + F.wave) * 64 + F.lane; i < 4 * 256 * 512; i += F.G * NWAVES * 64) { const int kk = i & 511, n = (i >> 9) & 255, kq = i >> 17, k = kq * 512 + kk, c = n >> 2, sp = n & 3; unsigned v = 0u;
          if (c < 36 && sp < 3) { const float w = gmo[k] * (c < 32 ? wre[k * 32 + c] : wrg[k * 4 + (c - 32)]); const unsigned t0 = f2bf(w); const float r1 = w - __builtin_bit_cast(float, t0 << 16);
              const unsigned t1 = f2bf(r1); const float r2 = r1 - __builtin_bit_cast(float, t1 << 16); v = sp == 0 ? t0 : (sp == 1 ? t1 : f2bf(r2)); }
          w3[i] = (bf16)v; } }
    float* tabA = (float*)(F.ws + WS_TAB); float* tabB = tabA + 16 * TABW;
    const int gt = (F.vcu * NWAVES + F.wave) * 64 + F.lane, NGT = F.G * NWAVES * 64;
    for (int i = gt; i < 16 * TABW + 36 * TABW; i += NGT) {
        if (i < 16 * TABW) { const int hd = i / TABW, d = i % TABW; tabA[i] = (d <= 127) ? FIN(I_RELB)[t5_bucket_dev(d) * 28 + hd] * LOG2E : NEGBIG; }
        else { const int j = i - 16 * TABW, p = j / (12 * TABW), hd = (j / TABW) % 12, d = j % TABW; const int r = (p == 0) ? 1 : (p == 1 ? 4 : 16);
            tabB[j] = (d <= 128) ? FIN(I_RELB)[t5_bucket_dev(d * r) * 28 + 16 + hd] * LOG2E : NEGBIG; }
    }
}

__device__ __forceinline__ void fill_tab(LAS float* tab, const float* gtab, int maxoff, int lane) {
#pragma unroll
    for (int j = 0; j < 4; ++j) { const int idx = lane + 64 * j, d = idx - 32; tab[idx] = (d >= 0 && d <= maxoff) ? gtab[d] : NEGBIG; }
    LDS_WAIT();
}
template <int NDT> __device__ __forceinline__ void store_o_global_fp8(const f32x16 (&O)[NDT], float inv_l, unsigned char* rowp, int h) {
#pragma unroll
    for (int dt = 0; dt < NDT; ++dt)
#pragma unroll
        for (int g = 0; g < 4; ++g) *(unsigned*)(rowp + 32 * dt + 8 * g + 4 * h) = cvt4_fp8(O[dt][4 * g] * inv_l, O[dt][4 * g + 1] * inv_l, O[dt][4 * g + 2] * inv_l, O[dt][4 * g + 3] * inv_l);
}
template <int NDT> __device__ __forceinline__ void store_o_global(const f32x16 (&O)[NDT], float inv_l, bf16* rowp, int h) {
#pragma unroll
    for (int dt = 0; dt < NDT; ++dt)
#pragma unroll
        for (int g = 0; g < 4; ++g) { v2u w; w.x = pg8::cvt_pk_bf16(O[dt][4 * g] * inv_l, O[dt][4 * g + 1] * inv_l); w.y = pg8::cvt_pk_bf16(O[dt][4 * g + 2] * inv_l, O[dt][4 * g + 3] * inv_l);
            *(v2u*)(rowp + 32 * dt + 8 * g + 4 * h) = w; }
}
__device__ __forceinline__ void p2_attention(Frame& F) {
    const bf16* qkv = (const bf16*)(F.ws + WS_QKV);
    unsigned char* oab = F.ws + WS_OA;
    const float* tabA = (const float*)(F.ws + WS_TAB); const float* tabB = tabA + 16 * TABW;
    LAS float* tab = (LAS float*)(F.lds + ATT_TAB_OFF + F.wave * 1024);
    LAS unsigned char* vst = F.lds + ATT_V_OFF + F.wave * ATT_V_WAVE64; LAS unsigned char* kst = F.lds + ATT_K_OFF64 + F.wave * ATT_K_WAVE64;
    LAS unsigned char* OB = F.lds + ATT_OB_OFF; LAS float* LSE = (LAS float*)(F.lds + ATT_LSE_OFF);
    const int lane = F.lane, w = F.wave, q = lane & 31, h = lane >> 5;
    constexpr int NBU = BATCH * 12 * 16, NAU = BATCH * 64 * 4;
    const int v = F.vcu, bal = (F.G == 256);
    for (int ui = 0; ; ++ui) {
        int L;
        if (bal) { if (ui > 3) break; if (v < 128) { if (ui == 3) break; L = ui == 0 ? v : (ui == 1 ? v + 128 : NBU + v); } else L = ui == 0 ? v + 128 : NBU + 128 + 3 * (v - 128) + (ui - 1); }
        else { L = v + ui * F.G; if (L >= NBU + NAU) break; }
        const bool isB = L < NBU;
        int b, hd = 0, t0 = 0, qblk = 0, hk = 0;
        if (isB) { b = L / 192; hd = (L / 16) % 12; t0 = (L % 16) * 512; } else { const int LA = L - NBU; b = LA / 256; qblk = (LA / 4) % 64; hk = LA % 4; }
        unsigned char* OB2 = F.ws + WS_ATT2 + (size_t)(isB ? L : 0) * ATT2_UNIT; float* LSE2 = (float*)(OB2 + 65536);
        const long brow = (long)b * SEQ;
        const int njobs = isB ? 6 : 2;
#pragma unroll 1
        for (int jj = 0; jj < njobs; ++jj) {
            AttnJob J; J.ldq = NQKV; J.ldkv = NQKV;
            int mode, p = 0, qs0 = 0, qsm = 0, maxoff = 128; const float* gtab;
            if (isB) {
                J.q = qkv + C_QB + hd * 64; J.k = qkv + C_KB + hd * 64; J.v = qkv + C_VB + hd * 64; J.m_init = 0.f; J.l_init = 0.f;
                if (jj < 2) { const int j = w + 8 * jj, c = j >> 2, n = j & 3; mode = 1; p = 1; J.i0 = t0 / 4 + 32 * n; J.qrow0 = brow + t0 + c + 128 * n; J.qstride = 4; J.qmask = 31; J.krow0 = brow + c; J.kstride = 4;
                    J.u_begin = (J.i0 - 128) > 0 ? (J.i0 - 128) : 0; J.ntiles = (J.i0 + 32 - J.u_begin) / 32; qs0 = c + 128 * n; qsm = 4; }
                else if (jj < 4) { const int c = w + 8 * (jj - 2); mode = 1; p = 2; J.i0 = t0 / 16; J.qrow0 = brow + t0 + c; J.qstride = 16; J.qmask = 31; J.krow0 = brow + c; J.kstride = 16;
                    J.u_begin = (J.i0 - 128) > 0 ? (J.i0 - 128) : 0; J.ntiles = (J.i0 + 32 - J.u_begin) / 32; qs0 = c; qsm = 16; }
                else { if (jj == 4) { VM_WAIT(); __syncthreads(); }
                    mode = 2; p = 0; J.i0 = t0 + 32 * (w + 8 * (jj - 4)); J.qrow0 = brow + J.i0; J.qstride = 1; J.qmask = 31; J.krow0 = brow; J.kstride = 1;
                    J.u_begin = (J.i0 - 128) > 0 ? (J.i0 - 128) : 0; J.ntiles = (J.i0 + 32 - J.u_begin) / 32; }
                gtab = tabB + (p * 12 + hd) * TABW;
            } else {
                const int jid = w + 8 * jj, g = jid >> 2, qt = jid & 3; hd = hk * 4 + g; mode = 0; maxoff = 127;
                J.q = qkv + C_QA + hd * 64; J.k = qkv + C_KA + hk * 64; J.v = qkv + C_VA + hk * 64; J.m_init = FIN(I_SINK)[hd] * LOG2E; J.l_init = 1.0f;
                J.i0 = qblk * 128 + 32 * qt; J.qrow0 = brow + J.i0; J.qstride = 1; J.qmask = 31; J.krow0 = brow; J.kstride = 1;
                J.u_begin = (J.i0 - 128) > 0 ? (J.i0 - 128) : 0; J.ntiles = (J.i0 + 32 - J.u_begin) / 32;
                gtab = tabA + hd * TABW;
            }
            f32x16 O[2]; float mm, ll;
            attn_job<64, true, true>(J, tab, gtab, maxoff, vst, kst, lane, O, mm, ll);
            if (mode == 0) {
                store_o_global_fp8<2>(O, OAB_SCALE / ll, oab + (size_t)(brow + J.i0 + q) * (AW + BW) + hd * 64, h);
            } else if (mode == 1) {
                const float inv_l = 1.0f / ll; const int qs = qs0 + qsm * q;
                if (p == 1) { LAS unsigned char* op = OB + qs * 128;
#pragma unroll
                    for (int dt = 0; dt < 2; ++dt)
#pragma unroll
                        for (int g = 0; g < 4; ++g) { v2u wv; wv.x = pg8::cvt_pk_bf16(O[dt][4 * g] * inv_l, O[dt][4 * g + 1] * inv_l); wv.y = pg8::cvt_pk_bf16(O[dt][4 * g + 2] * inv_l, O[dt][4 * g + 3] * inv_l);
                            *(LAS v2u*)(op + (32 * dt + 8 * g + 4 * h) * 2) = wv; }
                    if (h == 0) LSE[qs] = mm + __builtin_amdgcn_logf(ll);
                } else { unsigned char* op = OB2 + (size_t)qs * 128;
#pragma unroll
                    for (int dt = 0; dt < 2; ++dt)
#pragma unroll
                        for (int g = 0; g < 4; ++g) { v2u wv; wv.x = pg8::cvt_pk_bf16(O[dt][4 * g] * inv_l, O[dt][4 * g + 1] * inv_l); wv.y = pg8::cvt_pk_bf16(O[dt][4 * g + 2] * inv_l, O[dt][4 * g + 3] * inv_l);
                            *(v2u*)(op + (32 * dt + 8 * g + 4 * h) * 2) = wv; }
                    if (h == 0) LSE2[qs] = mm + __builtin_amdgcn_logf(ll);
                }
            } else {
                const int qs = J.i0 - t0 + q;
                const float l0 = mm + __builtin_amdgcn_logf(ll), l1 = LSE[qs], l2 = LSE2[qs];
                const float mx = fmaxf(l0, fmaxf(l1, l2)), w0 = fast_exp2(l0 - mx), w1 = fast_exp2(l1 - mx), w2 = fast_exp2(l2 - mx), inv = 1.0f / (w0 + w1 + w2);
                const float c0 = w0 * inv / ll * OAB_SCALE, c1 = w1 * inv * OAB_SCALE, c2 = w2 * inv * OAB_SCALE;
                unsigned char* rowp = oab + (size_t)(brow + J.i0 + q) * (AW + BW) + AW + hd * 64;
#pragma unroll
                for (int dt = 0; dt < 2; ++dt)
#pragma unroll
                    for (int g = 0; g < 4; ++g) { const int d = 32 * dt + 8 * g + 4 * h;
                        const v2u a = *(const LAS v2u*)(OB + (qs) * 128 + d * 2), c = *(const v2u*)(OB2 + (size_t)qs * 128 + d * 2);
                        const float r0 = c0 * O[dt][4 * g] + c1 * bf_lo(a.x) + c2 * bf_lo(c.x), r1 = c0 * O[dt][4 * g + 1] + c1 * bf_hi(a.x) + c2 * bf_hi(c.x);
                        const float r2 = c0 * O[dt][4 * g + 2] + c1 * bf_lo(a.y) + c2 * bf_lo(c.y), r3 = c0 * O[dt][4 * g + 3] + c1 * bf_hi(a.y) + c2 * bf_hi(c.y);
                        *(unsigned*)(rowp + d) = cvt4_fp8(r0, r1, r2, r3); }
            }
        }
        if (isB) __syncthreads();
    }
}

__device__ __forceinline__ void p6_cross_attention(Frame& F) {
    const bf16* qx = (const bf16*)(F.ws + WS_QX); const bf16* kvx = (const bf16*)(F.ws + WS_KVX); bf16* ox = (bf16*)(F.ws + WS_OX);
    LAS unsigned char* vst = F.lds + ATT_V_OFF + F.wave * ATT_V_WAVE128; LAS unsigned char* kst = F.lds + ATT_K_OFF128 + F.wave * ATT_K_WAVE128;
    const int lane = F.lane, q = lane & 31, h = lane >> 5;
    for (int jid = F.vcu * NWAVES + F.wave; jid < BATCH * 4 * 256; jid += F.G * NWAVES) {
        const int b = jid / 1024, hd = (jid / 256) % 4, qt = jid % 256;
        AttnJob J; J.q = qx + hd * 128; J.q2 = (const bf16*)(F.ws + WS_QX2) + hd * 128; J.ldq = XW; J.qrow0 = (long)b * SEQ + 32 * qt; J.qstride = 1; J.qmask = 31;
        J.k = kvx + hd * 128; J.v = kvx + XW + hd * 128; J.ldkv = 2 * XW; J.krow0 = (long)b * MEML; J.kstride = 1; J.i0 = 0; J.u_begin = 0; J.ntiles = MEML / 32; J.m_init = 0.f; J.l_init = 0.f;
        f32x16 O[4]; float mm, ll;
        attn_job<128, false, false, true>(J, nullptr, nullptr, 0, vst, kst, lane, O, mm, ll);
        store_o_global<4>(O, 1.0f / ll, ox + (size_t)(J.qrow0 + q) * XW + hd * 128, h);
    }
}

constexpr int RT_XS_STRIDE = 260, RT_XS_BUF = 64 * 260;
constexpr int RT_EP_OFF = 0, RT_GP_OFF = 32768, RT_SS_OFF = 36864, RT_CNT_OFF = 37120;
constexpr int RT_WG_OFF = 2 * RT_XS_BUF * 4;
constexpr size_t TAB_WRE2 = 65536;
__device__ __forceinline__ void p8_topk(Frame& F) {
    const float* part = (const float*)(F.ws + WS_PART); const float* ssq = (const float*)(F.ws + WS_SSQ);
    int* tok_e = (int*)(F.ws + WS_ROUTE + RT_E); float* tok_w = (float*)(F.ws + WS_ROUTE + RT_W); int* tok_slot = (int*)(F.ws + WS_ROUTE + RT_SLOT); float* rstd2 = (float*)(F.ws + WS_ROUTE + RT_RSTD);
    unsigned* gcnt = (unsigned*)(F.ctl + CW_CNT);
    LAS int* cnt = (LAS int*)(F.lds + RT_CNT_OFF); LAS int* cbase = cnt + 32;
    const int tid = F.tid, w = F.wave, lane = F.lane;
    { int* row_tok = (int*)(F.ws + WS_ROUTE + RT_ROWTOK); for (int i = (F.vcu * NWAVES + w) * 64 + lane; i < MAXPANEL * 256; i += F.G * NWAVES * 64) row_tok[i] = 0; }
    constexpr size_t QS = (size_t)M * 36;
    for (int blk = F.vcu; blk < M / 64; blk += F.G) {
        const int r0 = blk * 64;
        __syncthreads();
        if (tid < 32) cnt[tid] = 0;
        __syncthreads();
        int e0 = 0, e1 = 0; float gw0 = 0.f, gw1 = 0.f;
        if (tid < 64) {
            const int t = r0 + tid; float s = 0.f;
#pragma unroll
            for (int j = 0; j < 8; ++j) { const f32x4 p = *(const f32x4*)(ssq + (size_t)t * 32 + 4 * j); s += (p[0] + p[1]) + (p[2] + p[3]); }
            const float rs = 1.0f / sqrtf(s * (1.0f / D) + EPS);
            const float* pt = part + (size_t)t * 36;
            f32x4 g4 = *(const f32x4*)(pt + 32);
#pragma unroll
            for (int q = 1; q < 4; ++q) g4 += *(const f32x4*)(pt + q * QS + 32);
            float gl[4] = {g4[0] * rs, g4[1] * rs, g4[2] * rs, g4[3] * rs};
            int gi = 0; float gmx = gl[0];
#pragma unroll
            for (int j = 1; j < 4; ++j) if (gl[j] > gmx) { gmx = gl[j]; gi = j; }
            float gden = 0.f;
#pragma unroll
            for (int j = 0; j < 4; ++j) gden += expf(gl[j] - gmx);
            const float ggate = 1.0f / gden;
            f32x4 ea = *(const f32x4*)(pt + gi * 8), eb = *(const f32x4*)(pt + gi * 8 + 4);
#pragma unroll
            for (int q = 1; q < 4; ++q) { ea += *(const f32x4*)(pt + q * QS + gi * 8); eb += *(const f32x4*)(pt + q * QS + gi * 8 + 4); }
            const float el[8] = {ea[0] * rs, ea[1] * rs, ea[2] * rs, ea[3] * rs, eb[0] * rs, eb[1] * rs, eb[2] * rs, eb[3] * rs};
            int i0 = 0; float v0 = el[0];
#pragma unroll
            for (int j = 1; j < 8; ++j) if (el[j] > v0) { v0 = el[j]; i0 = j; }
            int i1 = -1; float v1 = -3.0e38f;
#pragma unroll
            for (int j = 0; j < 8; ++j) if (j != i0 && el[j] > v1) { v1 = el[j]; i1 = j; }
            const float p1 = expf(v1 - v0), den = 1.0f + p1;
            gw0 = ggate / den; gw1 = ggate * p1 / den; e0 = gi * 8 + i0; e1 = gi * 8 + i1;
            rstd2[t] = rs;
        }
        int s0 = 0, s1 = 0;
        if (tid < 64) { s0 = __hip_atomic_fetch_add(&cnt[e0], 1, __ATOMIC_RELAXED, __HIP_MEMORY_SCOPE_WORKGROUP); s1 = __hip_atomic_fetch_add(&cnt[e1], 1, __ATOMIC_RELAXED, __HIP_MEMORY_SCOPE_WORKGROUP); }
        __syncthreads();
        if (tid < 32) cbase[tid] = (int)__hip_atomic_fetch_add(&gcnt[tid], (unsigned)cnt[tid], __ATOMIC_RELAXED, __HIP_MEMORY_SCOPE_AGENT);
        __syncthreads();
        if (tid < 64) { const int t = r0 + tid;
            tok_e[2 * t] = e0; tok_e[2 * t + 1] = e1; tok_w[2 * t] = gw0; tok_w[2 * t + 1] = gw1; tok_slot[2 * t] = cbase[e0] + s0; tok_slot[2 * t + 1] = cbase[e1] + s1; }
    }
}
struct OneUnit {
    int pm, pn;
    __device__ __forceinline__ bool next(int i, pg8::Unit& u) const { if (i) return false; u.pm = pm; u.pn = pn; return true; }
    __device__ __forceinline__ void a_ready(const pg8::Unit&) const {}
    __device__ __forceinline__ void done(const pg8::Unit&) const {}
};

__device__ __forceinline__ int build_panels(Frame& F, LAS int* pexp, LAS int* pstart) {
    LAS int* cnts = pstart + 64;
    if (F.tid < NEXP) cnts[F.tid] = (int)__hip_atomic_load((const unsigned*)(F.ctl + CW_CNT) + F.tid, __ATOMIC_RELAXED, __HIP_MEMORY_SCOPE_AGENT);
    __syncthreads();
    if (F.tid == 0) {
        int row = 0, np = 0;
        for (int e = 0; e < NEXP; ++e) { const int c = cnts[e]; pstart[e] = row; const int npan = (c + 255) / 256;
            for (int j = 0; j < npan; ++j) pexp[np + j] = e; np += npan; row += npan * 256; }
        pstart[NEXP] = np;
    }
    __syncthreads();
    return pstart[NEXP];
}

__device__ __forceinline__ void p9_rowmap(Frame& F) {
    LAS int* pexp = (LAS int*)(F.lds + PEXP_OFF); LAS int* pstart = pexp + MAXPANEL;
    build_panels(F, pexp, pstart);
    const int* tok_e = (const int*)(F.ws + WS_ROUTE + RT_E); const int* tok_slot = (const int*)(F.ws + WS_ROUTE + RT_SLOT); int* tok_dest = (int*)(F.ws + WS_ROUTE + RT_DEST);
    const float* rstd2 = (const float*)(F.ws + WS_ROUTE + RT_RSTD); float* rsort = (float*)(F.ws + WS_ROUTE + RT_RSORT); int* row_tok = (int*)(F.ws + WS_ROUTE + RT_ROWTOK);
    for (int a = (F.vcu * NWAVES + F.wave) * 64 + F.lane; a < 2 * M; a += F.G * NWAVES * 64) {
        const int t = a >> 1, dest = pstart[tok_e[a]] + tok_slot[a];
        tok_dest[a] = dest; row_tok[dest] = t; rsort[dest] = rstd2[t];
    }
}

struct MoeOrder {
    int npanel, ntile, G, c; const LAS int* pexp;
    __device__ __forceinline__ bool next(int i, pg8::Unit& u) const { const long L = (long)i * G + c; if (L >= (long)npanel * ntile) return false; const int pm = (int)(L / ntile), j = (int)(L % ntile); u.pm = pm; u.pn = pexp[pm] * ntile + j; return true; }
    __device__ __forceinline__ void a_ready(const pg8::Unit&) const {}
    __device__ __forceinline__ void done(const pg8::Unit&) const {}
};

__device__ __forceinline__ float fp8_to_f32(unsigned b) { const float v = __builtin_bit_cast(float, (b & 0x7Fu) << 20) * 1.329227995784916e36f; return (b & 0x80u) ? -v : v; }
__device__ __forceinline__ f32x4 fp8x4_to_f32(unsigned w) { return (f32x4){fp8_to_f32(w & 0xFFu), fp8_to_f32((w >> 8) & 0xFFu), fp8_to_f32((w >> 16) & 0xFFu), fp8_to_f32(w >> 24)}; }
template <bool MOE, bool XBF = false> __device__ __forceinline__ void p12_final(Frame& F, const float* x2, const bf16* tap = nullptr, int tap_ld = 0, int tap_cols = 0) { const bf16* y = (const bf16*)(F.ws + WS_Y);
    const int* tok_dest = (const int*)(F.ws + WS_ROUTE + RT_DEST); const float* tok_w = (const float*)(F.ws + WS_ROUTE + RT_W);
    const float* gf = FIN(I_GFIN);
    for (int t = F.vcu * NWAVES + F.wave; t < M; t += F.G * NWAVES) {
        int d0 = 0, d1 = 0; float w0 = 0.f, w1 = 0.f; if (MOE) { d0 = tok_dest[2 * t]; d1 = tok_dest[2 * t + 1]; w0 = tok_w[2 * t]; w1 = tok_w[2 * t + 1]; }
        const f32x4* xr = (const f32x4*)(x2 + (size_t)t * D) + F.lane; const v2u* y0 = (const v2u*)(y + (size_t)d0 * D) + F.lane; const v2u* y1 = (const v2u*)(y + (size_t)d1 * D) + F.lane;
        f32x4 v[8]; float s = 0.f;
#pragma unroll
        for (int j = 0; j < 8; ++j) { f32x4 xv; if (XBF) { const v2u xb = ((const v2u*)((const bf16*)x2 + (size_t)t * D) + F.lane)[64 * j]; xv = (f32x4){bf_lo(xb.x), bf_hi(xb.x), bf_lo(xb.y), bf_hi(xb.y)}; } else xv = xr[64 * j]; if (MOE) {
#ifdef MK_NT12
            const v2u a = __builtin_nontemporal_load(y0 + 64 * j), b = __builtin_nontemporal_load(y1 + 64 * j);
#else
            const v2u a = y0[64 * j], b = y1[64 * j];
#endif

            xv[0] += w0 * bf_lo(a.x) + w1 * bf_lo(b.x); xv[1] += w0 * bf_hi(a.x) + w1 * bf_hi(b.x); xv[2] += w0 * bf_lo(a.y) + w1 * bf_lo(b.y); xv[3] += w0 * bf_hi(a.y) + w1 * bf_hi(b.y); }
            if (tap) { const int col = 4 * (F.lane + 64 * j); if (col < tap_cols) { const v2u a = *(const v2u*)(tap + (size_t)t * tap_ld + col); xv[0] += bf_lo(a.x); xv[1] += bf_hi(a.x); xv[2] += bf_lo(a.y); xv[3] += bf_hi(a.y); } }
            v[j] = xv; s += (xv[0] * xv[0] + xv[1] * xv[1]) + (xv[2] * xv[2] + xv[3] * xv[3]); }
        const float rstd = 1.0f / sqrtf(wave_sum(s) * (1.0f / D) + EPS);
        f32x4* orow = (f32x4*)(F.out + (size_t)t * D) + F.lane; const f32x4* gr = (const f32x4*)gf + F.lane;
#pragma unroll
        for (int j = 0; j < 8; ++j) {
#ifdef MK_NT12
            __builtin_nontemporal_store(v[j] * rstd * gr[64 * j], orow + 64 * j);
#else
            orow[64 * j] = v[j] * rstd * gr[64 * j];
#endif
        }
    }
}

#ifndef MK_PER_PHASE
#define MK_PER_PHASE 0
#endif
#ifndef MK_STOP_AFTER
#define MK_STOP_AFTER 11
#endif
#ifndef MK_REPEAT_MASK
#define MK_REPEAT_MASK 0
#endif
#ifndef MK_RT_PROBE
#define MK_RT_PROBE 0
#endif
#if MK_RT_PROBE
#define MK_REPS(k) (1 + ((rep_mask >> (k)) & 1))
#else
#define MK_REPS(k) (1 + ((MK_REPEAT_MASK >> (k)) & 1))
#endif
#ifndef MK_STAMP_BASE
#define MK_STAMP_BASE 0
#endif
#ifndef MK_NG1
#define MK_NG1 248
#endif
constexpr int NG1 = MK_NG1;
constexpr int NPHASE = 13;
#ifndef MK_DEEPS
#define MK_DEEPS true
#endif
#ifndef MK_DEEP10
#define MK_DEEP10 true
#endif
#ifndef MK_C1
#define MK_C1 0
#define MK_C3 4096
#define MK_C4 4096
#define MK_C5 0
#define MK_C7 0
#endif
constexpr int CV_1 = MK_C1, CV_3 = CV_1 + MK_C3, CV_4 = CV_3 + MK_C4, CV_5 = CV_4 + MK_C5, CV_7 = CV_5 + MK_C7;
static_assert(CV_7 >= N_W13 && CV_7 <= N_WEXP, "w1 / w3 are complete before P10");


__global__ void __launch_bounds__(NWAVES * 64, 2) mega_fwd(Args args) {
    extern __shared__ __attribute__((aligned(16))) unsigned char lds[];
    Frame F;
    F.lds = (LAS unsigned char*)lds;
    F.MISC = (volatile LAS unsigned*)(F.lds + MISC_OFF);
    F.tid = threadIdx.x; F.lane = F.tid & 63; F.wave = __builtin_amdgcn_readfirstlane(F.tid >> 6);
    F.G = gridDim.x; { const int bx = blockIdx.x; F.vcu = (F.G % 8 == 0) ? (bx % 8) * (F.G / 8) + bx / 8 : bx; }
    F.ws = args.ws; F.ctl = (gu32*)(args.ws + WS_CTL); F.out = args.out;
    if (F.tid < 16) F.MISC[F.tid] = 0u;
    if (F.tid == 0) {
#pragma unroll
        for (int i = 0; i < 24; ++i) { const unsigned long long pv = (unsigned long long)args.in[i]; F.MISC[16 + 2 * i] = (unsigned)pv; F.MISC[17 + 2 * i] = (unsigned)(pv >> 32); } }
    __syncthreads();
    const int lo = args.ph_lo, hi = args.ph_hi; const int rep_mask = __builtin_amdgcn_readfirstlane(args.rep_mask); (void)rep_mask;
    XcdBarrier bar; bar.bar = (unsigned*)(F.ctl + CW_BAR); bar.x = 0; bar.st = nullptr;
    if (hi - lo > 1) bar = xcd_barrier_post((unsigned*)(F.ctl + CW_BAR), F.MISC + 8);
#define IN(k) (lo <= (k) && (k) < hi && ((k) <= MK_STOP_AFTER || (k) == 12))
#define INR(k) (lo <= (k) && (k) < hi)
#ifdef MK_STAMP_PHASE
    unsigned long long st_t0 = __builtin_amdgcn_s_memrealtime(), st_tk = 0;
#define SEAM(k) do { if (INR(k) && INR((k) + 1) && (k) <= MK_STOP_AFTER) xcd_barrier(bar); if ((k) == MK_STAMP_PHASE - 1 && MK_STAMP_PHASE != 13) st_t0 = __builtin_amdgcn_s_memrealtime(); if ((k) == MK_STAMP_PHASE) st_tk = __builtin_amdgcn_s_memrealtime(); } while (0)
#else
#define SEAM(k) do { if (INR(k) && INR((k) + 1) && (k) <= MK_STOP_AFTER) xcd_barrier(bar); } while (0)
#endif
    LAS unsigned char* ring = F.lds + RING_OFF;
    LAS int* pexp = (LAS int*)(F.lds + PEXP_OFF); LAS int* pstart = pexp + MAXPANEL;

    for (int rep_ = 0; rep_ < MK_REPS(0); ++rep_) { if (rep_) xcd_barrier(bar); if (IN(0)) { p0_prologue(F); } } SEAM(0);

    for (int rep_ = 0; rep_ < MK_REPS(1); ++rep_) { if (rep_) xcd_barrier(bar); if (IN(1)) {
        const int G1 = F.G > NG1 ? NG1 : F.G / 2;
        if ((int)blockIdx.x < G1) {
            pg8::Gemm g{(const bf16*)(F.ws + WS_H), (const bf16*)(F.ws + WS_BT1), M, NB1, D / 2}; pg8::StaticOrder S; S.init(M, NB1, G1, (int)blockIdx.x);
            EpiQKVG E{(bf16*)(F.ws + WS_QKV), (bf16*)(F.ws + WS_GA), (bf16*)(F.ws + WS_GB), FIN(I_BGATE)};
            pg8::gemm_phase<EpiQKVG, pg8::StaticOrder, true, true, 2, true>(ring, g, S, E);
        } else { p0_convert_rest<0>(F, (int)blockIdx.x - G1, F.G - G1); p0_convert_rest<1>(F, (int)blockIdx.x - G1, F.G - G1); convert_w(F, 0, CV_1, ((int)blockIdx.x - G1) * NWAVES + F.wave, (F.G - G1) * NWAVES); }
    } } SEAM(1);

    for (int rep_ = 0; rep_ < MK_REPS(2); ++rep_) { if (rep_) xcd_barrier(bar); if (IN(2)) { p2_attention(F); } } SEAM(2);

    for (int rep_ = 0; rep_ < MK_REPS(3); ++rep_) { if (rep_) xcd_barrier(bar); if (IN(3)) {
        pg8::Gemm g{(const bf16*)(F.ws + WS_OA), (const bf16*)(F.ws + WS_WA), M, D, (AW + BW) / 2}; pg8::StaticOrder S; S.init(M, D, F.G, (int)blockIdx.x);
        EpiMix E{(const bf16*)(F.ws + WS_GA), (const bf16*)(F.ws + WS_GB), F.ws + WS_MIX8};
        const int grp = ((int)blockIdx.x >> 3) & 1, wsl = ((((int)blockIdx.x >> 4) << 3) + ((int)blockIdx.x & 7)) * NWAVES + F.wave, nws = (F.G >> 1) * NWAVES;
        if (grp) { convert_w<MK_DEEPS>(F, CV_1, CV_3, wsl, nws); __syncthreads(); }
        pg8::gemm_phase<EpiMix, pg8::StaticOrder, true, true, 2, true>(ring, g, S, E);
    } } SEAM(3);

    for (int rep_ = 0; rep_ < MK_REPS(4); ++rep_) { if (rep_) xcd_barrier(bar); if (IN(4)) {
#ifdef MK_STAG4
        if (((int)blockIdx.x >> 3) & 1) { const unsigned long long t0_ = __builtin_amdgcn_s_memrealtime(); while (__builtin_amdgcn_s_memrealtime() - t0_ < (unsigned long long)(MK_STAG4) * 100ull) __builtin_amdgcn_s_sleep(8); }
#endif
        pg8::Gemm g{(const bf16*)(F.ws + WS_MIX8), (const bf16*)(F.ws + WS_WO), M, D, D / 2}; pg8::StaticOrder S; S.init(M, D, F.G, (int)blockIdx.x);
        EpiResid E{FIN(I_X), (bf16*)(F.ws + WS_X1), (float*)(F.ws + WS_SSQ)};
        const int grp = ((int)blockIdx.x >> 3) & 1, wsl = ((((int)blockIdx.x >> 4) << 3) + ((int)blockIdx.x & 7)) * NWAVES + F.wave, nws = (F.G >> 1) * NWAVES;
        if (grp) { convert_w<MK_DEEPS>(F, CV_3, CV_4, wsl, nws); __syncthreads(); }
        pg8::gemm_phase<EpiResid, pg8::StaticOrder, true, true, 2, true>(ring, g, S, E);
        if (!grp) {
            const int wgi = (((int)blockIdx.x >> 4) << 3) + ((int)blockIdx.x & 7);
            if (wgi < 32) { __syncthreads(); const int kq = wgi & 3, tl = wgi >> 2;
                pg8::Gemm gk{(const bf16*)(F.ws + WS_MEMN) + kq * 512, (const bf16*)(F.ws + WS_WXKV) + kq * 512, BATCH * MEML, 2 * XW, 512}; OneUnit Sk{tl >> 2, tl & 3};
                EpiF32 Ek{(float*)(F.ws + WS_KVP) + (size_t)kq * (BATCH * MEML) * (2 * XW), 2 * XW};
                pg8::gemm_phase<EpiF32, OneUnit, true, true, 0, false, D, D>(ring, gk, Sk, Ek); } }
    } } SEAM(4);

    for (int rep_ = 0; rep_ < MK_REPS(5); ++rep_) { if (rep_) xcd_barrier(bar); if (IN(5)) {
        { const float* kvp = (const float*)(F.ws + WS_KVP); bf16* kvx = (bf16*)(F.ws + WS_KVX); constexpr int NKV = BATCH * MEML * 2 * XW;
          for (int i = ((int)blockIdx.x * (NWAVES * 64) + F.tid) * 4; i < NKV; i += F.G * NWAVES * 64 * 4) {
              const f32x4 s4 = (*(const f32x4*)(kvp + i) + *(const f32x4*)(kvp + NKV + i)) + (*(const f32x4*)(kvp + 2 * NKV + i) + *(const f32x4*)(kvp + 3 * NKV + i));
              v2u o; o.x = pg8::cvt_pk_bf16(s4[0], s4[1]); o.y = pg8::cvt_pk_bf16(s4[2], s4[3]); *(v2u*)(kvx + i) = o; } }
#pragma unroll 1
        for (int L = (int)blockIdx.x; L < 2 * (M / 256) * (XW / 256); L += F.G) { const int half = L / ((M / 256) * (XW / 256));
            pg8::StaticOrder So; So.init(M, XW, (M / 256) * (XW / 256), L % ((M / 256) * (XW / 256))); pg8::Unit u0; So.next(0, u0);
            pg8::Gemm g{(const bf16*)(F.ws + WS_X1) + half * (D / 2), (const bf16*)(F.ws + WS_WXQ) + half * (D / 2), M, XW, D / 2}; OneUnit S{u0.pm, u0.pn};
            EpiQx E{(bf16*)(F.ws + (half ? WS_QX2 : WS_QX)), (const float*)(F.ws + WS_SSQ), 0.08838834764831845f * LOG2E};
            pg8::gemm_phase<EpiQx, OneUnit, true, true, 0, false, D, D>(ring, g, S, E); }
    } } SEAM(5);

    for (int rep_ = 0; rep_ < MK_REPS(6); ++rep_) { if (rep_) xcd_barrier(bar); if (IN(6)) { p6_cross_attention(F); } } SEAM(6);

    for (int rep_ = 0; rep_ < MK_REPS(7); ++rep_) { if (rep_) xcd_barrier(bar); if (IN(7)) {
        pg8::Gemm g{(const bf16*)(F.ws + WS_OX), (const bf16*)(F.ws + WS_WXO), M, D, XW}; pg8::StaticOrder S; S.init(M, D, F.G, (int)blockIdx.x);
        EpiResid2 E{(bf16*)(F.ws + WS_X1), F.ws + WS_HM, FIN(I_GMOE), (float*)(F.ws + WS_SSQ)};
        const int grp = ((int)blockIdx.x >> 3) & 1, wsl = ((((int)blockIdx.x >> 4) << 3) + ((int)blockIdx.x & 7)) * NWAVES + F.wave, nws = (F.G >> 1) * NWAVES;
        if (grp) { convert_w<MK_DEEPS>(F, CV_5, CV_7, wsl, nws); __syncthreads(); }
        pg8::gemm_phase<EpiResid2, pg8::StaticOrder, true, true>(ring, g, S, E);
    } } SEAM(7);

    for (int rep_ = 0; rep_ < MK_REPS(8); ++rep_) { if (rep_) xcd_barrier(bar); if (IN(8)) {
#pragma unroll 1
        for (int L = (int)blockIdx.x; L < 4 * (M / 256); L += F.G) { const int pm = L >> 2, kq = L & 3;
            pg8::Gemm g{(const bf16*)(F.ws + WS_X1) + kq * 512, (const bf16*)(F.ws + WS_W3), M, 256, 512}; OneUnit S{pm, kq};
            EpiLogit E{(float*)(F.ws + WS_PART) + (size_t)kq * M * 36};
            pg8::gemm_phase<EpiLogit, OneUnit, true, true, 0, false, D>(ring, g, S, E); }
        xcd_barrier(bar);
        p8_topk(F);
    } } SEAM(8);
    for (int rep_ = 0; rep_ < MK_REPS(9); ++rep_) { if (rep_) xcd_barrier(bar); if (IN(9)) { p9_rowmap(F); } } SEAM(9);

    for (int rep_ = 0; rep_ < MK_REPS(10); ++rep_) { if (rep_) xcd_barrier(bar); if (IN(10)) {
        const int np = build_panels(F, pexp, pstart);
        {
            const int ntot = np * 4, R = (ntot + F.G - 1) / F.G, hv = ntot - (R - 1) * F.G, nl = F.G - hv;
            int wsl = F.vcu * NWAVES + F.wave, nws = F.G * NWAVES, hi = N_WEXP;
            if (nl * NWAVES * 4 >= N_WEXP - CV_7) { nws = nl * NWAVES; if (F.vcu >= hv) wsl = (F.vcu - hv) * NWAVES + F.wave; else { wsl = 0; hi = CV_7; } }
            convert_w<MK_DEEP10>(F, CV_7, hi, wsl, nws); __syncthreads();
        }
        pg8::Gemm g{(const bf16*)(F.ws + WS_HM), (const bf16*)(F.ws + WS_W13), MAXPANEL * 256, NEXP * 1024, D / 2}; MoeOrder S{np, 4, F.G, F.vcu, pexp};
        EpiSwiGLU E{F.ws + WS_ACT, (const float*)(F.ws + WS_ROUTE + RT_RSORT)};
        pg8::gemm_phase<EpiSwiGLU, MoeOrder, true, true, 1, true>(ring, g, S, E, (const int*)(F.ws + WS_ROUTE + RT_ROWTOK));
    } } SEAM(10);

    for (int rep_ = 0; rep_ < MK_REPS(11); ++rep_) { if (rep_) xcd_barrier(bar); if (IN(11)) {
        const int np = build_panels(F, pexp, pstart);
#ifdef MK_STAG11
        { const int ntot = np * 8, R = (ntot + F.G - 1) / F.G, hv = ntot - (R - 1) * F.G;
          if (F.vcu >= hv) { const unsigned long long t0_ = __builtin_amdgcn_s_memrealtime(); while (__builtin_amdgcn_s_memrealtime() - t0_ < (unsigned long long)(MK_STAG11) * 100ull) __builtin_amdgcn_s_sleep(8); } }
#endif
        int k2 = DFF / 2; asm volatile("" : "+s"(k2));
        pg8::Gemm g{(const bf16*)(F.ws + WS_ACT), (const bf16*)(F.ws + WS_W2), MAXPANEL * 256, NEXP * 2048, k2}; MoeOrder S{np, 8, F.G, F.vcu, pexp};
        EpiBf E{(bf16*)(F.ws + WS_Y), D, 8, 1.0f / (ACT_SCALE * W2_SCALE)};
        pg8::gemm_phase<EpiBf, MoeOrder, true, true, 2, true>(ring, g, S, E);
    } } SEAM(11);

#ifdef MK_TAP
    for (int rep_ = 0; rep_ < MK_REPS(12); ++rep_) { if (rep_) xcd_barrier(bar); if (IN(12)) { p12_final<false>(F, FIN(I_X), (const bf16*)(F.ws + (MK_TAP_OFF)), MK_TAP_LD, MK_TAP_COLS); } }
#else
    for (int rep_ = 0; rep_ < MK_REPS(12); ++rep_) { if (rep_) xcd_barrier(bar); if (IN(12)) { p12_final<(MK_STOP_AFTER >= 11), (MK_STOP_AFTER >= 4)>(F, (MK_STOP_AFTER >= 4) ? (const float*)(F.ws + WS_X1) : FIN(I_X)); } }
#endif
#ifdef MK_STAMP_PHASE
    xcd_barrier(bar);
    if (MK_STAMP_PHASE == 12) st_tk = __builtin_amdgcn_s_memrealtime();
    if (MK_STAMP_PHASE == 13) { st_tk = __builtin_amdgcn_s_memrealtime(); }
    if (blockIdx.x == 0) { for (int i = F.tid; i < 48 * D; i += NWAVES * 64) F.out[D + i] += 1.0f; }
    if (blockIdx.x == 0 && F.tid == 0) F.out[0] = MK_STAMP_BASE > 0 ? ((float)(st_tk - st_t0) * 0.01f - (float)MK_STAMP_BASE) * 0.125f : (float)(st_tk - st_t0) * (MK_STAMP_PHASE == 13 ? 0.0003125f : 0.00125f);
#endif
#undef IN
#undef INR
#undef SEAM
}

extern "C" void kernel_launch(void* const* d_in, const int* in_sizes, int n_in, void* d_out, int out_size, void* d_ws, size_t ws_size, hipStream_t stream) {
    static int grid = 0;
    if (grid == 0) {
        if (n_in != 24 || in_sizes[0] != M * D || out_size != M * D || ws_size < WS_END) { fprintf(stderr, "kernel_launch: unexpected shapes or workspace (%d inputs, ws %zu, need %zu); nothing launched\n", n_in, ws_size, (size_t)WS_END); grid = -1; return; }
        int dev = 0, cus = 0, per_cu = 0;
        if (hipGetDevice(&dev) != hipSuccess || hipDeviceGetAttribute(&cus, hipDeviceAttributeMultiprocessorCount, dev) != hipSuccess) { grid = -1; return; }
        if (hipFuncSetAttribute((const void*)mega_fwd, hipFuncAttributeMaxDynamicSharedMemorySize, LDS_BYTES) != hipSuccess) { fprintf(stderr, "kernel_launch: hipFuncSetAttribute failed\n"); grid = -1; return; }
        if (hipOccupancyMaxActiveBlocksPerMultiprocessor(&per_cu, (const void*)mega_fwd, NWAVES * 64, LDS_BYTES) != hipSuccess || per_cu < 1) { fprintf(stderr, "kernel_launch: occupancy query reports %d workgroups per CU\n", per_cu); }
        (void)hipGetLastError();
        grid = cus - cus % 16;
        if (grid < 144) { fprintf(stderr, "kernel_launch: %d CUs are too few for this kernel's phase layout\n", cus); grid = -1; return; }
    }
    if (grid < 0) return;
    if (hipMemsetAsync((char*)d_ws + WS_CTL, 0, CTL_ZERO_BYTES, stream) != hipSuccess) return;
    Args a{};
    for (int i = 0; i < 24; ++i) a.in[i] = (const float*)d_in[i];
    a.out = (float*)d_out; a.ws = (unsigned char*)d_ws; a.rep_mask = MK_REPEAT_MASK; a.pad = 0;
#if MK_PER_PHASE
    for (int p = 0; p < NPHASE; ++p) { if (p > MK_STOP_AFTER && p != 12) continue; a.ph_lo = p; a.ph_hi = p + 1; hipLaunchKernelGGL(mega_fwd, dim3(grid), dim3(NWAVES * 64), LDS_BYTES, stream, a); }
#else
    a.ph_lo = 0; a.ph_hi = NPHASE;
    hipLaunchKernelGGL(mega_fwd, dim3(grid), dim3(NWAVES * 64), LDS_BYTES, stream, a);
#endif
}
```

```cpp
#include <hip/hip_runtime.h>
#include <cstdio>
#include <cstdint>
namespace pg8 {
#define PG8_LAS __attribute__((address_space(3)))
typedef unsigned short bf16_t;
typedef short bf16x8 __attribute__((ext_vector_type(8)));
typedef float f32x4 __attribute__((ext_vector_type(4)));
typedef unsigned u32x4 __attribute__((ext_vector_type(4)));
constexpr int BM = 256, BK = 64, HALF = 128, HTB = HALF * BK * 2  , STAGE_BYTES = 8 * HTB, NXCD = 8, WGM = 8;

__host__ __device__ __forceinline__ int lds_byte(int r, int c) { const int st = (r >> 4) * 2 + (c >> 5), rr = r & 15, cc = c & 31, ob = rr * 64 + cc * 2; return st * 1024 + (ob ^ (((ob >> 9) & 1) << 5)); }
__host__ __device__ __forceinline__ void stage_rc(int b, int& R, int& C) { const int st = b / 1024, sb = b % 1024, swz = sb ^ (((sb >> 9) & 1) << 5); R = (st >> 1) * 16 + swz / 64; C = (st & 1) * 32 + (swz % 64) / 2; }
__host__ __device__ __forceinline__ int perm32(int rho) { const int n = rho >> 4, i = rho & 15; return 8 * (i >> 2) + 4 * n + (i & 3); }

struct Unit { int pm, pn; };
struct Gemm { const bf16_t* A; const bf16_t* Bt; int M, N, K; };

struct StaticOrder {
    int nM, nN, nwg, G, c;
    __host__ __device__ void init(int M, int N, int G_, int c_) { nM = M / BM; nN = N / BM; nwg = nM * nN; G = G_; c = c_; }
    __host__ __device__ __forceinline__ bool next(int i, Unit& u) const {
        const long L = (long)i * G + c; if (L >= nwg) return false;
        int wgid = (int)L; { const int q = nwg / NXCD, r = nwg % NXCD, xcd = wgid % NXCD, off = wgid / NXCD; wgid = (xcd < r ? xcd * (q + 1) : r * (q + 1) + (xcd - r) * q) + off; }
        const int nig = WGM * nN, gid = wgid / nig, fm = gid * WGM, gsz = (nM - fm) < WGM ? (nM - fm) : WGM;
        u.pm = fm + ((wgid % nig) % gsz); u.pn = (wgid % nig) / gsz; return true;
    }
    __device__ __forceinline__ void a_ready(const Unit&) const {}
    __device__ __forceinline__ void done(const Unit&) const {}
};

typedef __bf16 bf16x2_t __attribute__((ext_vector_type(2)));
__device__ __forceinline__ unsigned cvt_pk_bf16(float lo, float hi) { bf16x2_t v = {(__bf16)lo, (__bf16)hi}; return __builtin_bit_cast(unsigned, v); }
template <class Epi, class Sched, bool ALIGN_EPI = false, bool SP2 = false, int GATHER = 0  , bool FP8 = false, int LDA = 0  , int LDB = 0  >
__device__ __forceinline__ void gemm_phase(PG8_LAS unsigned char* lds, const Gemm g, const Sched& S, const Epi& E, const int* gidx = nullptr) {
    int tid_o = threadIdx.x; asm volatile("" : "+v"(tid_o));
    const int tid = tid_o, wid = __builtin_amdgcn_readfirstlane(tid >> 6), lane = tid & 63, wr = wid >> 2, wc = wid & 3, fr = lane & 15, fq = lane >> 4;
    const int K = g.K, nt = K / BK;
    unsigned voffA[2], voffB[2]; unsigned vAc[2][2] = {{0u, 0u}, {0u, 0u}};
#pragma unroll
    for (int i = 0; i < 2; ++i) { int R, C; stage_rc(tid * 16 + i * 8192, R, C); const int Rb = Epi::PERM ? ((R & ~31) + perm32(R & 31)) : R;
        voffA[i] = (unsigned)(R * (LDA ? LDA : K) + C) * 2u; voffB[i] = (unsigned)(Rb * (LDB ? LDB : K) + C) * 2u; }
    const size_t kstep = (size_t)(BK * 2);
    const size_t hstep = (size_t)HALF * K * 2;
    const size_t tstep = 2 * hstep;
    const size_t hstepA = LDA ? (size_t)HALF * LDA * 2 : hstep, tstepA = 2 * hstepA;
    const size_t hstepB = LDB ? (size_t)HALF * LDB * 2 : hstep, tstepB = 2 * hstepB;
    const unsigned ldsw = (unsigned)wid * 1024u;
    const int aoff = lds_byte(wr * 64 + fr, fq * 8), boff = lds_byte(wc * 32 + fr, fq * 8);
#define PG8_SA(b, h) (((b) * 2 + (h)) * HTB)
#define PG8_SB(b, h) ((4 + (b) * 2 + (h)) * HTB)
#define PG8_STAGE(bufoff, gbase, voff) do { _Pragma("unroll") for (int _i = 0; _i < 2; ++_i) \
        __builtin_amdgcn_global_load_lds((const unsigned*)((const char*)(gbase) + (voff)[_i]), (PG8_LAS unsigned*)(lds + (bufoff) + ldsw + _i * 8192), 16, 0, 0); } while (0)
#define PG8_STAGE_A(bufoff, gbase, half, usenext) do { if constexpr (GATHER != 0) { PG8_STAGE(bufoff, gbase, vAc[half]); } \
        else { PG8_STAGE(bufoff, (gbase) + ((half) ? hstepA : (size_t)0), voffA); } } while (0)
#define PG8_GIDX(dst, unit) do { _Pragma("unroll") for (int h_ = 0; h_ < 2; ++h_) _Pragma("unroll") for (int i_ = 0; i_ < 2; ++i_) { int R_, C_; stage_rc(tid * 16 + i_ * 8192, R_, C_); const int row_ = (unit).pm * BM + h_ * HALF + R_; dst[h_][i_] = (unsigned)((GATHER == 2 ? row_ : gidx[row_]) * K + C_) * 2u; } } while (0)
#define PG8_LDA(dst, b, h) do { _Pragma("unroll") for (int m = 0; m < 4; ++m) _Pragma("unroll") for (int k = 0; k < 2; ++k) dst[m][k] = *(const PG8_LAS bf16x8*)(lds + PG8_SA(b, h) + aoff + m * 2048 + k * 1024); } while (0)
#define PG8_LDB(dst, b, h) do { _Pragma("unroll") for (int n = 0; n < 2; ++n) _Pragma("unroll") for (int k = 0; k < 2; ++k) dst[n][k] = *(const PG8_LAS bf16x8*)(lds + PG8_SB(b, h) + boff + n * 2048 + k * 1024); } while (0)
#define PG8_MMA(ai, bj, At, Bt) do { __builtin_amdgcn_s_setprio(1); _Pragma("unroll") for (int m = 0; m < 4; ++m) _Pragma("unroll") for (int n = 0; n < 2; ++n) { \
        if constexpr (FP8) { typedef int v4i_ __attribute__((ext_vector_type(4))); typedef int v8i_ __attribute__((ext_vector_type(8))); \
            const v8i_ b8_ = __builtin_shufflevector(__builtin_bit_cast(v4i_, Bt[n][0]), __builtin_bit_cast(v4i_, Bt[n][1]), 0, 1, 2, 3, 4, 5, 6, 7); \
            const v8i_ a8_ = __builtin_shufflevector(__builtin_bit_cast(v4i_, At[m][0]), __builtin_bit_cast(v4i_, At[m][1]), 0, 1, 2, 3, 4, 5, 6, 7); \
            acc[ai][bj][m][n] = __builtin_amdgcn_mfma_scale_f32_16x16x128_f8f6f4(b8_, a8_, acc[ai][bj][m][n], 0, 0, 0, 0, 0, 0); } \
        else { _Pragma("unroll") for (int k = 0; k < 2; ++k) acc[ai][bj][m][n] = __builtin_amdgcn_mfma_f32_16x16x32_bf16(Bt[n][k], At[m][k], acc[ai][bj][m][n], 0, 0, 0); } } \
        __builtin_amdgcn_s_setprio(0); } while (0)
#define PG8_WAIT_V(n) asm volatile("s_waitcnt vmcnt(" #n ")" ::: "memory")
#define PG8_WAIT_L(n) asm volatile("s_waitcnt lgkmcnt(" #n ")" ::: "memory")
#define PG8_BAR __builtin_amdgcn_s_barrier()
#define PG8_SCHED __builtin_amdgcn_sched_barrier(0)
    Unit cur, nxt; int ui = 0;
    if (!S.next(0, cur)) return;
    f32x4 acc[2][2][4][2];
#pragma unroll
    for (int a = 0; a < 2; ++a)
#pragma unroll
        for (int b = 0; b < 2; ++b)
#pragma unroll
            for (int m = 0; m < 4; ++m)
#pragma unroll
                for (int n = 0; n < 2; ++n) acc[a][b][m][n] = (f32x4){0.f, 0.f, 0.f, 0.f};
    bf16x8 At[4][2], B0[2][2], B1[2][2];
    const char* cA = (const char*)g.A + (GATHER != 0 ? (size_t)0 : (size_t)cur.pm * tstepA); const char* cB = (const char*)g.Bt + (size_t)cur.pn * tstepB;
    S.a_ready(cur);
    if constexpr (GATHER != 0) PG8_GIDX(vAc, cur);
    if constexpr (SP2) {
        PG8_STAGE(PG8_SB(0, 0), cB, voffB); PG8_STAGE(PG8_SB(0, 1), cB + hstepB, voffB); PG8_STAGE_A(PG8_SA(0, 0), cA, 0, false); PG8_STAGE_A(PG8_SA(0, 1), cA, 1, false);
        if (wr == 1) PG8_BAR;
        PG8_WAIT_V(2); PG8_BAR;
        PG8_STAGE(PG8_SB(1, 0), cB + kstep, voffB); PG8_STAGE_A(PG8_SA(1, 0), cA + kstep, 0, false); PG8_STAGE(PG8_SB(1, 1), cB + hstepB + kstep, voffB);
        PG8_WAIT_V(6); PG8_BAR;
    } else {
        PG8_STAGE(PG8_SB(0, 0), cB, voffB); PG8_STAGE_A(PG8_SA(0, 0), cA, 0, false); PG8_STAGE(PG8_SB(0, 1), cB + hstepB, voffB); PG8_STAGE_A(PG8_SA(0, 1), cA, 1, false);
        if (wr == 1) PG8_BAR;
        PG8_WAIT_V(4); PG8_BAR;
        PG8_STAGE(PG8_SB(1, 0), cB + kstep, voffB); PG8_STAGE_A(PG8_SA(1, 0), cA + kstep, 0, false); PG8_STAGE(PG8_SB(1, 1), cB + hstepB + kstep, voffB);
        PG8_WAIT_V(6); PG8_BAR;
    }
    for (;;) {
        const bool has_next = S.next(ui + 1, nxt);
        const char* nA = has_next ? (const char*)g.A + (GATHER != 0 ? (size_t)0 : (size_t)nxt.pm * tstepA) : cA; const char* nB = has_next ? (const char*)g.Bt + (size_t)nxt.pn * tstepB : cB;
#pragma unroll 1
        for (int t = 0; t < nt; t += 2) {
            const bool last = (t == nt - 2);
            const char* a1 = cA + (size_t)(t + 1) * kstep;
            const char* a2 = last ? nA : cA + (size_t)(t + 2) * kstep; const char* b2 = last ? nB : cB + (size_t)(t + 2) * kstep;
            const char* a3 = a2 + kstep; const char* b3 = b2 + kstep;
            if constexpr (Epi::HAS_MID) { if (t == Epi::MID_T) E.mid(acc, cur, wr, wc, fr, fq); }
            if (last && has_next) S.a_ready(nxt);
            if constexpr (SP2) {
            PG8_LDB(B0, 0, 0); PG8_LDB(B1, 0, 1); PG8_SCHED; PG8_LDA(At, 0, 0); PG8_STAGE_A(PG8_SA(1, 1), a1, 1, false);
            if constexpr (GATHER != 0) { if (last && has_next) PG8_GIDX(vAc, nxt); }
            PG8_WAIT_V(8); PG8_WAIT_L(0); PG8_BAR; PG8_MMA(0, 0, At, B0); PG8_MMA(0, 1, At, B1); PG8_BAR; PG8_SCHED;
            PG8_LDA(At, 0, 1); PG8_STAGE(PG8_SB(0, 0), b2, voffB); PG8_STAGE(PG8_SB(0, 1), b2 + hstepB, voffB); PG8_STAGE_A(PG8_SA(0, 0), a2, 0, last);
            PG8_WAIT_V(8); PG8_WAIT_L(0); PG8_BAR; PG8_MMA(1, 0, At, B0); PG8_MMA(1, 1, At, B1); PG8_BAR; PG8_SCHED;
            PG8_LDB(B0, 1, 0); PG8_LDB(B1, 1, 1); PG8_SCHED; PG8_LDA(At, 1, 0); PG8_STAGE_A(PG8_SA(0, 1), a2, 1, last);
            PG8_WAIT_V(8); PG8_WAIT_L(0); PG8_BAR; PG8_MMA(0, 0, At, B0); PG8_MMA(0, 1, At, B1); PG8_BAR; PG8_SCHED;
            PG8_LDA(At, 1, 1); PG8_STAGE(PG8_SB(1, 0), b3, voffB); PG8_STAGE(PG8_SB(1, 1), b3 + hstepB, voffB); PG8_STAGE_A(PG8_SA(1, 0), a3, 0, last);
            PG8_WAIT_V(8); PG8_WAIT_L(0); PG8_BAR; PG8_MMA(1, 0, At, B0); PG8_MMA(1, 1, At, B1); PG8_BAR; PG8_SCHED;
            } else {
            PG8_LDB(B0, 0, 0); PG8_SCHED; PG8_LDA(At, 0, 0); PG8_STAGE_A(PG8_SA(1, 1), a1, 1, false);
            PG8_WAIT_L(8); PG8_BAR; PG8_WAIT_L(0); PG8_MMA(0, 0, At, B0); PG8_BAR; PG8_SCHED;
            PG8_LDB(B1, 0, 1); PG8_STAGE(PG8_SB(0, 0), b2, voffB);
            PG8_BAR; PG8_WAIT_L(0); PG8_MMA(0, 1, At, B1); PG8_BAR;
            PG8_LDA(At, 0, 1); PG8_STAGE_A(PG8_SA(0, 0), a2, 0, last);
            PG8_BAR; PG8_WAIT_L(0); PG8_MMA(1, 0, At, B0); PG8_BAR; PG8_SCHED;
            PG8_STAGE(PG8_SB(0, 1), b2 + hstepB, voffB);
            PG8_WAIT_V(6); PG8_BAR; PG8_MMA(1, 1, At, B1); PG8_BAR;
            PG8_LDB(B0, 1, 0); PG8_SCHED; PG8_LDA(At, 1, 0); PG8_STAGE_A(PG8_SA(0, 1), a2, 1, last);
            PG8_WAIT_L(8); PG8_BAR; PG8_WAIT_L(0); PG8_MMA(0, 0, At, B0); PG8_BAR; PG8_SCHED;
            PG8_LDB(B1, 1, 1); PG8_STAGE(PG8_SB(1, 0), b3, voffB);
            PG8_BAR; PG8_WAIT_L(0); PG8_MMA(0, 1, At, B1); PG8_BAR;
            PG8_LDA(At, 1, 1); PG8_STAGE_A(PG8_SA(1, 0), a3, 0, last);
            PG8_BAR; PG8_WAIT_L(0); PG8_MMA(1, 0, At, B0); PG8_BAR; PG8_SCHED;
            PG8_STAGE(PG8_SB(1, 1), b3 + hstepB, voffB);
            PG8_WAIT_V(6); PG8_BAR; PG8_MMA(1, 1, At, B1); PG8_BAR;
            }
        }
        if constexpr (ALIGN_EPI) { if (wr == 0) PG8_BAR; }
        if constexpr (!Epi::AFTER_DRAIN) { E(acc, cur, wr, wc, fr, fq); S.done(cur); }
        if (!has_next) break;
#pragma unroll
        for (int a = 0; a < 2; ++a)
#pragma unroll
            for (int b = 0; b < 2; ++b)
#pragma unroll
                for (int m = 0; m < 4; ++m)
#pragma unroll
                    for (int n = 0; n < 2; ++n) acc[a][b][m][n] = (f32x4){0.f, 0.f, 0.f, 0.f};
        cur = nxt; cA = nA; cB = nB; ++ui;
        if constexpr (ALIGN_EPI) { if (wr == 1) PG8_BAR; }
    }
    PG8_WAIT_V(0);
    if constexpr (!ALIGN_EPI) { if (wr == 0) PG8_BAR; }
    PG8_BAR;
    if constexpr (Epi::AFTER_DRAIN) { E.fused(acc, cur, wr, wc, fr, fq, lds, wid, lane); S.done(cur); }
#undef PG8_SA
#undef PG8_SB
#undef PG8_STAGE
#undef PG8_STAGE_A
#undef PG8_GIDX
#undef PG8_LDA
#undef PG8_LDB
#undef PG8_MMA
#undef PG8_WAIT_V
#undef PG8_WAIT_L
#undef PG8_BAR
#undef PG8_SCHED
}
}

#define GAS __attribute__((address_space(1)))
#define LAS __attribute__((address_space(3)))
typedef unsigned short bf16;
typedef unsigned v4u __attribute__((ext_vector_type(4)));
typedef unsigned v2u __attribute__((ext_vector_type(2)));
typedef float f32x4 __attribute__((ext_vector_type(4)));
typedef float f32x16 __attribute__((ext_vector_type(16)));
typedef short s16x8 __attribute__((ext_vector_type(8)));
typedef short s16x4 __attribute__((ext_vector_type(4)));
typedef GAS unsigned gu32;

constexpr int NWAVES = 8;
constexpr int BATCH = 2, SEQ = 8192, D = 2048, M = BATCH * SEQ;
constexpr int NQKV = 3840, NGATE = 4096, NB1 = NQKV + NGATE;
constexpr int AW = 1024, BW = 768, XW = 512, MEML = 256, NEXP = 32, DFF = 512;
constexpr int C_QA = 0, C_KA = 1024, C_VA = 1280, C_QB = 1536, C_KB = 2304, C_VB = 3072;
constexpr int MAXPANEL = 160;
constexpr float EPS = 1e-6f, LOG2E = 1.4426950408889634f, NEGBIG = -1e30f;
constexpr int TABW = 256;

constexpr size_t MiB = 1u << 20;
constexpr size_t WS_CTL = 0, CTL_ZERO_BYTES = 128 * 1024;
constexpr size_t WS_TAB = 1 * MiB, WS_ROUTE = 2 * MiB, WS_MEMN = 4 * MiB, WS_SSQ = 6 * MiB;
constexpr size_t WS_WA = 8 * MiB, WS_WB = 12 * MiB, WS_WO = 15 * MiB, WS_WXQ = 23 * MiB, WS_WXKV = 25 * MiB, WS_WXO = 29 * MiB;
constexpr size_t WS_W13 = 31 * MiB, WS_W2 = 159 * MiB, WS_X1 = 223 * MiB, WS_QKV = WS_X1, WS_U = 351 * MiB, WS_ACT = 575 * MiB, WS_END = 615 * MiB;
constexpr size_t WS_BT1 = WS_U, WS_H = WS_U + 32 * MiB, WS_GA = WS_U + 96 * MiB, WS_GB = WS_U + 160 * MiB;
constexpr size_t WS_OA = WS_U, WS_OB = WS_U + 32 * MiB, WS_XG = WS_U, WS_QX = WS_U + 64 * MiB, WS_KVX = WS_U + 80 * MiB, WS_OX = WS_U + 82 * MiB;
constexpr size_t WS_MIX8 = WS_U + 64 * MiB;
constexpr size_t WS_HM = WS_U, WS_AS = WS_U + 64 * MiB, WS_Y = WS_AS;
constexpr size_t WS_KVP = WS_U + 32 * MiB, WS_QX2 = WS_U + 40 * MiB;
constexpr size_t WS_W3 = WS_WB;
constexpr size_t WS_PART = WS_U + 64 * MiB;
constexpr size_t RT_E = 0, RT_W = 128 * 1024, RT_SLOT = 256 * 1024, RT_DEST = 384 * 1024, RT_RSTD = 512 * 1024, RT_RSORT = 576 * 1024, RT_ROWTOK = 768 * 1024;
constexpr int CW_BAR = 4096, CW_CNT = 16384;

constexpr int RING_OFF = 0, RING_BYTES = 131072, LDS_BYTES = 163840, MISC_OFF = LDS_BYTES - 2048, PEXP_OFF = MISC_OFF + 256;

#define LDS_WAIT() asm volatile("s_waitcnt lgkmcnt(0)" ::: "memory")
#define VM_WAIT() asm volatile("s_waitcnt vmcnt(0)" ::: "memory")
__device__ __forceinline__ unsigned f2bf(float f) { unsigned u = __builtin_bit_cast(unsigned, f); return (u + 0x7fffu + ((u >> 16) & 1u)) >> 16; }
__device__ __forceinline__ unsigned pk2(float lo, float hi) { return f2bf(lo) | (f2bf(hi) << 16); }
__device__ __forceinline__ float bf_lo(unsigned w) { return __builtin_bit_cast(float, w << 16); }
__device__ __forceinline__ float bf_hi(unsigned w) { return __builtin_bit_cast(float, w & 0xffff0000u); }
__device__ __forceinline__ float wave_sum(float v) {
#pragma unroll
    for (int o = 1; o < 64; o <<= 1) v += __shfl_xor(v, o);
    return v;
}
__device__ __forceinline__ float fast_exp2(float x) { return __builtin_amdgcn_exp2f(x); }
__device__ __forceinline__ float fast_rcp(float x) { return __builtin_amdgcn_rcpf(x); }

struct Args { const float* in[24]; float* out; unsigned char* ws; int ph_lo, ph_hi, rep_mask, pad; };
static_assert(sizeof(Args) == 26 * 8 + 16, "Args has no padding");
#define XB_TMO      128
#define XB_XCNT(j)  (256  + 64 * (j))
#define XB_XSUB(j)  (1280 + 64 * (j))
#define XB_XGEN(j)  (2304 + 64 * (j))
#define XB_TOP      3328
#define XB_TOPGEN   3392
#define XCD_BAR_WORDS 3456
#define XB_SPIN_CAP (1u << 18)

__device__ __forceinline__ unsigned xb_ld(unsigned* p)              { return __hip_atomic_load(p, __ATOMIC_RELAXED, __HIP_MEMORY_SCOPE_AGENT); }
__device__ __forceinline__ unsigned xb_add(unsigned* p, unsigned v) { return __hip_atomic_fetch_add(p, v, __ATOMIC_RELAXED, __HIP_MEMORY_SCOPE_AGENT); }
__device__ __forceinline__ unsigned xb_xcc_id() { return (unsigned)__builtin_amdgcn_s_getreg((3 << 11) | 20) & 0xFu; }
#define XB_SPIN(cond, bar) do { unsigned _sp = 0; while (cond) { __builtin_amdgcn_s_sleep(1); \
    if ((++_sp & 255u) == 0u) { if (xb_ld(&(bar)[XB_TMO])) break; if (_sp > XB_SPIN_CAP) { atomicAdd(&(bar)[XB_TMO], 1u); break; } } } } while (0)

struct XcdBarrier {
    unsigned* bar; unsigned x;
    volatile LAS unsigned* st;
};

__device__ __forceinline__ XcdBarrier xcd_barrier_post(unsigned* bar, volatile LAS unsigned* st) {
    XcdBarrier b; b.bar = bar; b.x = xb_xcc_id(); b.st = st;
    if (threadIdx.x == 0) (void)xb_add(&bar[XB_XCNT(b.x)], 1u);
    return b;
}
__device__ __forceinline__ void xcd_barrier_complete(unsigned* bar, unsigned x, unsigned& nloc, unsigned& nx) {
    const unsigned G = gridDim.x * gridDim.y * gridDim.z;
    unsigned sum, cnt, mine, sp = 0u;
    for (;;) {
        sum = 0u; cnt = 0u; mine = 0u;
#pragma unroll
        for (unsigned j = 0; j < 16; ++j) { const unsigned c = xb_ld(&bar[XB_XCNT(j)]); sum += c; cnt += (c > 0u) ? 1u : 0u; mine = (j == x) ? c : mine; }
        if (sum == G) break;
        __builtin_amdgcn_s_sleep(1);
        if ((++sp & 255u) == 0u) { if (xb_ld(&bar[XB_TMO])) break; if (sp > XB_SPIN_CAP) { atomicAdd(&bar[XB_TMO], 1u); break; } }
    }
    nloc = mine > 0u ? mine : 1u; nx = cnt > 0u ? cnt : 1u;
}

__device__ __forceinline__ void xcd_barrier(const XcdBarrier& b) {
    asm volatile("s_waitcnt vmcnt(0)" ::: "memory");
    __syncthreads();
    if (threadIdx.x == 0) {
        unsigned* bar = b.bar;
        __builtin_amdgcn_s_waitcnt(0);
        unsigned nloc = b.st[0], nx = b.st[1];
        if (nloc == 0u) { xcd_barrier_complete(bar, b.x, nloc, nx); b.st[0] = nloc; b.st[1] = nx; }
        const unsigned old = xb_add(&bar[XB_XSUB(b.x)], 1u);
        const unsigned gen = old / nloc;
        if (old + 1u == (gen + 1u) * nloc) {
            __builtin_amdgcn_fence(__ATOMIC_RELEASE, "agent");
            asm volatile("s_waitcnt vmcnt(0)" ::: "memory");
            const unsigned og = xb_add(&bar[XB_TOP], 1u);
            const unsigned tg = og / nx;
            if (og + 1u == (tg + 1u) * nx) xb_add(&bar[XB_TOPGEN], 1u);
            else XB_SPIN(xb_ld(&bar[XB_TOPGEN]) == tg, bar);
            __builtin_amdgcn_fence(__ATOMIC_ACQUIRE, "agent");
            xb_add(&bar[XB_XGEN(b.x)], 1u);
            asm volatile("s_waitcnt vmcnt(0)" ::: "memory");
        } else {
            XB_SPIN(xb_ld(&bar[XB_XGEN(b.x)]) == gen, bar);
            __builtin_amdgcn_fence(__ATOMIC_ACQUIRE, "agent");
            asm volatile("s_waitcnt vmcnt(0)" ::: "memory");
        }
    }
    __syncthreads();
}

#define EPI_ARGS const pg8::f32x4 (&acc)[2][2][4][2], const pg8::Unit& u, int wr, int wc, int fr, int fq
#define EPI_FOR_AI_M _Pragma("unroll") for (int ai = 0; ai < 2; ++ai) _Pragma("unroll") for (int m = 0; m < 4; ++m)
__device__ __forceinline__ v4u pack8(const f32x4 a, const f32x4 b) { v4u w; w.x = pg8::cvt_pk_bf16(a[0], a[1]); w.y = pg8::cvt_pk_bf16(a[2], a[3]); w.z = pg8::cvt_pk_bf16(b[0], b[1]); w.w = pg8::cvt_pk_bf16(b[2], b[3]); return w; }
__device__ __forceinline__ float sigmoidf_fast(float v) { return fast_rcp(1.0f + fast_exp2(-v * LOG2E)); }

__device__ __forceinline__ unsigned cvt4_fp8(float a, float b, float c, float d) { int p = __builtin_amdgcn_cvt_pk_fp8_f32(a, b, 0, false); p = __builtin_amdgcn_cvt_pk_fp8_f32(c, d, p, true); return (unsigned)p; }

constexpr float W2_SCALE = 16.0f, ACT_SCALE = 4.0f, W13_SCALE = 32.0f, W1_SCALE = 32.0f, WO_SCALE = 32.0f, MIX_SCALE = 16.0f, WXQ_SCALE = 32.0f;
struct EpiQKVG {
    static constexpr bool PERM = true, AFTER_DRAIN = false, HAS_MID = false; static constexpr int MID_T = 0;
    bf16* qkv; bf16* ga; bf16* gb; const float* bgate;
    __device__ __forceinline__ void operator()(EPI_ARGS) const {
        const int row0 = u.pm * 256 + wr * 64 + fr, ct = wc * 32 + 8 * fq;
        if (u.pn < 15) {
            const float sc = ((u.pn < 4 || (u.pn >= 6 && u.pn < 9)) ? 0.125f * LOG2E : 1.0f) * (1.0f / W1_SCALE);
            EPI_FOR_AI_M { bf16* rowp = qkv + (size_t)(row0 + ai * 128 + m * 16) * NQKV + u.pn * 256 + ct;
#pragma unroll
                for (int bj = 0; bj < 2; ++bj) *(v4u*)(rowp + bj * 128) = pack8(acc[ai][bj][m][0] * sc, acc[ai][bj][m][1] * sc); }
        } else {
            const int gt = u.pn - 15; bf16* base = (gt < 8) ? ga : gb; const int gc = (gt & 7) * 256 + ct, bc = gt * 256 + ct;
            _Pragma("unroll") for (int bj = 0; bj < 2; ++bj) { const f32x4 b0 = *(const f32x4*)(bgate + bc + bj * 128), b1 = *(const f32x4*)(bgate + bc + bj * 128 + 4);
                EPI_FOR_AI_M { bf16* rowp = base + (size_t)(row0 + ai * 128 + m * 16) * D + gc;
                    f32x4 v0 = acc[ai][bj][m][0] * (1.0f / W1_SCALE) + b0, v1 = acc[ai][bj][m][1] * (1.0f / W1_SCALE) + b1;
#pragma unroll
                    for (int j = 0; j < 4; ++j) { v0[j] = sigmoidf_fast(v0[j]); v1[j] = sigmoidf_fast(v1[j]); }
                    *(v4u*)(rowp + bj * 128) = pack8(v0, v1); } }
        }
    }
};

constexpr float OAB_SCALE = 16.0f, WAB_SCALE = 32.0f;
#define EPI_ROWSTEP(off, aim) do { off += (size_t)16 * D; if (((aim) & 3) == 3) off += (size_t)64 * D; } while (0)
#ifndef EPI_MIX_MID_AHEAD
#define EPI_MIX_MID_AHEAD 1
#endif
#ifndef EPI_MIX_AHEAD
#define EPI_MIX_AHEAD 1
#endif
struct EpiMix {
    static constexpr bool PERM = true, AFTER_DRAIN = false, HAS_MID = true; static constexpr int MID_T = 8;
    static constexpr int NM = EPI_MIX_MID_AHEAD, NA = EPI_MIX_AHEAD;
    const bf16* ga; const bf16* gb; unsigned char* mix8;
    __device__ __forceinline__ void mid(pg8::f32x4 (&acc)[2][2][4][2], const pg8::Unit& u, int wr, int wc, int fr, int fq) const {
        size_t offl = (size_t)(u.pm * 256 + wr * 64 + fr) * D + u.pn * 256 + wc * 32 + 8 * fq;
        asm volatile("" : "+v"(offl));
        v4u na[NM][2], nb[NM][2];
#pragma unroll
        for (int a = 0; a < NM; ++a) { if (a) EPI_ROWSTEP(offl, a - 1); na[a][0] = *(const v4u*)(ga + offl); na[a][1] = *(const v4u*)(ga + offl + 128); nb[a][0] = *(const v4u*)(gb + offl); nb[a][1] = *(const v4u*)(gb + offl + 128); }
#pragma unroll
        for (int aim = 0; aim < 8; ++aim) { const int ai = aim >> 2, m = aim & 3;
            const v4u ca[2] = {na[0][0], na[0][1]}, cb[2] = {nb[0][0], nb[0][1]};
#pragma unroll
            for (int a = 0; a + 1 < NM; ++a) { na[a][0] = na[a + 1][0]; na[a][1] = na[a + 1][1]; nb[a][0] = nb[a + 1][0]; nb[a][1] = nb[a + 1][1]; }
            if (aim + NM < 8) { EPI_ROWSTEP(offl, aim + NM - 1); na[NM - 1][0] = *(const v4u*)(ga + offl); na[NM - 1][1] = *(const v4u*)(ga + offl + 128); nb[NM - 1][0] = *(const v4u*)(gb + offl); nb[NM - 1][1] = *(const v4u*)(gb + offl + 128); }
            asm volatile("" : "+v"(offl) :: "memory");
#pragma unroll
            for (int bj = 0; bj < 2; ++bj) { const v4u a = ca[bj], b = cb[bj];
                const f32x4 r0 = {bf_lo(a.x) * fast_rcp(bf_lo(b.x)), bf_hi(a.x) * fast_rcp(bf_hi(b.x)), bf_lo(a.y) * fast_rcp(bf_lo(b.y)), bf_hi(a.y) * fast_rcp(bf_hi(b.y))};
                const f32x4 r1 = {bf_lo(a.z) * fast_rcp(bf_lo(b.z)), bf_hi(a.z) * fast_rcp(bf_hi(b.z)), bf_lo(a.w) * fast_rcp(bf_lo(b.w)), bf_hi(a.w) * fast_rcp(bf_hi(b.w))};
                acc[ai][bj][m][0] = acc[ai][bj][m][0] * r0; acc[ai][bj][m][1] = acc[ai][bj][m][1] * r1; } }
    }
    __device__ __forceinline__ void operator()(EPI_ARGS) const {
        size_t off = (size_t)(u.pm * 256 + wr * 64 + fr) * D + u.pn * 256 + wc * 32 + 8 * fq, offl = off;
        asm volatile("" : "+v"(off)); asm volatile("" : "+v"(offl));
        constexpr float sc = MIX_SCALE / (OAB_SCALE * WAB_SCALE);
        v4u nb[NA][2];
#pragma unroll
        for (int a = 0; a < NA; ++a) { if (a) EPI_ROWSTEP(offl, a - 1); nb[a][0] = *(const v4u*)(gb + offl); nb[a][1] = *(const v4u*)(gb + offl + 128); }
#pragma unroll
        for (int aim = 0; aim < 8; ++aim) { const int ai = aim >> 2, m = aim & 3;
            const v4u cb[2] = {nb[0][0], nb[0][1]}; const size_t offc = off;
#pragma unroll
            for (int a = 0; a + 1 < NA; ++a) { nb[a][0] = nb[a + 1][0]; nb[a][1] = nb[a + 1][1]; }
            EPI_ROWSTEP(off, aim);
            if (aim + NA < 8) { EPI_ROWSTEP(offl, aim + NA - 1); nb[NA - 1][0] = *(const v4u*)(gb + offl); nb[NA - 1][1] = *(const v4u*)(gb + offl + 128); }
            asm volatile("" : "+v"(off), "+v"(offl) :: "memory");
#pragma unroll
            for (int bj = 0; bj < 2; ++bj) { const v4u b = cb[bj]; const f32x4 a0 = acc[ai][bj][m][0] * sc, a1 = acc[ai][bj][m][1] * sc;
                v2u w8; w8.x = cvt4_fp8(a0[0] * bf_lo(b.x), a0[1] * bf_hi(b.x), a0[2] * bf_lo(b.y), a0[3] * bf_hi(b.y)); w8.y = cvt4_fp8(a1[0] * bf_lo(b.z), a1[1] * bf_hi(b.z), a1[2] * bf_lo(b.w), a1[3] * bf_hi(b.w));
                *(v2u*)(mix8 + offc + bj * 128) = w8; } }
    }
};

#ifndef EPI_RESID_AHEAD
#define EPI_RESID_AHEAD 3
#endif
struct EpiResid {
    static constexpr bool PERM = true, AFTER_DRAIN = false, HAS_MID = false; static constexpr int MID_T = 0;
    static constexpr int NA = EPI_RESID_AHEAD;
    const float* x; bf16* x1; float* ssq;
    __device__ __forceinline__ void operator()(EPI_ARGS) const {
        const int ct = u.pn * 256 + wc * 32 + 8 * fq; int row = u.pm * 256 + wr * 64 + fr;
        size_t off = (size_t)row * D + ct, offl = off;
        asm volatile("" : "+v"(off)); asm volatile("" : "+v"(offl));
#define EPI_LDX(dst) do { dst[0] = *(const f32x4*)(x + offl); dst[1] = *(const f32x4*)(x + offl + 4); dst[2] = *(const f32x4*)(x + offl + 128); dst[3] = *(const f32x4*)(x + offl + 132); } while (0)
        f32x4 nx[NA][4];
#pragma unroll
        for (int a = 0; a < NA; ++a) { if (a) EPI_ROWSTEP(offl, a - 1); EPI_LDX(nx[a]); }
#pragma unroll
        for (int aim = 0; aim < 8; ++aim) { const int ai = aim >> 2, m = aim & 3;
            const f32x4 cx[4] = {nx[0][0], nx[0][1], nx[0][2], nx[0][3]}; const size_t offc = off; const int rowc = row;
#pragma unroll
            for (int a = 0; a + 1 < NA; ++a)
#pragma unroll
                for (int q = 0; q < 4; ++q) nx[a][q] = nx[a + 1][q];
            EPI_ROWSTEP(off, aim); row += 16; if (m == 3) row += 64;
            if (aim + NA < 8) { EPI_ROWSTEP(offl, aim + NA - 1); EPI_LDX(nx[NA - 1]); }
            asm volatile("" : "+v"(off), "+v"(offl) :: "memory");
            float s = 0.f;
#pragma unroll
            for (int bj = 0; bj < 2; ++bj) {
                const f32x4 v0 = cx[2 * bj] + acc[ai][bj][m][0] * (1.0f / (MIX_SCALE * WO_SCALE)), v1 = cx[2 * bj + 1] + acc[ai][bj][m][1] * (1.0f / (MIX_SCALE * WO_SCALE));
                *(v4u*)(x1 + offc + bj * 128) = pack8(v0, v1);
                s += ((v0[0] * v0[0] + v0[1] * v0[1]) + (v0[2] * v0[2] + v0[3] * v0[3])) + ((v1[0] * v1[0] + v1[1] * v1[1]) + (v1[2] * v1[2] + v1[3] * v1[3]));
            }
            s += __shfl_xor(s, 16); s += __shfl_xor(s, 32);
            if (fq == 0) ssq[(size_t)rowc * 32 + u.pn * 4 + wc] = s; }
#undef EPI_LDX
    }
};

struct EpiQx {
    static constexpr bool PERM = true, AFTER_DRAIN = false, HAS_MID = false; static constexpr int MID_T = 0;
    bf16* qx; const float* ssq; float scale;
    __device__ __forceinline__ void operator()(EPI_ARGS) const {
        int row = u.pm * 256 + wr * 64 + fr; const int ct = u.pn * 256 + wc * 32 + 8 * fq;
        asm volatile("" : "+v"(row));
#pragma unroll
        for (int ai = 0; ai < 2; ++ai) {
#pragma unroll
            for (int m = 0; m < 4; ++m) {
                const f32x4 p0 = *(const f32x4*)(ssq + (size_t)row * 32 + fq * 8), p1 = *(const f32x4*)(ssq + (size_t)row * 32 + fq * 8 + 4);
                float s = ((p0[0] + p0[1]) + (p0[2] + p0[3])) + ((p1[0] + p1[1]) + (p1[2] + p1[3]));
                s += __shfl_xor(s, 16); s += __shfl_xor(s, 32);
                const float rs = scale / sqrtf(s * (1.0f / D) + EPS);
                bf16* rowp = qx + (size_t)row * XW + ct;
#pragma unroll
                for (int bj = 0; bj < 2; ++bj) *(v4u*)(rowp + bj * 128) = pack8(acc[ai][bj][m][0] * rs, acc[ai][bj][m][1] * rs);
                row += 16; asm volatile("" : "+v"(row) :: "memory"); }
            row += 64; }
    }
};

struct EpiBf {
    static constexpr bool PERM = true, AFTER_DRAIN = false, HAS_MID = false; static constexpr int MID_T = 0;
    bf16* out; int ldc; int tmod; float sc;
    __device__ __forceinline__ void operator()(EPI_ARGS) const {
        const int row0 = u.pm * 256 + wr * 64 + fr, ct = (u.pn % tmod) * 256 + wc * 32 + 8 * fq;
        EPI_FOR_AI_M { bf16* rowp = out + (size_t)(row0 + ai * 128 + m * 16) * ldc + ct;
#pragma unroll
            for (int bj = 0; bj < 2; ++bj) *(v4u*)(rowp + bj * 128) = pack8(acc[ai][bj][m][0] * sc, acc[ai][bj][m][1] * sc); }
    }
};

struct EpiF8 {
    static constexpr bool PERM = true, AFTER_DRAIN = false, HAS_MID = false; static constexpr int MID_T = 0;
    unsigned char* out; int ldc; int tmod; float sc;
    __device__ __forceinline__ void operator()(EPI_ARGS) const {
        const int row0 = u.pm * 256 + wr * 64 + fr, ct = (u.pn % tmod) * 256 + wc * 32 + 8 * fq;
        EPI_FOR_AI_M { unsigned char* rowp = out + (size_t)(row0 + ai * 128 + m * 16) * ldc + ct;
#pragma unroll
            for (int bj = 0; bj < 2; ++bj) { const f32x4 a0 = acc[ai][bj][m][0] * sc, a1 = acc[ai][bj][m][1] * sc; v2u w8; w8.x = cvt4_fp8(a0[0], a0[1], a0[2], a0[3]); w8.y = cvt4_fp8(a1[0], a1[1], a1[2], a1[3]);
                *(v2u*)(rowp + bj * 128) = w8; } }
    }
};

#ifndef EPI_RESID2_AHEAD
#define EPI_RESID2_AHEAD 1
#endif
struct EpiResid2 {
    static constexpr bool PERM = true, AFTER_DRAIN = false, HAS_MID = false; static constexpr int MID_T = 0;
    bf16* x1; unsigned char* hm; const float* gm; float* ssq;
    __device__ __forceinline__ void operator()(EPI_ARGS) const {
        const int ct = u.pn * 256 + wc * 32 + 8 * fq; int row = u.pm * 256 + wr * 64 + fr;
        size_t off = (size_t)row * D + ct;
        asm volatile("" : "+v"(off));
        const f32x4 gv[2][2] = {{*(const f32x4*)(gm + ct), *(const f32x4*)(gm + ct + 4)}, {*(const f32x4*)(gm + ct + 128), *(const f32x4*)(gm + ct + 132)}};
        v4u nt[2];
        nt[0] = *(const v4u*)(x1 + off); nt[1] = *(const v4u*)(x1 + off + 128);
#pragma unroll
        for (int aim = 0; aim < 8; ++aim) { const int ai = aim >> 2, m = aim & 3;
            const v4u ctv[2] = {nt[0], nt[1]}; const size_t offc = off; const int rowc = row;
            EPI_ROWSTEP(off, aim); row += 16; if (m == 3) row += 64;
            if (aim < 7) { nt[0] = *(const v4u*)(x1 + off); nt[1] = *(const v4u*)(x1 + off + 128); }
            asm volatile("" : "+v"(off) :: "memory");
            float s = 0.f;
#pragma unroll
            for (int bj = 0; bj < 2; ++bj) { const v4u t = ctv[bj]; const f32x4 a0 = acc[ai][bj][m][0], a1 = acc[ai][bj][m][1];
                const f32x4 o0 = {bf_lo(t.x) + a0[0], bf_hi(t.x) + a0[1], bf_lo(t.y) + a0[2], bf_hi(t.y) + a0[3]}, o1 = {bf_lo(t.z) + a1[0], bf_hi(t.z) + a1[1], bf_lo(t.w) + a1[2], bf_hi(t.w) + a1[3]};
                *(v4u*)(x1 + offc + bj * 128) = pack8(o0, o1);
                const f32x4 h0 = o0 * gv[bj][0], h1 = o1 * gv[bj][1];
                v2u w8; w8.x = cvt4_fp8(h0[0], h0[1], h0[2], h0[3]); w8.y = cvt4_fp8(h1[0], h1[1], h1[2], h1[3]);
                *(v2u*)(hm + offc + bj * 128) = w8;
                s += ((o0[0] * o0[0] + o0[1] * o0[1]) + (o0[2] * o0[2] + o0[3] * o0[3])) + ((o1[0] * o1[0] + o1[1] * o1[1]) + (o1[2] * o1[2] + o1[3] * o1[3])); }
            s += __shfl_xor(s, 16); s += __shfl_xor(s, 32);
            if (fq == 0) ssq[(size_t)rowc * 32 + u.pn * 4 + wc] = s; }
    }
};
struct EpiLogit {
    static constexpr bool PERM = true, AFTER_DRAIN = false, HAS_MID = false; static constexpr int MID_T = 0;
    float* part;
    __device__ __forceinline__ void operator()(EPI_ARGS) const {
        const int c0 = wc * 8 + 2 * fq;
        EPI_FOR_AI_M { const int row = u.pm * 256 + wr * 64 + fr + ai * 128 + m * 16;
            { const f32x4 a = acc[ai][0][m][0], b = acc[ai][0][m][1]; v2u st; st.x = __builtin_bit_cast(unsigned, (a[0] + a[1]) + (a[2] + a[3])); st.y = __builtin_bit_cast(unsigned, (b[0] + b[1]) + (b[2] + b[3]));
              *(v2u*)(part + (size_t)row * 36 + c0) = st; }
            if (wc == 0 && fq < 2) { const f32x4 a = acc[ai][1][m][0], b = acc[ai][1][m][1]; v2u st; st.x = __builtin_bit_cast(unsigned, (a[0] + a[1]) + (a[2] + a[3])); st.y = __builtin_bit_cast(unsigned, (b[0] + b[1]) + (b[2] + b[3]));
              *(v2u*)(part + (size_t)row * 36 + 32 + c0) = st; } }
    }
};

struct EpiF32 {
    static constexpr bool PERM = true, AFTER_DRAIN = false, HAS_MID = false; static constexpr int MID_T = 0;
    float* c; int ldc;
    __device__ __forceinline__ void operator()(EPI_ARGS) const {
        const int ct = u.pn * 256 + wc * 32 + 8 * fq;
        EPI_FOR_AI_M { float* rp = c + (size_t)(u.pm * 256 + wr * 64 + fr + ai * 128 + m * 16) * ldc + ct;
#pragma unroll
            for (int bj = 0; bj < 2; ++bj) { *(f32x4*)(rp + bj * 128) = acc[ai][bj][m][0]; *(f32x4*)(rp + bj * 128 + 4) = acc[ai][bj][m][1]; } }
    }
};
struct EpiSwiGLU {
    static constexpr bool PERM = true, AFTER_DRAIN = false, HAS_MID = false; static constexpr int MID_T = 0;
    unsigned char* act; const float* rsort;
    __device__ __forceinline__ void operator()(EPI_ARGS) const {
        const int row0 = u.pm * 256 + wr * 64 + fr, ct = (u.pn & 3) * 128 + wc * 16 + 4 * fq;
        EPI_FOR_AI_M { const int row = row0 + ai * 128 + m * 16; const float rs = rsort[row] * (1.0f / W13_SCALE); unsigned char* rowp = act + (size_t)row * DFF + ct;
#pragma unroll
            for (int bj = 0; bj < 2; ++bj) { const f32x4 a = acc[ai][bj][m][0] * rs, b = acc[ai][bj][m][1] * rs;
                const float o0 = a[0] * sigmoidf_fast(a[0]) * a[1], o1 = a[2] * sigmoidf_fast(a[2]) * a[3], o2 = b[0] * sigmoidf_fast(b[0]) * b[1], o3 = b[2] * sigmoidf_fast(b[2]) * b[3];
                *(unsigned*)(rowp + bj * 64) = cvt4_fp8(o0 * ACT_SCALE, o1 * ACT_SCALE, o2 * ACT_SCALE, o3 * ACT_SCALE); } }
    }
};

constexpr int ATT_TAB_OFF = 0;
constexpr int ATT_V_OFF = 8192;
constexpr int ATT_V_WAVE64 = 6144, ATT_V_WAVE128 = 10240;
constexpr int ATT_K_WAVE64 = 32 * 144, ATT_K_WAVE128 = 32 * 272;
constexpr int ATT_K_OFF64 = ATT_V_OFF + 8 * ATT_V_WAVE64, ATT_K_OFF128 = ATT_V_OFF + 8 * ATT_V_WAVE128;
constexpr int ATT_OB_OFF = ATT_K_OFF64 + 8 * ATT_K_WAVE64;
constexpr int ATT_LSE_OFF = ATT_OB_OFF + 65536;
static_assert(ATT_LSE_OFF + 2048 <= 161792 && ATT_K_OFF128 + 8 * ATT_K_WAVE128 <= 161792, "attention LDS map below the control words");

template <int DH> struct AttnGeom { static constexpr int KSTRIDE = 2 * DH + 16, VSTRIDE = (DH == 64) ? 192 : 320, CPR = DH / 8, RPI = 64 / CPR, NVI = 32 / RPI, NST = DH / 16, NDT = DH / 32; };


template <int VSTRIDE, int DT>
__device__ __forceinline__ void pv_step(unsigned tr_base, const s16x8 (&pf)[2], f32x16& Od) {
    s16x4 a0, a1, b0, b1;
    asm volatile("ds_read_b64_tr_b16 %0, %4 offset:%5\n\tds_read_b64_tr_b16 %1, %4 offset:%6\n\tds_read_b64_tr_b16 %2, %4 offset:%7\n\tds_read_b64_tr_b16 %3, %4 offset:%8\n\ts_waitcnt lgkmcnt(0)"
                 : "=&v"(a0), "=&v"(a1), "=&v"(b0), "=&v"(b1)
                 : "v"(tr_base), "i"(64 * DT), "i"(64 * DT + 8 * VSTRIDE), "i"(64 * DT + 16 * VSTRIDE), "i"(64 * DT + 24 * VSTRIDE) : "memory");
    const s16x8 vf0 = __builtin_shufflevector(a0, a1, 0, 1, 2, 3, 4, 5, 6, 7), vf1 = __builtin_shufflevector(b0, b1, 0, 1, 2, 3, 4, 5, 6, 7);
    Od = __builtin_amdgcn_mfma_f32_32x32x16_bf16(vf0, pf[0], Od, 0, 0, 0);
    Od = __builtin_amdgcn_mfma_f32_32x32x16_bf16(vf1, pf[1], Od, 0, 0, 0);
}

template <int VSTRIDE, int DT>
__device__ __forceinline__ void pv_step2(unsigned tr_base, const s16x8 (&pf)[2], f32x16& Od0, f32x16& Od1) {
    s16x4 a0, a1, b0, b1, c0, c1, d0, d1;
    asm volatile("ds_read_b64_tr_b16 %0, %8 offset:%9\n\tds_read_b64_tr_b16 %1, %8 offset:%10\n\tds_read_b64_tr_b16 %2, %8 offset:%11\n\tds_read_b64_tr_b16 %3, %8 offset:%12\n\t"
                 "ds_read_b64_tr_b16 %4, %8 offset:%13\n\tds_read_b64_tr_b16 %5, %8 offset:%14\n\tds_read_b64_tr_b16 %6, %8 offset:%15\n\tds_read_b64_tr_b16 %7, %8 offset:%16\n\ts_waitcnt lgkmcnt(0)"
                 : "=&v"(a0), "=&v"(a1), "=&v"(b0), "=&v"(b1), "=&v"(c0), "=&v"(c1), "=&v"(d0), "=&v"(d1)
                 : "v"(tr_base), "i"(64 * DT), "i"(64 * DT + 8 * VSTRIDE), "i"(64 * DT + 16 * VSTRIDE), "i"(64 * DT + 24 * VSTRIDE),
                   "i"(64 * DT + 64), "i"(64 * DT + 64 + 8 * VSTRIDE), "i"(64 * DT + 64 + 16 * VSTRIDE), "i"(64 * DT + 64 + 24 * VSTRIDE) : "memory");
    const s16x8 v00 = __builtin_shufflevector(a0, a1, 0, 1, 2, 3, 4, 5, 6, 7), v01 = __builtin_shufflevector(b0, b1, 0, 1, 2, 3, 4, 5, 6, 7);
    const s16x8 v10 = __builtin_shufflevector(c0, c1, 0, 1, 2, 3, 4, 5, 6, 7), v11 = __builtin_shufflevector(d0, d1, 0, 1, 2, 3, 4, 5, 6, 7);
    Od0 = __builtin_amdgcn_mfma_f32_32x32x16_bf16(v00, pf[0], Od0, 0, 0, 0);
    Od1 = __builtin_amdgcn_mfma_f32_32x32x16_bf16(v10, pf[0], Od1, 0, 0, 0);
    Od0 = __builtin_amdgcn_mfma_f32_32x32x16_bf16(v01, pf[1], Od0, 0, 0, 0);
    Od1 = __builtin_amdgcn_mfma_f32_32x32x16_bf16(v11, pf[1], Od1, 0, 0, 0);
}

struct AttnJob {
    const bf16* q; int ldq; long qrow0; int qstride; int qmask;
    const bf16* q2;
    const bf16* k; const bf16* v; int ldkv; long krow0; int kstride;
    int i0;
    int u_begin, ntiles;
    float m_init, l_init;
};

template <int DH> struct KVTile { v4u k[AttnGeom<DH>::NVI]; v4u v[AttnGeom<DH>::NVI]; };
template <int DH> struct KVPtr { const bf16* k[AttnGeom<DH>::NVI]; const bf16* v[AttnGeom<DH>::NVI]; long step; };
template <int DH> __device__ __forceinline__ void attn_ptr_init(const AttnJob& J, int lane, KVPtr<DH>& P) {
    typedef AttnGeom<DH> G;
    const int q = lane & 31, h = lane >> 5, vr = lane / G::CPR, vc = lane % G::CPR;
#pragma unroll
    for (int i = 0; i < G::NVI; ++i) P.k[i] = J.k + (size_t)(J.krow0 + (long)(J.u_begin + vr + G::RPI * i) * J.kstride) * J.ldkv + 8 * vc;
#pragma unroll
    for (int i = 0; i < G::NVI; ++i) P.v[i] = J.v + (size_t)(J.krow0 + (long)(J.u_begin + vr + G::RPI * i) * J.kstride) * J.ldkv + 8 * vc;
    P.step = (long)32 * J.kstride * J.ldkv;
}
template <int DH> __device__ __forceinline__ void attn_load_k(KVPtr<DH>& P, KVTile<DH>& T) {
    typedef AttnGeom<DH> G;
#pragma unroll
    for (int i = 0; i < G::NVI; ++i) T.k[i] = *(const v4u*)(P.k[i]);
#pragma unroll
    for (int i = 0; i < G::NVI; ++i) P.k[i] += P.step;
}
template <int DH> __device__ __forceinline__ void attn_load_v(KVPtr<DH>& P, KVTile<DH>& T) {
    typedef AttnGeom<DH> G;
#pragma unroll
    for (int i = 0; i < G::NVI; ++i) T.v[i] = *(const v4u*)(P.v[i]);
#pragma unroll
    for (int i = 0; i < G::NVI; ++i) P.v[i] += P.step;
}
template <int DH> __device__ __forceinline__ void attn_load_tile(KVPtr<DH>& P, KVTile<DH>& T) { attn_load_k<DH>(P, T); attn_load_v<DH>(P, T); }
constexpr float ATT_THR = 6.0f;

template <int DH, bool TAB>
__device__ __forceinline__ void attn_qk(const AttnJob& J, int u0, const KVTile<DH>& T, const s16x8 (&qf)[DH / 16], const LAS float* tab, LAS unsigned char* kst, int lane, float mrun, f32x16& S) {
    typedef AttnGeom<DH> G;
    const int q = lane & 31, h = lane >> 5, vr = lane / G::CPR, vc = lane % G::CPR;
#pragma unroll
    for (int i = 0; i < G::NVI; ++i) *(LAS v4u*)(kst + (vr + G::RPI * i) * G::KSTRIDE + 16 * vc) = T.k[i];
    const int dbase = (J.i0 - u0) + q - 4 * h + 32;
#pragma unroll
    for (int i = 0; i < 16; ++i) { const int cr = (i & 3) + 8 * (i >> 2); S[i] = (TAB ? tab[dbase - cr] : 0.f) - mrun; }
    s16x8 kf[G::NST];
#pragma unroll
    for (int st = 0; st < G::NST; ++st) kf[st] = *(const LAS s16x8*)(kst + q * G::KSTRIDE + 32 * st + 16 * h);
#pragma unroll
    for (int st = 0; st < G::NST; ++st) S = __builtin_amdgcn_mfma_f32_32x32x16_bf16(kf[st], qf[st], S, 0, 0, 0);
}
template <int DH>
__device__ __forceinline__ void attn_softmax_pv(const KVTile<DH>& T, f32x16& S, f32x16& Sn, bool has_next, LAS unsigned char* vst, unsigned tr_base, int lane,
                                                f32x16 (&O)[DH / 32], float& mrun, float& lrun) {
    typedef AttnGeom<DH> G;
    const int vr = lane / G::CPR, vc = lane % G::CPR;
#pragma unroll
    for (int i = 0; i < G::NVI; ++i) *(LAS v4u*)(vst + (vr + G::RPI * i) * G::VSTRIDE + 16 * vc) = T.v[i];
    float mx = S[0];
#pragma unroll
    for (int i = 1; i < 16; ++i) mx = fmaxf(mx, S[i]);
    if (!__all(mx <= ATT_THR)) {
        mx = fmaxf(mx, __shfl_xor(mx, 32));
        const float d = fmaxf(mx, 0.f), alpha = fast_exp2(-d);
        mrun += d; lrun *= alpha;
#pragma unroll
        for (int dt = 0; dt < G::NDT; ++dt)
#pragma unroll
            for (int i = 0; i < 16; ++i) O[dt][i] *= alpha;
#pragma unroll
        for (int i = 0; i < 16; ++i) S[i] -= d;
        if (has_next) {
#pragma unroll
            for (int i = 0; i < 16; ++i) Sn[i] -= d; }
    }
    float ps = 0.f;
#pragma unroll
    for (int i = 0; i < 16; ++i) { S[i] = fast_exp2(S[i]); ps += S[i]; }
    lrun += ps;
    s16x8 pf[2];
#pragma unroll
    for (int s = 0; s < 2; ++s) { unsigned w0 = pg8::cvt_pk_bf16(S[8 * s + 0], S[8 * s + 1]), w1 = pg8::cvt_pk_bf16(S[8 * s + 2], S[8 * s + 3]), w2 = pg8::cvt_pk_bf16(S[8 * s + 4], S[8 * s + 5]), w3 = pg8::cvt_pk_bf16(S[8 * s + 6], S[8 * s + 7]);
        v4u w = {w0, w1, w2, w3}; pf[s] = __builtin_bit_cast(s16x8, w); }
    LDS_WAIT();
    pv_step2<G::VSTRIDE, 0>(tr_base, pf, O[0], O[1]);
    if constexpr (G::NDT == 4) pv_step2<G::VSTRIDE, 2>(tr_base, pf, O[2], O[3]);
}

__device__ __forceinline__ void attn_fill_tab(LAS float* tab, const float* gtab, int maxoff, int lane) {
#pragma unroll
    for (int j = 0; j < 4; ++j) { const int idx = lane + 64 * j, d = idx - 32; tab[idx] = (d >= 0 && d <= maxoff) ? gtab[d] : NEGBIG; }
    LDS_WAIT();
}
template <int DH, bool TAB, bool PIPE, bool QSUM = false>
__device__ __forceinline__ void attn_job(const AttnJob& J, LAS float* tab, const float* gtab, int maxoff, LAS unsigned char* vst, LAS unsigned char* kst, int lane, f32x16 (&O)[DH / 32], float& m_out, float& l_out) {
    typedef AttnGeom<DH> G;
    const int q = lane & 31, h = lane >> 5;
    s16x8 qf[G::NST];
    { const bf16* qp = J.q + (size_t)(J.qrow0 + (long)(q & J.qmask) * J.qstride) * J.ldq + 8 * h;
#pragma unroll
      for (int st = 0; st < G::NST; ++st) qf[st] = *(const s16x8*)(qp + 16 * st);
      if constexpr (QSUM) { const bf16* qp2 = J.q2 + (size_t)(J.qrow0 + (long)(q & J.qmask) * J.qstride) * J.ldq + 8 * h;
#pragma unroll
          for (int st = 0; st < G::NST; ++st) { const v4u a = __builtin_bit_cast(v4u, qf[st]), b = *(const v4u*)(qp2 + 16 * st); v4u r;
              r.x = pg8::cvt_pk_bf16(bf_lo(a.x) + bf_lo(b.x), bf_hi(a.x) + bf_hi(b.x)); r.y = pg8::cvt_pk_bf16(bf_lo(a.y) + bf_lo(b.y), bf_hi(a.y) + bf_hi(b.y));
              r.z = pg8::cvt_pk_bf16(bf_lo(a.z) + bf_lo(b.z), bf_hi(a.z) + bf_hi(b.z)); r.w = pg8::cvt_pk_bf16(bf_lo(a.w) + bf_lo(b.w), bf_hi(a.w) + bf_hi(b.w));
              qf[st] = __builtin_bit_cast(s16x8, r); } } }
#pragma unroll
    for (int dt = 0; dt < G::NDT; ++dt)
#pragma unroll
        for (int i = 0; i < 16; ++i) O[dt][i] = 0.f;
    float mrun = J.m_init, lrun = (lane < 32) ? J.l_init : 0.f;
    const unsigned tr_base = (unsigned)(size_t)vst + (unsigned)((4 * h + ((lane & 15) >> 2)) * G::VSTRIDE + (16 * ((lane >> 4) & 1) + 4 * (lane & 3)) * 2);
    const int nt = J.ntiles, ub = J.u_begin;
    KVPtr<DH> P; attn_ptr_init<DH>(J, lane, P);
    if constexpr (PIPE) {
        KVTile<DH> A, B; f32x16 S0, S1;
        attn_load_tile<DH>(P, A);
        if constexpr (TAB) attn_fill_tab(tab, gtab, maxoff, lane);
        if (1 < nt) attn_load_tile<DH>(P, B);
        attn_qk<DH, TAB>(J, ub, A, qf, tab, kst, lane, mrun, S0);
        int t = 0;
        for (;;) {
            if (t + 2 < nt) attn_load_k<DH>(P, A);
            const bool n1 = t + 1 < nt;
            if (n1) attn_qk<DH, TAB>(J, ub + 32 * (t + 1), B, qf, tab, kst, lane, mrun, S1);
            attn_softmax_pv<DH>(A, S0, S1, n1, vst, tr_base, lane, O, mrun, lrun);
            if (t + 2 < nt) attn_load_v<DH>(P, A);
            if (++t >= nt) break;
            if (t + 2 < nt) attn_load_k<DH>(P, B);
            const bool n2 = t + 1 < nt;
            if (n2) attn_qk<DH, TAB>(J, ub + 32 * (t + 1), A, qf, tab, kst, lane, mrun, S0);
            attn_softmax_pv<DH>(B, S1, S0, n2, vst, tr_base, lane, O, mrun, lrun);
            if (t + 2 < nt) attn_load_v<DH>(P, B);
            if (++t >= nt) break;
        }
    } else {
        if constexpr (TAB) attn_fill_tab(tab, gtab, maxoff, lane);
        for (int t = 0; t < nt; ++t) { KVTile<DH> A; f32x16 S0, Sx; attn_load_tile<DH>(P, A); attn_qk<DH, TAB>(J, ub + 32 * t, A, qf, tab, kst, lane, mrun, S0); attn_softmax_pv<DH>(A, S0, Sx, false, vst, tr_base, lane, O, mrun, lrun); }
    }
    m_out = mrun; l_out = lrun + __shfl_xor(lrun, 32);
}


struct Frame {
    LAS unsigned char* lds;
    volatile LAS unsigned* MISC;
    gu32* ctl;
    unsigned char* ws;
    int tid, lane, wave, vcu, G;
    float* out;
};
__device__ __forceinline__ const float* frame_in(const Frame& F, int i) { const unsigned lo = __builtin_amdgcn_readfirstlane(F.MISC[16 + 2 * i]), hi = __builtin_amdgcn_readfirstlane(F.MISC[17 + 2 * i]); return (const float*)(((unsigned long long)hi << 32) | lo); }
#define FIN(i) frame_in(F, (i))
enum { I_X = 0, I_MEM, I_RELB, I_GMIX, I_WIN, I_SINK, I_WAOUT, I_WBOUT, I_WGATE, I_BGATE, I_WO, I_GX, I_GMEM, I_WXQ, I_WXK, I_WXV, I_WXO, I_GMOE, I_WRG, I_WRE, I_W1, I_W3, I_W2, I_GFIN };

__device__ __forceinline__ void p0_transpose_item(const float* W, int K, int N, bf16* WT, int row_off, int row_mul, LAS unsigned* scr, int item, int lane, const float* rowscale = nullptr) {
    const int nblk = N / 64, kb = item / nblk, nb = item % nblk, k0 = 64 * kb, n0 = 64 * nb;
    const int r4 = lane >> 4, c16 = lane & 15;
    f32x4 v[16];
    const float* src = W + (size_t)(k0 + 2 * r4) * N + n0 + 4 * c16;
#pragma unroll
    for (int i = 0; i < 8; ++i) { v[2 * i] = *(const f32x4*)(src + (size_t)(8 * i) * N); v[2 * i + 1] = *(const f32x4*)(src + (size_t)(8 * i + 1) * N); }
    if (rowscale) {
#pragma unroll
        for (int i = 0; i < 8; ++i) { v[2 * i] *= rowscale[k0 + 2 * r4 + 8 * i]; v[2 * i + 1] *= rowscale[k0 + 2 * r4 + 8 * i + 1]; } }
#pragma unroll
    for (int i = 0; i < 8; ++i)
#pragma unroll
        for (int j = 0; j < 4; ++j) scr[(4 * c16 + j) * 33 + 4 * i + r4] = pg8::cvt_pk_bf16(v[2 * i][j], v[2 * i + 1][j]);
    LDS_WAIT(); asm volatile("" ::: "memory");
    const int nr = lane >> 3, c = lane & 7;
#pragma unroll
    for (int jj = 0; jj < 8; ++jj) { const int n = nr + 8 * jj; const LAS unsigned* s = scr + n * 33 + 4 * c;
        v4u o; o.x = s[0]; o.y = s[1]; o.z = s[2]; o.w = s[3];
        *(v4u*)(WT + (size_t)(row_off + (n0 + n) * row_mul) * K + k0 + 8 * c) = o; }
    LDS_WAIT(); asm volatile("" ::: "memory");
}
template <bool DEEP = false>
__device__ __forceinline__ void p0_transpose_item_fp8(const float* W, int K, int N, unsigned char* WT, int row_off, int row_mul, float scale, LAS unsigned* scr, int item, int lane, int pitch = 0, int kbase = 0) {
    if (pitch == 0) pitch = K;
    const int nblk = N / 64, kb = item / nblk, nb = item % nblk, k0 = 128 * kb, n0 = 64 * nb;
    const int r4 = lane >> 4, c16 = lane & 15;
    if constexpr (DEEP) {
        f32x4 v[2][4][4];
#pragma unroll
        for (int pass = 0; pass < 2; ++pass) { const float* src = W + (size_t)(k0 + 64 * pass + 4 * r4) * N + n0 + 4 * c16;
#pragma unroll
            for (int i = 0; i < 4; ++i)
#pragma unroll
                for (int kk = 0; kk < 4; ++kk) v[pass][i][kk] = __builtin_nontemporal_load((const f32x4*)(src + (size_t)(16 * i + kk) * N)); }
#pragma unroll
        for (int pass = 0; pass < 2; ++pass)
#pragma unroll
            for (int i = 0; i < 4; ++i)
#pragma unroll
                for (int j = 0; j < 4; ++j) scr[(4 * c16 + j) * 33 + 16 * pass + 4 * i + r4] = cvt4_fp8(v[pass][i][0][j] * scale, v[pass][i][1][j] * scale, v[pass][i][2][j] * scale, v[pass][i][3][j] * scale);
    } else {
#pragma unroll
    for (int pass = 0; pass < 2; ++pass) {
        f32x4 v[4][4];
        const float* src = W + (size_t)(k0 + 64 * pass + 4 * r4) * N + n0 + 4 * c16;
#pragma unroll
        for (int i = 0; i < 4; ++i)
#pragma unroll
            for (int kk = 0; kk < 4; ++kk) v[i][kk] = *(const f32x4*)(src + (size_t)(16 * i + kk) * N);
#pragma unroll
        for (int i = 0; i < 4; ++i)
#pragma unroll
            for (int j = 0; j < 4; ++j) scr[(4 * c16 + j) * 33 + 16 * pass + 4 * i + r4] = cvt4_fp8(v[i][0][j] * scale, v[i][1][j] * scale, v[i][2][j] * scale, v[i][3][j] * scale);
    }
    }
    LDS_WAIT(); asm volatile("" ::: "memory");
    const int nr = lane >> 3, c = lane & 7;
#pragma unroll
    for (int jj = 0; jj < 8; ++jj) { const int n = nr + 8 * jj; const LAS unsigned* s = scr + n * 33 + 4 * c;
        v4u o; o.x = s[0]; o.y = s[1]; o.z = s[2]; o.w = s[3];
        *(v4u*)(WT + (size_t)(row_off + (n0 + n) * row_mul) * pitch + kbase + k0 + 16 * c) = o; }
    LDS_WAIT(); asm volatile("" ::: "memory");
}
__device__ __forceinline__ void rms_row_to_bf16(const float* xrow, const float* g, bf16* orow, int lane) {
    const f32x4* xr = (const f32x4*)xrow + lane; const f32x4* gr = (const f32x4*)g + lane;
    f32x4 v[8]; float s = 0.f;
#pragma unroll
    for (int j = 0; j < 8; ++j) { v[j] = xr[64 * j]; s += (v[j][0] * v[j][0] + v[j][1] * v[j][1]) + (v[j][2] * v[j][2] + v[j][3] * v[j][3]); }
    const float rstd = 1.0f / sqrtf(wave_sum(s) * (1.0f / D) + EPS);
    v2u* o8 = (v2u*)orow + lane;
#pragma unroll
    for (int j = 0; j < 8; ++j) { const f32x4 gg = gr[64 * j]; v2u w; w.x = pk2(v[j][0] * rstd * gg[0], v[j][1] * rstd * gg[1]); w.y = pk2(v[j][2] * rstd * gg[2], v[j][3] * rstd * gg[3]); o8[64 * j] = w; }
}
__device__ __forceinline__ void rms_row_to_fp8(const float* xrow, const float* g, unsigned char* orow, int lane) {
    const f32x4* xr = (const f32x4*)xrow + lane; const f32x4* gr = (const f32x4*)g + lane;
    f32x4 v[8]; float s = 0.f;
#pragma unroll
    for (int j = 0; j < 8; ++j) { v[j] = xr[64 * j]; s += (v[j][0] * v[j][0] + v[j][1] * v[j][1]) + (v[j][2] * v[j][2] + v[j][3] * v[j][3]); }
    const float rstd = 1.0f / sqrtf(wave_sum(s) * (1.0f / D) + EPS);
    unsigned* o4 = (unsigned*)orow + lane;
#pragma unroll
    for (int j = 0; j < 8; ++j) { const f32x4 gg = gr[64 * j]; o4[64 * j] = cvt4_fp8(v[j][0] * rstd * gg[0], v[j][1] * rstd * gg[1], v[j][2] * rstd * gg[2], v[j][3] * rstd * gg[3]); }
}
__device__ __forceinline__ int t5_bucket_dev(int d) {
    if (d < 16) return d;
    int large = 16 + (int)(log((double)d / 16.0) / log(128.0) * 16.0);
    return large < 31 ? large : 31;
}
constexpr int I_IN = 16 * 60, I_GT = 16 * 64, I_A = 8 * 32, I_B = 6 * 32, I_O = 16 * 32, I_Q = 32 * 8, I_XO = 8 * 32, I_E13 = 16 * 8, I_E2 = 4 * 32;
template <int PART> __device__ __forceinline__ void p0_convert_rest(Frame& F, int wgi, int nwg) {
    int lane_o = F.lane; asm volatile("" : "+v"(lane_o));
    LAS unsigned* scr = (LAS unsigned*)(F.lds + RING_OFF + F.wave * 16384);
    const int gw = wgi * NWAVES + F.wave, NGW = nwg * NWAVES;
    constexpr int NITEMS = PART == 0 ? I_A + I_B + I_O : 3 * I_Q + I_XO;
#pragma unroll 1
    for (int it = gw; it < NITEMS; it += NGW) {
        int r = it;
        if constexpr (PART == 0) {
            if (r < I_A) { p0_transpose_item_fp8(FIN(I_WAOUT), AW, D, F.ws + WS_WA, 0, 1, WAB_SCALE, scr, r, lane_o, AW + BW, 0); continue; } r -= I_A;
            if (r < I_B) { p0_transpose_item_fp8(FIN(I_WBOUT), BW, D, F.ws + WS_WA, 0, 1, WAB_SCALE, scr, r, lane_o, AW + BW, AW); continue; } r -= I_B;
            p0_transpose_item_fp8(FIN(I_WO), D, D, F.ws + WS_WO, 0, 1, WO_SCALE, scr, r, lane_o);
        } else {
            if (r < I_Q) { p0_transpose_item(FIN(I_WXQ), D, XW, (bf16*)(F.ws + WS_WXQ), 0, 1, scr, r, lane_o, FIN(I_GX)); continue; } r -= I_Q;
            if (r < I_Q) { p0_transpose_item(FIN(I_WXK), D, XW, (bf16*)(F.ws + WS_WXKV), 0, 1, scr, r, lane_o); continue; } r -= I_Q;
            if (r < I_Q) { p0_transpose_item(FIN(I_WXV), D, XW, (bf16*)(F.ws + WS_WXKV), XW, 1, scr, r, lane_o); continue; } r -= I_Q;
            p0_transpose_item(FIN(I_WXO), XW, D, (bf16*)(F.ws + WS_WXO), 0, 1, scr, r, lane_o);
        }
    }
}
constexpr int N_W13 = 2 * NEXP * I_E13, N_WEXP = N_W13 + NEXP * I_E2;
template <bool DEEP = false> __device__ __forceinline__ void convert_w(Frame& F, int lo, int hi, int wsl, int nws) {
    int lane_o = F.lane; asm volatile("" : "+v"(lane_o));
    LAS unsigned* scr = (LAS unsigned*)(F.lds + RING_OFF + F.wave * 16384);
#pragma unroll 1
    for (int it = lo + wsl; it < hi; it += nws) {
        if (it < N_W13) { const int mat = it >= NEXP * I_E13 ? 1 : 0, r = it - mat * NEXP * I_E13, e = r / I_E13;
            p0_transpose_item_fp8<DEEP>(FIN(mat ? I_W3 : I_W1) + (size_t)e * D * DFF, D, DFF, F.ws + WS_W13, e * 1024 + mat, 2, W13_SCALE, scr, r % I_E13, lane_o); }
        else { const int r = it - N_W13, e = r / I_E2; p0_transpose_item_fp8<DEEP>(FIN(I_W2) + (size_t)e * DFF * D, DFF, D, F.ws + WS_W2, e * 2048, 1, W2_SCALE, scr, r % I_E2, lane_o); }
    }
}
__device__ __forceinline__ void p0_prologue(Frame& F) {
    LAS unsigned* scr = (LAS unsigned*)(F.lds + RING_OFF + F.wave * 16384);
    const int gw = F.vcu * NWAVES + F.wave, NGW = F.G * NWAVES;
    for (int it = gw; it < I_IN + I_GT; it += NGW) {
        if (it < I_IN) p0_transpose_item_fp8(FIN(I_WIN), D, NQKV, F.ws + WS_BT1, 0, 1, W1_SCALE, scr, it, F.lane);
        else p0_transpose_item_fp8(FIN(I_WGATE), D, NGATE, F.ws + WS_BT1, NQKV, 1, W1_SCALE, scr, it - I_IN, F.lane);
    }
    for (int m = gw; m < M + BATCH * MEML; m += NGW) {
        if (m < M) rms_row_to_fp8(FIN(I_X) + (size_t)m * D, FIN(I_GMIX), F.ws + WS_H + (size_t)m * D, F.lane);
        else rms_row_to_bf16(FIN(I_MEM) + (size_t)(m - M) * D, FIN(I_GMEM), (bf16*)(F.ws + WS_MEMN) + (size_t)(m - M) * D, F.lane);
    }
    { bf16* w3 = (bf16*)(F.ws + WS_W3); const float* wre = FIN(I_WRE); const float* wrg = FIN(I_WRG); const float* gmo = FIN(I_GMOE);
      for (int i = (F.vcu * NWAVES + F.wave) * 64 + F.lane; i < 4 * 256 * 512; i += F.G * NWAVES * 64) { const int kk = i & 511, n = (i >> 9) & 255, kq = i >> 17, k = kq * 512 + kk, c = n >> 2, sp = n & 3; unsigned v = 0u;
          if (c < 36 && sp < 3) { const float w = gmo[k] * (c < 32 ? wre[k * 32 + c] : wrg[k * 4 + (c - 32)]); const unsigned t0 = f2bf(w); const float r1 = w - __builtin_bit_cast(float, t0 << 16);
              const unsigned t1 = f2bf(r1); const float r2 = r1 - __builtin_bit_cast(float, t1 << 16); v = sp == 0 ? t0 : (sp == 1 ? t1 : f2bf(r2)); }
          w3[i] = (bf16)v; } }
    float* tabA = (float*)(F.ws + WS_TAB); float* tabB = tabA + 16 * TABW;
    const int gt = (F.vcu * NWAVES + F.wave) * 64 + F.lane, NGT = F.G * NWAVES * 64;
    for (int i = gt; i < 16 * TABW + 36 * TABW; i += NGT) {
        if (i < 16 * TABW) { const int hd = i / TABW, d = i % TABW; tabA[i] = (d <= 127) ? FIN(I_RELB)[t5_bucket_dev(d) * 28 + hd] * LOG2E : NEGBIG; }
        else { const int j = i - 16 * TABW, p = j / (12 * TABW), hd = (j / TABW) % 12, d = j % TABW; const int r = (p == 0) ? 1 : (p == 1 ? 4 : 16);
            tabB[j] = (d <= 128) ? FIN(I_RELB)[t5_bucket_dev(d * r) * 28 + 16 + hd] * LOG2E : NEGBIG; }
    }
}

__device__ __forceinline__ void fill_tab(LAS float* tab, const float* gtab, int maxoff, int lane) {
#pragma unroll
    for (int j = 0; j < 4; ++j) { const int idx = lane + 64 * j, d = idx - 32; tab[idx] = (d >= 0 && d <= maxoff) ? gtab[d] : NEGBIG; }
    LDS_WAIT();
}
template <int NDT> __device__ __forceinline__ void store_o_global_fp8(const f32x16 (&O)[NDT], float inv_l, unsigned char* rowp, int h) {
#pragma unroll
    for (int dt = 0; dt < NDT; ++dt)
#pragma unroll
        for (int g = 0; g < 4; ++g) *(unsigned*)(rowp + 32 * dt + 8 * g + 4 * h) = cvt4_fp8(O[dt][4 * g] * inv_l, O[dt][4 * g + 1] * inv_l, O[dt][4 * g + 2] * inv_l, O[dt][4 * g + 3] * inv_l);
}
template <int NDT> __device__ __forceinline__ void store_o_global(const f32x16 (&O)[NDT], float inv_l, bf16* rowp, int h) {
#pragma unroll
    for (int dt = 0; dt < NDT; ++dt)
#pragma unroll
        for (int g = 0; g < 4; ++g) { v2u w; w.x = pg8::cvt_pk_bf16(O[dt][4 * g] * inv_l, O[dt][4 * g + 1] * inv_l); w.y = pg8::cvt_pk_bf16(O[dt][4 * g + 2] * inv_l, O[dt][4 * g + 3] * inv_l);
            *(v2u*)(rowp + 32 * dt + 8 * g + 4 * h) = w; }
}
__device__ __forceinline__ void p2_attention(Frame& F) {
    const bf16* qkv = (const bf16*)(F.ws + WS_QKV);
    unsigned char* oab = F.ws + WS_OA;
    const float* tabA = (const float*)(F.ws + WS_TAB); const float* tabB = tabA + 16 * TABW;
    LAS float* tab = (LAS float*)(F.lds + ATT_TAB_OFF + F.wave * 1024);
    LAS unsigned char* vst = F.lds + ATT_V_OFF + F.wave * ATT_V_WAVE64; LAS unsigned char* kst = F.lds + ATT_K_OFF64 + F.wave * ATT_K_WAVE64;
    LAS unsigned char* OB = F.lds + ATT_OB_OFF; LAS float* LSE = (LAS float*)(F.lds + ATT_LSE_OFF);
    const int lane = F.lane, w = F.wave, q = lane & 31, h = lane >> 5;
    constexpr int NBU = BATCH * 12 * 32, NAU = BATCH * 64 * 4;
    for (int L = F.vcu; L < NBU + NAU; L += F.G) {
        const bool isB = L < NBU;
        int b, hd = 0, t0 = 0, qblk = 0, hk = 0;
        if (isB) { b = L / 384; hd = (L / 32) % 12; t0 = (L % 32) * 256; } else { const int LA = L - NBU; b = LA / 256; qblk = (LA / 4) % 64; hk = LA % 4; }
        const long brow = (long)b * SEQ;
        const int njobs = isB ? 4 : 2;
#pragma unroll 1
        for (int jj = 0; jj < njobs; ++jj) {
            AttnJob J; J.ldq = NQKV; J.ldkv = NQKV;
            int mode, p = 0, qs0 = 0, qsm = 0, nvalid = 32, maxoff = 128; const float* gtab;
            if (isB) {
                J.q = qkv + C_QB + hd * 64; J.k = qkv + C_KB + hd * 64; J.v = qkv + C_VB + hd * 64; J.m_init = 0.f; J.l_init = 0.f;
                if (jj == 0) { const int c = w >> 1, n = w & 1; mode = 1; p = 1; J.i0 = t0 / 4 + 32 * n; J.qrow0 = brow + t0 + c + 128 * n; J.qstride = 4; J.qmask = 31; J.krow0 = brow + c; J.kstride = 4;
                    J.u_begin = (J.i0 - 128) > 0 ? (J.i0 - 128) : 0; J.ntiles = (J.i0 + 32 - J.u_begin) / 32; qs0 = c + 128 * n; qsm = 4; }
                else if (jj < 3) { const int c = w + 8 * (jj - 1); mode = 1; p = 2; J.i0 = t0 / 16; J.qrow0 = brow + t0 + c; J.qstride = 16; J.qmask = 15; J.krow0 = brow + c; J.kstride = 16;
                    int ub = (J.i0 - 128) & ~31; if (ub < 0) ub = 0; J.u_begin = ub; J.ntiles = (((J.i0 + 15) & ~31) - ub) / 32 + 1; qs0 = c; qsm = 16; nvalid = 16; }
                else { __syncthreads(); mode = 2; p = 0; J.i0 = t0 + 32 * w; J.qrow0 = brow + J.i0; J.qstride = 1; J.qmask = 31; J.krow0 = brow; J.kstride = 1;
                    J.u_begin = (J.i0 - 128) > 0 ? (J.i0 - 128) : 0; J.ntiles = (J.i0 + 32 - J.u_begin) / 32; }
                gtab = tabB + (p * 12 + hd) * TABW;
            } else {
                const int jid = w + 8 * jj, g = jid >> 2, qt = jid & 3; hd = hk * 4 + g; mode = 0; maxoff = 127;
                J.q = qkv + C_QA + hd * 64; J.k = qkv + C_KA + hk * 64; J.v = qkv + C_VA + hk * 64; J.m_init = FIN(I_SINK)[hd] * LOG2E; J.l_init = 1.0f;
                J.i0 = qblk * 128 + 32 * qt; J.qrow0 = brow + J.i0; J.qstride = 1; J.qmask = 31; J.krow0 = brow; J.kstride = 1;
                J.u_begin = (J.i0 - 128) > 0 ? (J.i0 - 128) : 0; J.ntiles = (J.i0 + 32 - J.u_begin) / 32;
                gtab = tabA + hd * TABW;
            }
            f32x16 O[2]; float mm, ll;
            attn_job<64, true, true>(J, tab, gtab, maxoff, vst, kst, lane, O, mm, ll);
            if (mode == 0) {
                store_o_global_fp8<2>(O, OAB_SCALE / ll, oab + (size_t)(brow + J.i0 + q) * (AW + BW) + hd * 64, h);
            } else if (mode == 1) {
                if (q < nvalid) {
                    const float inv_l = 1.0f / ll; const int qs = qs0 + qsm * q;
                    LAS unsigned char* op = OB + ((p - 1) * 256 + qs) * 128;
#pragma unroll
                    for (int dt = 0; dt < 2; ++dt)
#pragma unroll
                        for (int g = 0; g < 4; ++g) { v2u wv; wv.x = pg8::cvt_pk_bf16(O[dt][4 * g] * inv_l, O[dt][4 * g + 1] * inv_l); wv.y = pg8::cvt_pk_bf16(O[dt][4 * g + 2] * inv_l, O[dt][4 * g + 3] * inv_l);
                            *(LAS v2u*)(op + (32 * dt + 8 * g + 4 * h) * 2) = wv; }
                    if (h == 0) LSE[(p - 1) * 256 + qs] = mm + __builtin_amdgcn_logf(ll);
                }
            } else {
                const int qs = 32 * w + q;
                const float l0 = mm + __builtin_amdgcn_logf(ll), l1 = LSE[qs], l2 = LSE[256 + qs];
                const float mx = fmaxf(l0, fmaxf(l1, l2)), w0 = fast_exp2(l0 - mx), w1 = fast_exp2(l1 - mx), w2 = fast_exp2(l2 - mx), inv = 1.0f / (w0 + w1 + w2);
                const float c0 = w0 * inv / ll * OAB_SCALE, c1 = w1 * inv * OAB_SCALE, c2 = w2 * inv * OAB_SCALE;
                unsigned char* rowp = oab + (size_t)(brow + J.i0 + q) * (AW + BW) + AW + hd * 64;
#pragma unroll
                for (int dt = 0; dt < 2; ++dt)
#pragma unroll
                    for (int g = 0; g < 4; ++g) { const int d = 32 * dt + 8 * g + 4 * h;
                        const v2u a = *(const LAS v2u*)(OB + (qs) * 128 + d * 2), c = *(const LAS v2u*)(OB + (256 + qs) * 128 + d * 2);
                        const float r0 = c0 * O[dt][4 * g] + c1 * bf_lo(a.x) + c2 * bf_lo(c.x), r1 = c0 * O[dt][4 * g + 1] + c1 * bf_hi(a.x) + c2 * bf_hi(c.x);
                        const float r2 = c0 * O[dt][4 * g + 2] + c1 * bf_lo(a.y) + c2 * bf_lo(c.y), r3 = c0 * O[dt][4 * g + 3] + c1 * bf_hi(a.y) + c2 * bf_hi(c.y);
                        *(unsigned*)(rowp + d) = cvt4_fp8(r0, r1, r2, r3); }
            }
        }
        if (isB) __syncthreads();
    }
}

__device__ __forceinline__ void p6_cross_attention(Frame& F) {
    const bf16* qx = (const bf16*)(F.ws + WS_QX); const bf16* kvx = (const bf16*)(F.ws + WS_KVX); bf16* ox = (bf16*)(F.ws + WS_OX);
    LAS unsigned char* vst = F.lds + ATT_V_OFF + F.wave * ATT_V_WAVE128; LAS unsigned char* kst = F.lds + ATT_K_OFF128 + F.wave * ATT_K_WAVE128;
    const int lane = F.lane, q = lane & 31, h = lane >> 5;
    for (int jid = F.vcu * NWAVES + F.wave; jid < BATCH * 4 * 256; jid += F.G * NWAVES) {
        const int b = jid / 1024, hd = (jid / 256) % 4, qt = jid % 256;
        AttnJob J; J.q = qx + hd * 128; J.q2 = (const bf16*)(F.ws + WS_QX2) + hd * 128; J.ldq = XW; J.qrow0 = (long)b * SEQ + 32 * qt; J.qstride = 1; J.qmask = 31;
        J.k = kvx + hd * 128; J.v = kvx + XW + hd * 128; J.ldkv = 2 * XW; J.krow0 = (long)b * MEML; J.kstride = 1; J.i0 = 0; J.u_begin = 0; J.ntiles = MEML / 32; J.m_init = 0.f; J.l_init = 0.f;
        f32x16 O[4]; float mm, ll;
        attn_job<128, false, false, true>(J, nullptr, nullptr, 0, vst, kst, lane, O, mm, ll);
        store_o_global<4>(O, 1.0f / ll, ox + (size_t)(J.qrow0 + q) * XW + hd * 128, h);
    }
}

constexpr int RT_XS_STRIDE = 260, RT_XS_BUF = 64 * 260;
constexpr int RT_EP_OFF = 0, RT_GP_OFF = 32768, RT_SS_OFF = 36864, RT_CNT_OFF = 37120;
constexpr int RT_WG_OFF = 2 * RT_XS_BUF * 4;
constexpr size_t TAB_WRE2 = 65536;
__device__ __forceinline__ void p8_topk(Frame& F) {
    const float* part = (const float*)(F.ws + WS_PART); const float* ssq = (const float*)(F.ws + WS_SSQ);
    int* tok_e = (int*)(F.ws + WS_ROUTE + RT_E); float* tok_w = (float*)(F.ws + WS_ROUTE + RT_W); int* tok_slot = (int*)(F.ws + WS_ROUTE + RT_SLOT); float* rstd2 = (float*)(F.ws + WS_ROUTE + RT_RSTD);
    unsigned* gcnt = (unsigned*)(F.ctl + CW_CNT);
    LAS int* cnt = (LAS int*)(F.lds + RT_CNT_OFF); LAS int* cbase = cnt + 32;
    const int tid = F.tid, w = F.wave, lane = F.lane;
    { int* row_tok = (int*)(F.ws + WS_ROUTE + RT_ROWTOK); for (int i = (F.vcu * NWAVES + w) * 64 + lane; i < MAXPANEL * 256; i += F.G * NWAVES * 64) row_tok[i] = 0; }
    constexpr size_t QS = (size_t)M * 36;
    for (int blk = F.vcu; blk < M / 64; blk += F.G) {
        const int r0 = blk * 64;
        __syncthreads();
        if (tid < 32) cnt[tid] = 0;
        __syncthreads();
        int e0 = 0, e1 = 0; float gw0 = 0.f, gw1 = 0.f;
        if (tid < 64) {
            const int t = r0 + tid; float s = 0.f;
#pragma unroll
            for (int j = 0; j < 8; ++j) { const f32x4 p = *(const f32x4*)(ssq + (size_t)t * 32 + 4 * j); s += (p[0] + p[1]) + (p[2] + p[3]); }
            const float rs = 1.0f / sqrtf(s * (1.0f / D) + EPS);
            const float* pt = part + (size_t)t * 36;
            f32x4 g4 = *(const f32x4*)(pt + 32);
#pragma unroll
            for (int q = 1; q < 4; ++q) g4 += *(const f32x4*)(pt + q * QS + 32);
            float gl[4] = {g4[0] * rs, g4[1] * rs, g4[2] * rs, g4[3] * rs};
            int gi = 0; float gmx = gl[0];
#pragma unroll
            for (int j = 1; j < 4; ++j) if (gl[j] > gmx) { gmx = gl[j]; gi = j; }
            float gden = 0.f;
#pragma unroll
            for (int j = 0; j < 4; ++j) gden += expf(gl[j] - gmx);
            const float ggate = 1.0f / gden;
            f32x4 ea = *(const f32x4*)(pt + gi * 8), eb = *(const f32x4*)(pt + gi * 8 + 4);
#pragma unroll
            for (int q = 1; q < 4; ++q) { ea += *(const f32x4*)(pt + q * QS + gi * 8); eb += *(const f32x4*)(pt + q * QS + gi * 8 + 4); }
            const float el[8] = {ea[0] * rs, ea[1] * rs, ea[2] * rs, ea[3] * rs, eb[0] * rs, eb[1] * rs, eb[2] * rs, eb[3] * rs};
            int i0 = 0; float v0 = el[0];
#pragma unroll
            for (int j = 1; j < 8; ++j) if (el[j] > v0) { v0 = el[j]; i0 = j; }
            int i1 = -1; float v1 = -3.0e38f;
#pragma unroll
            for (int j = 0; j < 8; ++j) if (j != i0 && el[j] > v1) { v1 = el[j]; i1 = j; }
            const float p1 = expf(v1 - v0), den = 1.0f + p1;
            gw0 = ggate / den; gw1 = ggate * p1 / den; e0 = gi * 8 + i0; e1 = gi * 8 + i1;
            rstd2[t] = rs;
        }
        int s0 = 0, s1 = 0;
        if (tid < 64) { s0 = __hip_atomic_fetch_add(&cnt[e0], 1, __ATOMIC_RELAXED, __HIP_MEMORY_SCOPE_WORKGROUP); s1 = __hip_atomic_fetch_add(&cnt[e1], 1, __ATOMIC_RELAXED, __HIP_MEMORY_SCOPE_WORKGROUP); }
        __syncthreads();
        if (tid < 32) cbase[tid] = (int)__hip_atomic_fetch_add(&gcnt[tid], (unsigned)cnt[tid], __ATOMIC_RELAXED, __HIP_MEMORY_SCOPE_AGENT);
        __syncthreads();
        if (tid < 64) { const int t = r0 + tid;
            tok_e[2 * t] = e0; tok_e[2 * t + 1] = e1; tok_w[2 * t] = gw0; tok_w[2 * t + 1] = gw1; tok_slot[2 * t] = cbase[e0] + s0; tok_slot[2 * t + 1] = cbase[e1] + s1; }
    }
}
struct OneUnit {
    int pm, pn;
    __device__ __forceinline__ bool next(int i, pg8::Unit& u) const { if (i) return false; u.pm = pm; u.pn = pn; return true; }
    __device__ __forceinline__ void a_ready(const pg8::Unit&) const {}
    __device__ __forceinline__ void done(const pg8::Unit&) const {}
};

__device__ __forceinline__ int build_panels(Frame& F, LAS int* pexp, LAS int* pstart) {
    LAS int* cnts = pstart + 64;
    if (F.tid < NEXP) cnts[F.tid] = (int)__hip_atomic_load((const unsigned*)(F.ctl + CW_CNT) + F.tid, __ATOMIC_RELAXED, __HIP_MEMORY_SCOPE_AGENT);
    __syncthreads();
    if (F.tid == 0) {
        int row = 0, np = 0;
        for (int e = 0; e < NEXP; ++e) { const int c = cnts[e]; pstart[e] = row; const int npan = (c + 255) / 256;
            for (int j = 0; j < npan; ++j) pexp[np + j] = e; np += npan; row += npan * 256; }
        pstart[NEXP] = np;
    }
    __syncthreads();
    return pstart[NEXP];
}

__device__ __forceinline__ void p9_rowmap(Frame& F) {
    LAS int* pexp = (LAS int*)(F.lds + PEXP_OFF); LAS int* pstart = pexp + MAXPANEL;
    build_panels(F, pexp, pstart);
    const int* tok_e = (const int*)(F.ws + WS_ROUTE + RT_E); const int* tok_slot = (const int*)(F.ws + WS_ROUTE + RT_SLOT); int* tok_dest = (int*)(F.ws + WS_ROUTE + RT_DEST);
    const float* rstd2 = (const float*)(F.ws + WS_ROUTE + RT_RSTD); float* rsort = (float*)(F.ws + WS_ROUTE + RT_RSORT); int* row_tok = (int*)(F.ws + WS_ROUTE + RT_ROWTOK);
    for (int a = (F.vcu * NWAVES + F.wave) * 64 + F.lane; a < 2 * M; a += F.G * NWAVES * 64) {
        const int t = a >> 1, dest = pstart[tok_e[a]] + tok_slot[a];
        tok_dest[a] = dest; row_tok[dest] = t; rsort[dest] = rstd2[t];
    }
}

struct MoeOrder {
    int npanel, ntile, G, c; const LAS int* pexp;
    __device__ __forceinline__ bool next(int i, pg8::Unit& u) const { const long L = (long)i * G + c; if (L >= (long)npanel * ntile) return false; const int pm = (int)(L / ntile), j = (int)(L % ntile); u.pm = pm; u.pn = pexp[pm] * ntile + j; return true; }
    __device__ __forceinline__ void a_ready(const pg8::Unit&) const {}
    __device__ __forceinline__ void done(const pg8::Unit&) const {}
};

__device__ __forceinline__ float fp8_to_f32(unsigned b) { const float v = __builtin_bit_cast(float, (b & 0x7Fu) << 20) * 1.329227995784916e36f; return (b & 0x80u) ? -v : v; }
__device__ __forceinline__ f32x4 fp8x4_to_f32(unsigned w) { return (f32x4){fp8_to_f32(w & 0xFFu), fp8_to_f32((w >> 8) & 0xFFu), fp8_to_f32((w >> 16) & 0xFFu), fp8_to_f32(w >> 24)}; }
template <bool MOE, bool XBF = false> __device__ __forceinline__ void p12_final(Frame& F, const float* x2, const bf16* tap = nullptr, int tap_ld = 0, int tap_cols = 0) { const bf16* y = (const bf16*)(F.ws + WS_Y);
    const int* tok_dest = (const int*)(F.ws + WS_ROUTE + RT_DEST); const float* tok_w = (const float*)(F.ws + WS_ROUTE + RT_W);
    const float* gf = FIN(I_GFIN);
    for (int t = F.vcu * NWAVES + F.wave; t < M; t += F.G * NWAVES) {
        int d0 = 0, d1 = 0; float w0 = 0.f, w1 = 0.f; if (MOE) { d0 = tok_dest[2 * t]; d1 = tok_dest[2 * t + 1]; w0 = tok_w[2 * t]; w1 = tok_w[2 * t + 1]; }
        const f32x4* xr = (const f32x4*)(x2 + (size_t)t * D) + F.lane; const v2u* y0 = (const v2u*)(y + (size_t)d0 * D) + F.lane; const v2u* y1 = (const v2u*)(y + (size_t)d1 * D) + F.lane;
        f32x4 v[8]; float s = 0.f;
#pragma unroll
        for (int j = 0; j < 8; ++j) { f32x4 xv; if (XBF) { const v2u xb = ((const v2u*)((const bf16*)x2 + (size_t)t * D) + F.lane)[64 * j]; xv = (f32x4){bf_lo(xb.x), bf_hi(xb.x), bf_lo(xb.y), bf_hi(xb.y)}; } else xv = xr[64 * j]; if (MOE) {
#ifdef MK_NT12
            const v2u a = __builtin_nontemporal_load(y0 + 64 * j), b = __builtin_nontemporal_load(y1 + 64 * j);
#else
            const v2u a = y0[64 * j], b = y1[64 * j];
#endif

            xv[0] += w0 * bf_lo(a.x) + w1 * bf_lo(b.x); xv[1] += w0 * bf_hi(a.x) + w1 * bf_hi(b.x); xv[2] += w0 * bf_lo(a.y) + w1 * bf_lo(b.y); xv[3] += w0 * bf_hi(a.y) + w1 * bf_hi(b.y); }
            if (tap) { const int col = 4 * (F.lane + 64 * j); if (col < tap_cols) { const v2u a = *(const v2u*)(tap + (size_t)t * tap_ld + col); xv[0] += bf_lo(a.x); xv[1] += bf_hi(a.x); xv[2] += bf_lo(a.y); xv[3] += bf_hi(a.y); } }
            v[j] = xv; s += (xv[0] * xv[0] + xv[1] * xv[1]) + (xv[2] * xv[2] + xv[3] * xv[3]); }
        const float rstd = 1.0f / sqrtf(wave_sum(s) * (1.0f / D) + EPS);
        f32x4* orow = (f32x4*)(F.out + (size_t)t * D) + F.lane; const f32x4* gr = (const f32x4*)gf + F.lane;
#pragma unroll
        for (int j = 0; j < 8; ++j) {
#ifdef MK_NT12
            __builtin_nontemporal_store(v[j] * rstd * gr[64 * j], orow + 64 * j);
#else
            orow[64 * j] = v[j] * rstd * gr[64 * j];
#endif
        }
    }
}

#ifndef MK_PER_PHASE
#define MK_PER_PHASE 0
#endif
#ifndef MK_STOP_AFTER
#define MK_STOP_AFTER 11
#endif
#ifndef MK_REPEAT_MASK
#define MK_REPEAT_MASK 0
#endif
#ifndef MK_RT_PROBE
#define MK_RT_PROBE 0
#endif
#if MK_RT_PROBE
#define MK_REPS(k) (1 + ((rep_mask >> (k)) & 1))
#else
#define MK_REPS(k) (1 + ((MK_REPEAT_MASK >> (k)) & 1))
#endif
#ifndef MK_STAMP_BASE
#define MK_STAMP_BASE 0
#endif
#ifndef MK_NG1
#define MK_NG1 248
#endif
constexpr int NG1 = MK_NG1;
constexpr int NPHASE = 13;
#ifndef MK_DEEPS
#define MK_DEEPS true
#endif
#ifndef MK_DEEP10
#define MK_DEEP10 true
#endif
#ifndef MK_C1
#define MK_C1 0
#define MK_C3 4096
#define MK_C4 4096
#define MK_C5 0
#define MK_C7 0
#endif
constexpr int CV_1 = MK_C1, CV_3 = CV_1 + MK_C3, CV_4 = CV_3 + MK_C4, CV_5 = CV_4 + MK_C5, CV_7 = CV_5 + MK_C7;
static_assert(CV_7 >= N_W13 && CV_7 <= N_WEXP, "w1 / w3 are complete before P10");


__global__ void __launch_bounds__(NWAVES * 64, 2) mega_fwd(Args args) {
    extern __shared__ __attribute__((aligned(16))) unsigned char lds[];
    Frame F;
    F.lds = (LAS unsigned char*)lds;
    F.MISC = (volatile LAS unsigned*)(F.lds + MISC_OFF);
    F.tid = threadIdx.x; F.lane = F.tid & 63; F.wave = __builtin_amdgcn_readfirstlane(F.tid >> 6);
    F.G = gridDim.x; { const int bx = blockIdx.x; F.vcu = (F.G % 8 == 0) ? (bx % 8) * (F.G / 8) + bx / 8 : bx; }
    F.ws = args.ws; F.ctl = (gu32*)(args.ws + WS_CTL); F.out = args.out;
    if (F.tid < 16) F.MISC[F.tid] = 0u;
    if (F.tid == 0) {
#pragma unroll
        for (int i = 0; i < 24; ++i) { const unsigned long long pv = (unsigned long long)args.in[i]; F.MISC[16 + 2 * i] = (unsigned)pv; F.MISC[17 + 2 * i] = (unsigned)(pv >> 32); } }
    __syncthreads();
    const int lo = args.ph_lo, hi = args.ph_hi; const int rep_mask = __builtin_amdgcn_readfirstlane(args.rep_mask); (void)rep_mask;
    XcdBarrier bar; bar.bar = (unsigned*)(F.ctl + CW_BAR); bar.x = 0; bar.st = nullptr;
    if (hi - lo > 1) bar = xcd_barrier_post((unsigned*)(F.ctl + CW_BAR), F.MISC + 8);
#define IN(k) (lo <= (k) && (k) < hi && ((k) <= MK_STOP_AFTER || (k) == 12))
#define INR(k) (lo <= (k) && (k) < hi)
#ifdef MK_STAMP_PHASE
    unsigned long long st_t0 = __builtin_amdgcn_s_memrealtime(), st_tk = 0;
#define SEAM(k) do { if (INR(k) && INR((k) + 1) && (k) <= MK_STOP_AFTER) xcd_barrier(bar); if ((k) == MK_STAMP_PHASE - 1 && MK_STAMP_PHASE != 13) st_t0 = __builtin_amdgcn_s_memrealtime(); if ((k) == MK_STAMP_PHASE) st_tk = __builtin_amdgcn_s_memrealtime(); } while (0)
#else
#define SEAM(k) do { if (INR(k) && INR((k) + 1) && (k) <= MK_STOP_AFTER) xcd_barrier(bar); } while (0)
#endif
    LAS unsigned char* ring = F.lds + RING_OFF;
    LAS int* pexp = (LAS int*)(F.lds + PEXP_OFF); LAS int* pstart = pexp + MAXPANEL;

    for (int rep_ = 0; rep_ < MK_REPS(0); ++rep_) { if (rep_) xcd_barrier(bar); if (IN(0)) { p0_prologue(F); } } SEAM(0);

    for (int rep_ = 0; rep_ < MK_REPS(1); ++rep_) { if (rep_) xcd_barrier(bar); if (IN(1)) {
        const int G1 = F.G > NG1 ? NG1 : F.G / 2;
        if ((int)blockIdx.x < G1) {
            pg8::Gemm g{(const bf16*)(F.ws + WS_H), (const bf16*)(F.ws + WS_BT1), M, NB1, D / 2}; pg8::StaticOrder S; S.init(M, NB1, G1, (int)blockIdx.x);
            EpiQKVG E{(bf16*)(F.ws + WS_QKV), (bf16*)(F.ws + WS_GA), (bf16*)(F.ws + WS_GB), FIN(I_BGATE)};
            pg8::gemm_phase<EpiQKVG, pg8::StaticOrder, true, true, 2, true>(ring, g, S, E);
        } else { p0_convert_rest<0>(F, (int)blockIdx.x - G1, F.G - G1); p0_convert_rest<1>(F, (int)blockIdx.x - G1, F.G - G1); convert_w(F, 0, CV_1, ((int)blockIdx.x - G1) * NWAVES + F.wave, (F.G - G1) * NWAVES); }
    } } SEAM(1);

    for (int rep_ = 0; rep_ < MK_REPS(2); ++rep_) { if (rep_) xcd_barrier(bar); if (IN(2)) { p2_attention(F); } } SEAM(2);

    for (int rep_ = 0; rep_ < MK_REPS(3); ++rep_) { if (rep_) xcd_barrier(bar); if (IN(3)) {
        pg8::Gemm g{(const bf16*)(F.ws + WS_OA), (const bf16*)(F.ws + WS_WA), M, D, (AW + BW) / 2}; pg8::StaticOrder S; S.init(M, D, F.G, (int)blockIdx.x);
        EpiMix E{(const bf16*)(F.ws + WS_GA), (const bf16*)(F.ws + WS_GB), F.ws + WS_MIX8};
        const int grp = ((int)blockIdx.x >> 3) & 1, wsl = ((((int)blockIdx.x >> 4) << 3) + ((int)blockIdx.x & 7)) * NWAVES + F.wave, nws = (F.G >> 1) * NWAVES;
        if (grp) { convert_w<MK_DEEPS>(F, CV_1, CV_3, wsl, nws); __syncthreads(); }
        pg8::gemm_phase<EpiMix, pg8::StaticOrder, true, true, 2, true>(ring, g, S, E);
    } } SEAM(3);

    for (int rep_ = 0; rep_ < MK_REPS(4); ++rep_) { if (rep_) xcd_barrier(bar); if (IN(4)) {
#ifdef MK_STAG4
        if (((int)blockIdx.x >> 3) & 1) { const unsigned long long t0_ = __builtin_amdgcn_s_memrealtime(); while (__builtin_amdgcn_s_memrealtime() - t0_ < (unsigned long long)(MK_STAG4) * 100ull) __builtin_amdgcn_s_sleep(8); }
#endif
        pg8::Gemm g{(const bf16*)(F.ws + WS_MIX8), (const bf16*)(F.ws + WS_WO), M, D, D / 2}; pg8::StaticOrder S; S.init(M, D, F.G, (int)blockIdx.x);
        EpiResid E{FIN(I_X), (bf16*)(F.ws + WS_X1), (float*)(F.ws + WS_SSQ)};
        const int grp = ((int)blockIdx.x >> 3) & 1, wsl = ((((int)blockIdx.x >> 4) << 3) + ((int)blockIdx.x & 7)) * NWAVES + F.wave, nws = (F.G >> 1) * NWAVES;
        if (grp) { convert_w<MK_DEEPS>(F, CV_3, CV_4, wsl, nws); __syncthreads(); }
        pg8::gemm_phase<EpiResid, pg8::StaticOrder, true, true, 2, true>(ring, g, S, E);
        if (!grp) {
            const int wgi = (((int)blockIdx.x >> 4) << 3) + ((int)blockIdx.x & 7);
            if (wgi < 32) { __syncthreads(); const int kq = wgi & 3, tl = wgi >> 2;
                pg8::Gemm gk{(const bf16*)(F.ws + WS_MEMN) + kq * 512, (const bf16*)(F.ws + WS_WXKV) + kq * 512, BATCH * MEML, 2 * XW, 512}; OneUnit Sk{tl >> 2, tl & 3};
                EpiF32 Ek{(float*)(F.ws + WS_KVP) + (size_t)kq * (BATCH * MEML) * (2 * XW), 2 * XW};
                pg8::gemm_phase<EpiF32, OneUnit, true, true, 0, false, D, D>(ring, gk, Sk, Ek); } }
    } } SEAM(4);

    for (int rep_ = 0; rep_ < MK_REPS(5); ++rep_) { if (rep_) xcd_barrier(bar); if (IN(5)) {
        { const float* kvp = (const float*)(F.ws + WS_KVP); bf16* kvx = (bf16*)(F.ws + WS_KVX); constexpr int NKV = BATCH * MEML * 2 * XW;
          for (int i = ((int)blockIdx.x * (NWAVES * 64) + F.tid) * 4; i < NKV; i += F.G * NWAVES * 64 * 4) {
              const f32x4 s4 = (*(const f32x4*)(kvp + i) + *(const f32x4*)(kvp + NKV + i)) + (*(const f32x4*)(kvp + 2 * NKV + i) + *(const f32x4*)(kvp + 3 * NKV + i));
              v2u o; o.x = pg8::cvt_pk_bf16(s4[0], s4[1]); o.y = pg8::cvt_pk_bf16(s4[2], s4[3]); *(v2u*)(kvx + i) = o; } }
#pragma unroll 1
        for (int L = (int)blockIdx.x; L < 2 * (M / 256) * (XW / 256); L += F.G) { const int half = L / ((M / 256) * (XW / 256));
            pg8::StaticOrder So; So.init(M, XW, (M / 256) * (XW / 256), L % ((M / 256) * (XW / 256))); pg8::Unit u0; So.next(0, u0);
            pg8::Gemm g{(const bf16*)(F.ws + WS_X1) + half * (D / 2), (const bf16*)(F.ws + WS_WXQ) + half * (D / 2), M, XW, D / 2}; OneUnit S{u0.pm, u0.pn};
            EpiQx E{(bf16*)(F.ws + (half ? WS_QX2 : WS_QX)), (const float*)(F.ws + WS_SSQ), 0.08838834764831845f * LOG2E};
            pg8::gemm_phase<EpiQx, OneUnit, true, true, 0, false, D, D>(ring, g, S, E); }
    } } SEAM(5);

    for (int rep_ = 0; rep_ < MK_REPS(6); ++rep_) { if (rep_) xcd_barrier(bar); if (IN(6)) { p6_cross_attention(F); } } SEAM(6);

    for (int rep_ = 0; rep_ < MK_REPS(7); ++rep_) { if (rep_) xcd_barrier(bar); if (IN(7)) {
        pg8::Gemm g{(const bf16*)(F.ws + WS_OX), (const bf16*)(F.ws + WS_WXO), M, D, XW}; pg8::StaticOrder S; S.init(M, D, F.G, (int)blockIdx.x);
        EpiResid2 E{(bf16*)(F.ws + WS_X1), F.ws + WS_HM, FIN(I_GMOE), (float*)(F.ws + WS_SSQ)};
        const int grp = ((int)blockIdx.x >> 3) & 1, wsl = ((((int)blockIdx.x >> 4) << 3) + ((int)blockIdx.x & 7)) * NWAVES + F.wave, nws = (F.G >> 1) * NWAVES;
        if (grp) { convert_w<MK_DEEPS>(F, CV_5, CV_7, wsl, nws); __syncthreads(); }
        pg8::gemm_phase<EpiResid2, pg8::StaticOrder, true, true>(ring, g, S, E);
    } } SEAM(7);

    for (int rep_ = 0; rep_ < MK_REPS(8); ++rep_) { if (rep_) xcd_barrier(bar); if (IN(8)) {
#pragma unroll 1
        for (int L = (int)blockIdx.x; L < 4 * (M / 256); L += F.G) { const int pm = L >> 2, kq = L & 3;
            pg8::Gemm g{(const bf16*)(F.ws + WS_X1) + kq * 512, (const bf16*)(F.ws + WS_W3), M, 256, 512}; OneUnit S{pm, kq};
            EpiLogit E{(float*)(F.ws + WS_PART) + (size_t)kq * M * 36};
            pg8::gemm_phase<EpiLogit, OneUnit, true, true, 0, false, D>(ring, g, S, E); }
        xcd_barrier(bar);
        p8_topk(F);
    } } SEAM(8);
    for (int rep_ = 0; rep_ < MK_REPS(9); ++rep_) { if (rep_) xcd_barrier(bar); if (IN(9)) { p9_rowmap(F); } } SEAM(9);

    for (int rep_ = 0; rep_ < MK_REPS(10); ++rep_) { if (rep_) xcd_barrier(bar); if (IN(10)) {
        const int np = build_panels(F, pexp, pstart);
        {
            const int ntot = np * 4, R = (ntot + F.G - 1) / F.G, hv = ntot - (R - 1) * F.G, nl = F.G - hv;
            int wsl = F.vcu * NWAVES + F.wave, nws = F.G * NWAVES, hi = N_WEXP;
            if (nl * NWAVES * 4 >= N_WEXP - CV_7) { nws = nl * NWAVES; if (F.vcu >= hv) wsl = (F.vcu - hv) * NWAVES + F.wave; else { wsl = 0; hi = CV_7; } }
            convert_w<MK_DEEP10>(F, CV_7, hi, wsl, nws); __syncthreads();
        }
        pg8::Gemm g{(const bf16*)(F.ws + WS_HM), (const bf16*)(F.ws + WS_W13), MAXPANEL * 256, NEXP * 1024, D / 2}; MoeOrder S{np, 4, F.G, F.vcu, pexp};
        EpiSwiGLU E{F.ws + WS_ACT, (const float*)(F.ws + WS_ROUTE + RT_RSORT)};
        pg8::gemm_phase<EpiSwiGLU, MoeOrder, true, true, 1, true>(ring, g, S, E, (const int*)(F.ws + WS_ROUTE + RT_ROWTOK));
    } } SEAM(10);

    for (int rep_ = 0; rep_ < MK_REPS(11); ++rep_) { if (rep_) xcd_barrier(bar); if (IN(11)) {
        const int np = build_panels(F, pexp, pstart);
#ifdef MK_STAG11
        { const int ntot = np * 8, R = (ntot + F.G - 1) / F.G, hv = ntot - (R - 1) * F.G;
          if (F.vcu >= hv) { const unsigned long long t0_ = __builtin_amdgcn_s_memrealtime(); while (__builtin_amdgcn_s_memrealtime() - t0_ < (unsigned long long)(MK_STAG11) * 100ull) __builtin_amdgcn_s_sleep(8); } }
#endif
        int k2 = DFF / 2; asm volatile("" : "+s"(k2));
        pg8::Gemm g{(const bf16*)(F.ws + WS_ACT), (const bf16*)(F.ws + WS_W2), MAXPANEL * 256, NEXP * 2048, k2}; MoeOrder S{np, 8, F.G, F.vcu, pexp};
        EpiBf E{(bf16*)(F.ws + WS_Y), D, 8, 1.0f / (ACT_SCALE * W2_SCALE)};
        pg8::gemm_phase<EpiBf, MoeOrder, true, true, 2, true>(ring, g, S, E);
    } } SEAM(11);

#ifdef MK_TAP
    for (int rep_ = 0; rep_ < MK_REPS(12); ++rep_) { if (rep_) xcd_barrier(bar); if (IN(12)) { p12_final<false>(F, FIN(I_X), (const bf16*)(F.ws + (MK_TAP_OFF)), MK_TAP_LD, MK_TAP_COLS); } }
#else
    for (int rep_ = 0; rep_ < MK_REPS(12); ++rep_) { if (rep_) xcd_barrier(bar); if (IN(12)) { p12_final<(MK_STOP_AFTER >= 11), (MK_STOP_AFTER >= 4)>(F, (MK_STOP_AFTER >= 4) ? (const float*)(F.ws + WS_X1) : FIN(I_X)); } }
#endif
#ifdef MK_STAMP_PHASE
    xcd_barrier(bar);
    if (MK_STAMP_PHASE == 12) st_tk = __builtin_amdgcn_s_memrealtime();
    if (MK_STAMP_PHASE == 13) { st_tk = __builtin_amdgcn_s_memrealtime(); }
    if (blockIdx.x == 0) { for (int i = F.tid; i < 48 * D; i += NWAVES * 64) F.out[D + i] += 1.0f; }
    if (blockIdx.x == 0 && F.tid == 0) F.out[0] = MK_STAMP_BASE > 0 ? ((float)(st_tk - st_t0) * 0.01f - (float)MK_STAMP_BASE) * 0.125f : (float)(st_tk - st_t0) * (MK_STAMP_PHASE == 13 ? 0.0003125f : 0.00125f);
#endif
#undef IN
#undef INR
#undef SEAM
}

extern "C" void kernel_launch(void* const* d_in, const int* in_sizes, int n_in, void* d_out, int out_size, void* d_ws, size_t ws_size, hipStream_t stream) {
    static int grid = 0;
    if (grid == 0) {
        if (n_in != 24 || in_sizes[0] != M * D || out_size != M * D || ws_size < WS_END) { fprintf(stderr, "kernel_launch: unexpected shapes or workspace (%d inputs, ws %zu, need %zu); nothing launched\n", n_in, ws_size, (size_t)WS_END); grid = -1; return; }
        int dev = 0, cus = 0, per_cu = 0;
        if (hipGetDevice(&dev) != hipSuccess || hipDeviceGetAttribute(&cus, hipDeviceAttributeMultiprocessorCount, dev) != hipSuccess) { grid = -1; return; }
        if (hipFuncSetAttribute((const void*)mega_fwd, hipFuncAttributeMaxDynamicSharedMemorySize, LDS_BYTES) != hipSuccess) { fprintf(stderr, "kernel_launch: hipFuncSetAttribute failed\n"); grid = -1; return; }
        if (hipOccupancyMaxActiveBlocksPerMultiprocessor(&per_cu, (const void*)mega_fwd, NWAVES * 64, LDS_BYTES) != hipSuccess || per_cu < 1) { fprintf(stderr, "kernel_launch: occupancy query reports %d workgroups per CU\n", per_cu); }
        (void)hipGetLastError();
        grid = cus - cus % 16;
        if (grid < 144) { fprintf(stderr, "kernel_launch: %d CUs are too few for this kernel's phase layout\n", cus); grid = -1; return; }
    }
    if (grid < 0) return;
    if (hipMemsetAsync((char*)d_ws + WS_CTL, 0, CTL_ZERO_BYTES, stream) != hipSuccess) return;
    Args a{};
    for (int i = 0; i < 24; ++i) a.in[i] = (const float*)d_in[i];
    a.out = (float*)d_out; a.ws = (unsigned char*)d_ws; a.rep_mask = MK_REPEAT_MASK; a.pad = 0;
#if MK_PER_PHASE
    for (int p = 0; p < NPHASE; ++p) { if (p > MK_STOP_AFTER && p != 12) continue; a.ph_lo = p; a.ph_hi = p + 1; hipLaunchKernelGGL(mega_fwd, dim3(grid), dim3(NWAVES * 64), LDS_BYTES, stream, a); }
#else
    a.ph_lo = 0; a.ph_hi = NPHASE;
    hipLaunchKernelGGL(mega_fwd, dim3(grid), dim3(NWAVES * 64), LDS_BYTES, stream, a);
#endif
}
```

```cpp
#include <hip/hip_runtime.h>
#include <cstdio>
#include <cstdint>
namespace pg8 {
#define PG8_LAS __attribute__((address_space(3)))
typedef unsigned short bf16_t;
typedef short bf16x8 __attribute__((ext_vector_type(8)));
typedef float f32x4 __attribute__((ext_vector_type(4)));
typedef unsigned u32x4 __attribute__((ext_vector_type(4)));
constexpr int BM = 256, BK = 64, HALF = 128, HTB = HALF * BK * 2  , STAGE_BYTES = 8 * HTB, NXCD = 8, WGM = 8;

__host__ __device__ __forceinline__ int lds_byte(int r, int c) { const int st = (r >> 4) * 2 + (c >> 5), rr = r & 15, cc = c & 31, ob = rr * 64 + cc * 2; return st * 1024 + (ob ^ (((ob >> 9) & 1) << 5)); }
__host__ __device__ __forceinline__ void stage_rc(int b, int& R, int& C) { const int st = b / 1024, sb = b % 1024, swz = sb ^ (((sb >> 9) & 1) << 5); R = (st >> 1) * 16 + swz / 64; C = (st & 1) * 32 + (swz % 64) / 2; }
__host__ __device__ __forceinline__ int perm32(int rho) { const int n = rho >> 4, i = rho & 15; return 8 * (i >> 2) + 4 * n + (i & 3); }

struct Unit { int pm, pn; };
struct Gemm { const bf16_t* A; const bf16_t* Bt; int M, N, K; };

struct StaticOrder {
    int nM, nN, nwg, G, c;
    __host__ __device__ void init(int M, int N, int G_, int c_) { nM = M / BM; nN = N / BM; nwg = nM * nN; G = G_; c = c_; }
    __host__ __device__ __forceinline__ bool next(int i, Unit& u) const {
        const long L = (long)i * G + c; if (L >= nwg) return false;
        int wgid = (int)L; { const int q = nwg / NXCD, r = nwg % NXCD, xcd = wgid % NXCD, off = wgid / NXCD; wgid = (xcd < r ? xcd * (q + 1) : r * (q + 1) + (xcd - r) * q) + off; }
        const int nig = WGM * nN, gid = wgid / nig, fm = gid * WGM, gsz = (nM - fm) < WGM ? (nM - fm) : WGM;
        u.pm = fm + ((wgid % nig) % gsz); u.pn = (wgid % nig) / gsz; return true;
    }
    __device__ __forceinline__ void a_ready(const Unit&) const {}
    __device__ __forceinline__ void done(const Unit&) const {}
};

typedef __bf16 bf16x2_t __attribute__((ext_vector_type(2)));
__device__ __forceinline__ unsigned cvt_pk_bf16(float lo, float hi) { bf16x2_t v = {(__bf16)lo, (__bf16)hi}; return __builtin_bit_cast(unsigned, v); }
template <class Epi, class Sched, bool ALIGN_EPI = false, bool SP2 = false, int GATHER = 0  , bool FP8 = false, int LDA = 0  , int LDB = 0  >
__device__ __forceinline__ void gemm_phase(PG8_LAS unsigned char* lds, const Gemm g, const Sched& S, const Epi& E, const int* gidx = nullptr) {
    int tid_o = threadIdx.x; asm volatile("" : "+v"(tid_o));
    const int tid = tid_o, wid = __builtin_amdgcn_readfirstlane(tid >> 6), lane = tid & 63, wr = wid >> 2, wc = wid & 3, fr = lane & 15, fq = lane >> 4;
    const int K = g.K, nt = K / BK;
    unsigned voffA[2], voffB[2]; unsigned vAc[2][2] = {{0u, 0u}, {0u, 0u}};
#pragma unroll
    for (int i = 0; i < 2; ++i) { int R, C; stage_rc(tid * 16 + i * 8192, R, C); const int Rb = Epi::PERM ? ((R & ~31) + perm32(R & 31)) : R;
        voffA[i] = (unsigned)(R * (LDA ? LDA : K) + C) * 2u; voffB[i] = (unsigned)(Rb * (LDB ? LDB : K) + C) * 2u; }
    const size_t kstep = (size_t)(BK * 2);
    const size_t hstep = (size_t)HALF * K * 2;
    const size_t tstep = 2 * hstep;
    const size_t hstepA = LDA ? (size_t)HALF * LDA * 2 : hstep, tstepA = 2 * hstepA;
    const size_t hstepB = LDB ? (size_t)HALF * LDB * 2 : hstep, tstepB = 2 * hstepB;
    const unsigned ldsw = (unsigned)wid * 1024u;
    const int aoff = lds_byte(wr * 64 + fr, fq * 8), boff = lds_byte(wc * 32 + fr, fq * 8);
#define PG8_SA(b, h) (((b) * 2 + (h)) * HTB)
#define PG8_SB(b, h) ((4 + (b) * 2 + (h)) * HTB)
#define PG8_STAGE(bufoff, gbase, voff) do { _Pragma("unroll") for (int _i = 0; _i < 2; ++_i) \
        __builtin_amdgcn_global_load_lds((const unsigned*)((const char*)(gbase) + (voff)[_i]), (PG8_LAS unsigned*)(lds + (bufoff) + ldsw + _i * 8192), 16, 0, 0); } while (0)
#define PG8_STAGE_A(bufoff, gbase, half, usenext) do { if constexpr (GATHER != 0) { PG8_STAGE(bufoff, gbase, vAc[half]); } \
        else { PG8_STAGE(bufoff, (gbase) + ((half) ? hstepA : (size_t)0), voffA); } } while (0)
#define PG8_GIDX(dst, unit) do { _Pragma("unroll") for (int h_ = 0; h_ < 2; ++h_) _Pragma("unroll") for (int i_ = 0; i_ < 2; ++i_) { int R_, C_; stage_rc(tid * 16 + i_ * 8192, R_, C_); const int row_ = (unit).pm * BM + h_ * HALF + R_; dst[h_][i_] = (unsigned)((GATHER == 2 ? row_ : gidx[row_]) * K + C_) * 2u; } } while (0)
#define PG8_LDA(dst, b, h) do { _Pragma("unroll") for (int m = 0; m < 4; ++m) _Pragma("unroll") for (int k = 0; k < 2; ++k) dst[m][k] = *(const PG8_LAS bf16x8*)(lds + PG8_SA(b, h) + aoff + m * 2048 + k * 1024); } while (0)
#define PG8_LDB(dst, b, h) do { _Pragma("unroll") for (int n = 0; n < 2; ++n) _Pragma("unroll") for (int k = 0; k < 2; ++k) dst[n][k] = *(const PG8_LAS bf16x8*)(lds + PG8_SB(b, h) + boff + n * 2048 + k * 1024); } while (0)
#define PG8_MMA(ai, bj, At, Bt) do { __builtin_amdgcn_s_setprio(1); _Pragma("unroll") for (int m = 0; m < 4; ++m) _Pragma("unroll") for (int n = 0; n < 2; ++n) { \
        if constexpr (FP8) { typedef int v4i_ __attribute__((ext_vector_type(4))); typedef int v8i_ __attribute__((ext_vector_type(8))); \
            const v8i_ b8_ = __builtin_shufflevector(__builtin_bit_cast(v4i_, Bt[n][0]), __builtin_bit_cast(v4i_, Bt[n][1]), 0, 1, 2, 3, 4, 5, 6, 7); \
            const v8i_ a8_ = __builtin_shufflevector(__builtin_bit_cast(v4i_, At[m][0]), __builtin_bit_cast(v4i_, At[m][1]), 0, 1, 2, 3, 4, 5, 6, 7); \
            acc[ai][bj][m][n] = __builtin_amdgcn_mfma_scale_f32_16x16x128_f8f6f4(b8_, a8_, acc[ai][bj][m][n], 0, 0, 0, 0, 0, 0); } \
        else { _Pragma("unroll") for (int k = 0; k < 2; ++k) acc[ai][bj][m][n] = __builtin_amdgcn_mfma_f32_16x16x32_bf16(Bt[n][k], At[m][k], acc[ai][bj][m][n], 0, 0, 0); } } \
        __builtin_amdgcn_s_setprio(0); } while (0)
#define PG8_WAIT_V(n) asm volatile("s_waitcnt vmcnt(" #n ")" ::: "memory")
#define PG8_WAIT_L(n) asm volatile("s_waitcnt lgkmcnt(" #n ")" ::: "memory")
#define PG8_BAR __builtin_amdgcn_s_barrier()
#define PG8_SCHED __builtin_amdgcn_sched_barrier(0)
    Unit cur, nxt; int ui = 0;
    if (!S.next(0, cur)) return;
    f32x4 acc[2][2][4][2];
#pragma unroll
    for (int a = 0; a < 2; ++a)
#pragma unroll
        for (int b = 0; b < 2; ++b)
#pragma unroll
            for (int m = 0; m < 4; ++m)
#pragma unroll
                for (int n = 0; n < 2; ++n) acc[a][b][m][n] = (f32x4){0.f, 0.f, 0.f, 0.f};
    bf16x8 At[4][2], B0[2][2], B1[2][2];
    const char* cA = (const char*)g.A + (GATHER != 0 ? (size_t)0 : (size_t)cur.pm * tstepA); const char* cB = (const char*)g.Bt + (size_t)cur.pn * tstepB;
    S.a_ready(cur);
    if constexpr (GATHER != 0) PG8_GIDX(vAc, cur);
    if constexpr (SP2) {
        PG8_STAGE(PG8_SB(0, 0), cB, voffB); PG8_STAGE(PG8_SB(0, 1), cB + hstepB, voffB); PG8_STAGE_A(PG8_SA(0, 0), cA, 0, false); PG8_STAGE_A(PG8_SA(0, 1), cA, 1, false);
        if (wr == 1) PG8_BAR;
        PG8_WAIT_V(2); PG8_BAR;
        PG8_STAGE(PG8_SB(1, 0), cB + kstep, voffB); PG8_STAGE_A(PG8_SA(1, 0), cA + kstep, 0, false); PG8_STAGE(PG8_SB(1, 1), cB + hstepB + kstep, voffB);
        PG8_WAIT_V(6); PG8_BAR;
    } else {
        PG8_STAGE(PG8_SB(0, 0), cB, voffB); PG8_STAGE_A(PG8_SA(0, 0), cA, 0, false); PG8_STAGE(PG8_SB(0, 1), cB + hstepB, voffB); PG8_STAGE_A(PG8_SA(0, 1), cA, 1, false);
        if (wr == 1) PG8_BAR;
        PG8_WAIT_V(4); PG8_BAR;
        PG8_STAGE(PG8_SB(1, 0), cB + kstep, voffB); PG8_STAGE_A(PG8_SA(1, 0), cA + kstep, 0, false); PG8_STAGE(PG8_SB(1, 1), cB + hstepB + kstep, voffB);
        PG8_WAIT_V(6); PG8_BAR;
    }
    for (;;) {
        const bool has_next = S.next(ui + 1, nxt);
        const char* nA = has_next ? (const char*)g.A + (GATHER != 0 ? (size_t)0 : (size_t)nxt.pm * tstepA) : cA; const char* nB = has_next ? (const char*)g.Bt + (size_t)nxt.pn * tstepB : cB;
#pragma unroll 1
        for (int t = 0; t < nt; t += 2) {
            const bool last = (t == nt - 2);
            const char* a1 = cA + (size_t)(t + 1) * kstep;
            const char* a2 = last ? nA : cA + (size_t)(t + 2) * kstep; const char* b2 = last ? nB : cB + (size_t)(t + 2) * kstep;
            const char* a3 = a2 + kstep; const char* b3 = b2 + kstep;
            if constexpr (Epi::HAS_MID) { if (t == Epi::MID_T) E.mid(acc, cur, wr, wc, fr, fq); }
            if (last && has_next) S.a_ready(nxt);
            if constexpr (SP2) {
            PG8_LDB(B0, 0, 0); PG8_LDB(B1, 0, 1); PG8_SCHED; PG8_LDA(At, 0, 0); PG8_STAGE_A(PG8_SA(1, 1), a1, 1, false);
            if constexpr (GATHER != 0) { if (last && has_next) PG8_GIDX(vAc, nxt); }
            PG8_WAIT_V(8); PG8_WAIT_L(0); PG8_BAR; PG8_MMA(0, 0, At, B0); PG8_MMA(0, 1, At, B1); PG8_BAR; PG8_SCHED;
            PG8_LDA(At, 0, 1); PG8_STAGE(PG8_SB(0, 0), b2, voffB); PG8_STAGE(PG8_SB(0, 1), b2 + hstepB, voffB); PG8_STAGE_A(PG8_SA(0, 0), a2, 0, last);
            PG8_WAIT_V(8); PG8_WAIT_L(0); PG8_BAR; PG8_MMA(1, 0, At, B0); PG8_MMA(1, 1, At, B1); PG8_BAR; PG8_SCHED;
            PG8_LDB(B0, 1, 0); PG8_LDB(B1, 1, 1); PG8_SCHED; PG8_LDA(At, 1, 0); PG8_STAGE_A(PG8_SA(0, 1), a2, 1, last);
            PG8_WAIT_V(8); PG8_WAIT_L(0); PG8_BAR; PG8_MMA(0, 0, At, B0); PG8_MMA(0, 1, At, B1); PG8_BAR; PG8_SCHED;
            PG8_LDA(At, 1, 1); PG8_STAGE(PG8_SB(1, 0), b3, voffB); PG8_STAGE(PG8_SB(1, 1), b3 + hstepB, voffB); PG8_STAGE_A(PG8_SA(1, 0), a3, 0, last);
            PG8_WAIT_V(8); PG8_WAIT_L(0); PG8_BAR; PG8_MMA(1, 0, At, B0); PG8_MMA(1, 1, At, B1); PG8_BAR; PG8_SCHED;
            } else {
            PG8_LDB(B0, 0, 0); PG8_SCHED; PG8_LDA(At, 0, 0); PG8_STAGE_A(PG8_SA(1, 1), a1, 1, false);
            PG8_WAIT_L(8); PG8_BAR; PG8_WAIT_L(0); PG8_MMA(0, 0, At, B0); PG8_BAR; PG8_SCHED;
            PG8_LDB(B1, 0, 1); PG8_STAGE(PG8_SB(0, 0), b2, voffB);
            PG8_BAR; PG8_WAIT_L(0); PG8_MMA(0, 1, At, B1); PG8_BAR;
            PG8_LDA(At, 0, 1); PG8_STAGE_A(PG8_SA(0, 0), a2, 0, last);
            PG8_BAR; PG8_WAIT_L(0); PG8_MMA(1, 0, At, B0); PG8_BAR; PG8_SCHED;
            PG8_STAGE(PG8_SB(0, 1), b2 + hstepB, voffB);
            PG8_WAIT_V(6); PG8_BAR; PG8_MMA(1, 1, At, B1); PG8_BAR;
            PG8_LDB(B0, 1, 0); PG8_SCHED; PG8_LDA(At, 1, 0); PG8_STAGE_A(PG8_SA(0, 1), a2, 1, last);
            PG8_WAIT_L(8); PG8_BAR; PG8_WAIT_L(0); PG8_MMA(0, 0, At, B0); PG8_BAR; PG8_SCHED;
            PG8_LDB(B1, 1, 1); PG8_STAGE(PG8_SB(1, 0), b3, voffB);
            PG8_BAR; PG8_WAIT_L(0); PG8_MMA(0, 1, At, B1); PG8_BAR;
            PG8_LDA(At, 1, 1); PG8_STAGE_A(PG8_SA(1, 0), a3, 0, last);
            PG8_BAR; PG8_WAIT_L(0); PG8_MMA(1, 0, At, B0); PG8_BAR; PG8_SCHED;
            PG8_STAGE(PG8_SB(1, 1), b3 + hstepB, voffB);
            PG8_WAIT_V(6); PG8_BAR; PG8_MMA(1, 1, At, B1); PG8_BAR;
            }
        }
        if constexpr (ALIGN_EPI) { if (wr == 0) PG8_BAR; }
        if constexpr (!Epi::AFTER_DRAIN) { E(acc, cur, wr, wc, fr, fq); S.done(cur); }
        if (!has_next) break;
#pragma unroll
        for (int a = 0; a < 2; ++a)
#pragma unroll
            for (int b = 0; b < 2; ++b)
#pragma unroll
                for (int m = 0; m < 4; ++m)
#pragma unroll
                    for (int n = 0; n < 2; ++n) acc[a][b][m][n] = (f32x4){0.f, 0.f, 0.f, 0.f};
        cur = nxt; cA = nA; cB = nB; ++ui;
        if constexpr (ALIGN_EPI) { if (wr == 1) PG8_BAR; }
    }
    PG8_WAIT_V(0);
    if constexpr (!ALIGN_EPI) { if (wr == 0) PG8_BAR; }
    PG8_BAR;
    if constexpr (Epi::AFTER_DRAIN) { E.fused(acc, cur, wr, wc, fr, fq, lds, wid, lane); S.done(cur); }
#undef PG8_SA
#undef PG8_SB
#undef PG8_STAGE
#undef PG8_STAGE_A
#undef PG8_GIDX
#undef PG8_LDA
#undef PG8_LDB
#undef PG8_MMA
#undef PG8_WAIT_V
#undef PG8_WAIT_L
#undef PG8_BAR
#undef PG8_SCHED
}
}

#define GAS __attribute__((address_space(1)))
#define LAS __attribute__((address_space(3)))
typedef unsigned short bf16;
typedef unsigned v4u __attribute__((ext_vector_type(4)));
typedef unsigned v2u __attribute__((ext_vector_type(2)));
typedef float f32x4 __attribute__((ext_vector_type(4)));
typedef float f32x16 __attribute__((ext_vector_type(16)));
typedef short s16x8 __attribute__((ext_vector_type(8)));
typedef short s16x4 __attribute__((ext_vector_type(4)));
typedef GAS unsigned gu32;

constexpr int NWAVES = 8;
constexpr int BATCH = 2, SEQ = 8192, D = 2048, M = BATCH * SEQ;
constexpr int NQKV = 3840, NGATE = 4096, NB1 = NQKV + NGATE;
constexpr int AW = 1024, BW = 768, XW = 512, MEML = 256, NEXP = 32, DFF = 512;
constexpr int C_QA = 0, C_KA = 1024, C_VA = 1280, C_QB = 1536, C_KB = 2304, C_VB = 3072;
constexpr int MAXPANEL = 160;
constexpr float EPS = 1e-6f, LOG2E = 1.4426950408889634f, NEGBIG = -1e30f;
constexpr int TABW = 256;

constexpr size_t MiB = 1u << 20;
constexpr size_t WS_CTL = 0, CTL_ZERO_BYTES = 128 * 1024;
constexpr size_t WS_TAB = 1 * MiB, WS_ROUTE = 2 * MiB, WS_MEMN = 4 * MiB, WS_SSQ = 6 * MiB;
constexpr size_t WS_WA = 8 * MiB, WS_WB = 12 * MiB, WS_WO = 15 * MiB, WS_WXQ = 23 * MiB, WS_WXKV = 25 * MiB, WS_WXO = 29 * MiB;
constexpr size_t WS_W13 = 31 * MiB, WS_W2 = 159 * MiB, WS_X1 = 223 * MiB, WS_QKV = WS_X1, WS_U = 351 * MiB, WS_ACT = 575 * MiB, WS_END = 615 * MiB;
constexpr size_t WS_BT1 = WS_U, WS_H = WS_U + 32 * MiB, WS_GA = WS_U + 96 * MiB, WS_GB = WS_U + 160 * MiB;
constexpr size_t WS_OA = WS_U, WS_OB = WS_U + 32 * MiB, WS_XG = WS_U, WS_QX = WS_U + 64 * MiB, WS_KVX = WS_U + 80 * MiB, WS_OX = WS_U + 82 * MiB;
constexpr size_t WS_MIX8 = WS_U + 64 * MiB;
constexpr size_t WS_HM = WS_U, WS_AS = WS_U + 64 * MiB, WS_Y = WS_AS;
constexpr size_t WS_KVP = WS_U + 32 * MiB, WS_QX2 = WS_U + 40 * MiB;
constexpr size_t WS_W3 = WS_WB;
constexpr size_t WS_PART = WS_U + 64 * MiB;
constexpr size_t RT_E = 0, RT_W = 128 * 1024, RT_SLOT = 256 * 1024, RT_DEST = 384 * 1024, RT_RSTD = 512 * 1024, RT_RSORT = 576 * 1024, RT_ROWTOK = 768 * 1024;
constexpr int CW_BAR = 4096, CW_CNT = 16384;

constexpr int RING_OFF = 0, RING_BYTES = 131072, LDS_BYTES = 163840, MISC_OFF = LDS_BYTES - 2048, PEXP_OFF = MISC_OFF + 256;

#define LDS_WAIT() asm volatile("s_waitcnt lgkmcnt(0)" ::: "memory")
#define VM_WAIT() asm volatile("s_waitcnt vmcnt(0)" ::: "memory")
__device__ __forceinline__ unsigned f2bf(float f) { unsigned u = __builtin_bit_cast(unsigned, f); return (u + 0x7fffu + ((u >> 16) & 1u)) >> 16; }
__device__ __forceinline__ unsigned pk2(float lo, float hi) { return f2bf(lo) | (f2bf(hi) << 16); }
__device__ __forceinline__ float bf_lo(unsigned w) { return __builtin_bit_cast(float, w << 16); }
__device__ __forceinline__ float bf_hi(unsigned w) { return __builtin_bit_cast(float, w & 0xffff0000u); }
__device__ __forceinline__ float wave_sum(float v) {
#pragma unroll
    for (int o = 1; o < 64; o <<= 1) v += __shfl_xor(v, o);
    return v;
}
__device__ __forceinline__ float fast_exp2(float x) { return __builtin_amdgcn_exp2f(x); }
__device__ __forceinline__ float fast_rcp(float x) { return __builtin_amdgcn_rcpf(x); }

struct Args { const float* in[24]; float* out; unsigned char* ws; int ph_lo, ph_hi, rep_mask, pad; };
static_assert(sizeof(Args) == 26 * 8 + 16, "Args has no padding");
#define XB_TMO      128
#define XB_XCNT(j)  (256  + 64 * (j))
#define XB_XSUB(j)  (1280 + 64 * (j))
#define XB_XGEN(j)  (2304 + 64 * (j))
#define XB_TOP      3328
#define XB_TOPGEN   3392
#define XCD_BAR_WORDS 3456
#define XB_SPIN_CAP (1u << 18)

__device__ __forceinline__ unsigned xb_ld(unsigned* p)              { return __hip_atomic_load(p, __ATOMIC_RELAXED, __HIP_MEMORY_SCOPE_AGENT); }
__device__ __forceinline__ unsigned xb_add(unsigned* p, unsigned v) { return __hip_atomic_fetch_add(p, v, __ATOMIC_RELAXED, __HIP_MEMORY_SCOPE_AGENT); }
__device__ __forceinline__ unsigned xb_xcc_id() { return (unsigned)__builtin_amdgcn_s_getreg((3 << 11) | 20) & 0xFu; }
#define XB_SPIN(cond, bar) do { unsigned _sp = 0; while (cond) { __builtin_amdgcn_s_sleep(1); \
    if ((++_sp & 255u) == 0u) { if (xb_ld(&(bar)[XB_TMO])) break; if (_sp > XB_SPIN_CAP) { atomicAdd(&(bar)[XB_TMO], 1u); break; } } } } while (0)

struct XcdBarrier {
    unsigned* bar; unsigned x;
    volatile LAS unsigned* st;
};

__device__ __forceinline__ XcdBarrier xcd_barrier_post(unsigned* bar, volatile LAS unsigned* st) {
    XcdBarrier b; b.bar = bar; b.x = xb_xcc_id(); b.st = st;
    if (threadIdx.x == 0) (void)xb_add(&bar[XB_XCNT(b.x)], 1u);
    return b;
}
__device__ __forceinline__ void xcd_barrier_complete(unsigned* bar, unsigned x, unsigned& nloc, unsigned& nx) {
    const unsigned G = gridDim.x * gridDim.y * gridDim.z;
    unsigned sum, cnt, mine, sp = 0u;
    for (;;) {
        sum = 0u; cnt = 0u; mine = 0u;
#pragma unroll
        for (unsigned j = 0; j < 16; ++j) { const unsigned c = xb_ld(&bar[XB_XCNT(j)]); sum += c; cnt += (c > 0u) ? 1u : 0u; mine = (j == x) ? c : mine; }
        if (sum == G) break;
        __builtin_amdgcn_s_sleep(1);
        if ((++sp & 255u) == 0u) { if (xb_ld(&bar[XB_TMO])) break; if (sp > XB_SPIN_CAP) { atomicAdd(&bar[XB_TMO], 1u); break; } }
    }
    nloc = mine > 0u ? mine : 1u; nx = cnt > 0u ? cnt : 1u;
}

__device__ __forceinline__ void xcd_barrier(const XcdBarrier& b) {
    asm volatile("s_waitcnt vmcnt(0)" ::: "memory");
    __syncthreads();
    if (threadIdx.x == 0) {
        unsigned* bar = b.bar;
        __builtin_amdgcn_s_waitcnt(0);
        unsigned nloc = b.st[0], nx = b.st[1];
        if (nloc == 0u) { xcd_barrier_complete(bar, b.x, nloc, nx); b.st[0] = nloc; b.st[1] = nx; }
        const unsigned old = xb_add(&bar[XB_XSUB(b.x)], 1u);
        const unsigned gen = old / nloc;
        if (old + 1u == (gen + 1u) * nloc) {
            __builtin_amdgcn_fence(__ATOMIC_RELEASE, "agent");
            asm volatile("s_waitcnt vmcnt(0)" ::: "memory");
            const unsigned og = xb_add(&bar[XB_TOP], 1u);
            const unsigned tg = og / nx;
            if (og + 1u == (tg + 1u) * nx) xb_add(&bar[XB_TOPGEN], 1u);
            else XB_SPIN(xb_ld(&bar[XB_TOPGEN]) == tg, bar);
            __builtin_amdgcn_fence(__ATOMIC_ACQUIRE, "agent");
            xb_add(&bar[XB_XGEN(b.x)], 1u);
            asm volatile("s_waitcnt vmcnt(0)" ::: "memory");
        } else {
            XB_SPIN(xb_ld(&bar[XB_XGEN(b.x)]) == gen, bar);
            __builtin_amdgcn_fence(__ATOMIC_ACQUIRE, "agent");
            asm volatile("s_waitcnt vmcnt(0)" ::: "memory");
        }
    }
    __syncthreads();
}

#define EPI_ARGS const pg8::f32x4 (&acc)[2][2][4][2], const pg8::Unit& u, int wr, int wc, int fr, int fq
#define EPI_FOR_AI_M _Pragma("unroll") for (int ai = 0; ai < 2; ++ai) _Pragma("unroll") for (int m = 0; m < 4; ++m)
__device__ __forceinline__ v4u pack8(const f32x4 a, const f32x4 b) { v4u w; w.x = pg8::cvt_pk_bf16(a[0], a[1]); w.y = pg8::cvt_pk_bf16(a[2], a[3]); w.z = pg8::cvt_pk_bf16(b[0], b[1]); w.w = pg8::cvt_pk_bf16(b[2], b[3]); return w; }
__device__ __forceinline__ float sigmoidf_fast(float v) { return fast_rcp(1.0f + fast_exp2(-v * LOG2E)); }

__device__ __forceinline__ unsigned cvt4_fp8(float a, float b, float c, float d) { int p = __builtin_amdgcn_cvt_pk_fp8_f32(a, b, 0, false); p = __builtin_amdgcn_cvt_pk_fp8_f32(c, d, p, true); return (unsigned)p; }

constexpr float W2_SCALE = 16.0f, ACT_SCALE = 4.0f, W13_SCALE = 32.0f, W1_SCALE = 32.0f, WO_SCALE = 32.0f, MIX_SCALE = 16.0f, WXQ_SCALE = 32.0f;
struct EpiQKVG {
    static constexpr bool PERM = true, AFTER_DRAIN = false, HAS_MID = false; static constexpr int MID_T = 0;
    bf16* qkv; bf16* ga; bf16* gb; const float* bgate;
    __device__ __forceinline__ void operator()(EPI_ARGS) const {
        const int row0 = u.pm * 256 + wr * 64 + fr, ct = wc * 32 + 8 * fq;
        if (u.pn < 15) {
            const float sc = ((u.pn < 4 || (u.pn >= 6 && u.pn < 9)) ? 0.125f * LOG2E : 1.0f) * (1.0f / W1_SCALE);
            EPI_FOR_AI_M { bf16* rowp = qkv + (size_t)(row0 + ai * 128 + m * 16) * NQKV + u.pn * 256 + ct;
#pragma unroll
                for (int bj = 0; bj < 2; ++bj) *(v4u*)(rowp + bj * 128) = pack8(acc[ai][bj][m][0] * sc, acc[ai][bj][m][1] * sc); }
        } else {
            const int gt = u.pn - 15; bf16* base = (gt < 8) ? ga : gb; const int gc = (gt & 7) * 256 + ct, bc = gt * 256 + ct;
            _Pragma("unroll") for (int bj = 0; bj < 2; ++bj) { const f32x4 b0 = *(const f32x4*)(bgate + bc + bj * 128), b1 = *(const f32x4*)(bgate + bc + bj * 128 + 4);
                EPI_FOR_AI_M { bf16* rowp = base + (size_t)(row0 + ai * 128 + m * 16) * D + gc;
                    f32x4 v0 = acc[ai][bj][m][0] * (1.0f / W1_SCALE) + b0, v1 = acc[ai][bj][m][1] * (1.0f / W1_SCALE) + b1;
#pragma unroll
                    for (int j = 0; j < 4; ++j) { v0[j] = sigmoidf_fast(v0[j]); v1[j] = sigmoidf_fast(v1[j]); }
                    *(v4u*)(rowp + bj * 128) = pack8(v0, v1); } }
        }
    }
};

constexpr float OAB_SCALE = 16.0f, WAB_SCALE = 32.0f;
#define EPI_ROWSTEP(off, aim) do { off += (size_t)16 * D; if (((aim) & 3) == 3) off += (size_t)64 * D; } while (0)
#ifndef EPI_MIX_MID_AHEAD
#define EPI_MIX_MID_AHEAD 1
#endif
#ifndef EPI_MIX_AHEAD
#define EPI_MIX_AHEAD 1
#endif
struct EpiMix {
    static constexpr bool PERM = true, AFTER_DRAIN = false, HAS_MID = true; static constexpr int MID_T = 8;
    static constexpr int NM = EPI_MIX_MID_AHEAD, NA = EPI_MIX_AHEAD;
    const bf16* ga; const bf16* gb; unsigned char* mix8;
    __device__ __forceinline__ void mid(pg8::f32x4 (&acc)[2][2][4][2], const pg8::Unit& u, int wr, int wc, int fr, int fq) const {
        size_t offl = (size_t)(u.pm * 256 + wr * 64 + fr) * D + u.pn * 256 + wc * 32 + 8 * fq;
        asm volatile("" : "+v"(offl));
        v4u na[NM][2], nb[NM][2];
#pragma unroll
        for (int a = 0; a < NM; ++a) { if (a) EPI_ROWSTEP(offl, a - 1); na[a][0] = *(const v4u*)(ga + offl); na[a][1] = *(const v4u*)(ga + offl + 128); nb[a][0] = *(const v4u*)(gb + offl); nb[a][1] = *(const v4u*)(gb + offl + 128); }
#pragma unroll
        for (int aim = 0; aim < 8; ++aim) { const int ai = aim >> 2, m = aim & 3;
            const v4u ca[2] = {na[0][0], na[0][1]}, cb[2] = {nb[0][0], nb[0][1]};
#pragma unroll
            for (int a = 0; a + 1 < NM; ++a) { na[a][0] = na[a + 1][0]; na[a][1] = na[a + 1][1]; nb[a][0] = nb[a + 1][0]; nb[a][1] = nb[a + 1][1]; }
            if (aim + NM < 8) { EPI_ROWSTEP(offl, aim + NM - 1); na[NM - 1][0] = *(const v4u*)(ga + offl); na[NM - 1][1] = *(const v4u*)(ga + offl + 128); nb[NM - 1][0] = *(const v4u*)(gb + offl); nb[NM - 1][1] = *(const v4u*)(gb + offl + 128); }
            asm volatile("" : "+v"(offl) :: "memory");
#pragma unroll
            for (int bj = 0; bj < 2; ++bj) { const v4u a = ca[bj], b = cb[bj];
                const f32x4 r0 = {bf_lo(a.x) * fast_rcp(bf_lo(b.x)), bf_hi(a.x) * fast_rcp(bf_hi(b.x)), bf_lo(a.y) * fast_rcp(bf_lo(b.y)), bf_hi(a.y) * fast_rcp(bf_hi(b.y))};
                const f32x4 r1 = {bf_lo(a.z) * fast_rcp(bf_lo(b.z)), bf_hi(a.z) * fast_rcp(bf_hi(b.z)), bf_lo(a.w) * fast_rcp(bf_lo(b.w)), bf_hi(a.w) * fast_rcp(bf_hi(b.w))};
                acc[ai][bj][m][0] = acc[ai][bj][m][0] * r0; acc[ai][bj][m][1] = acc[ai][bj][m][1] * r1; } }
    }
    __device__ __forceinline__ void operator()(EPI_ARGS) const {
        size_t off = (size_t)(u.pm * 256 + wr * 64 + fr) * D + u.pn * 256 + wc * 32 + 8 * fq, offl = off;
        asm volatile("" : "+v"(off)); asm volatile("" : "+v"(offl));
        constexpr float sc = MIX_SCALE / (OAB_SCALE * WAB_SCALE);
        v4u nb[NA][2];
#pragma unroll
        for (int a = 0; a < NA; ++a) { if (a) EPI_ROWSTEP(offl, a - 1); nb[a][0] = *(const v4u*)(gb + offl); nb[a][1] = *(const v4u*)(gb + offl + 128); }
#pragma unroll
        for (int aim = 0; aim < 8; ++aim) { const int ai = aim >> 2, m = aim & 3;
            const v4u cb[2] = {nb[0][0], nb[0][1]}; const size_t offc = off;
#pragma unroll
            for (int a = 0; a + 1 < NA; ++a) { nb[a][0] = nb[a + 1][0]; nb[a][1] = nb[a + 1][1]; }
            EPI_ROWSTEP(off, aim);
            if (aim + NA < 8) { EPI_ROWSTEP(offl, aim + NA - 1); nb[NA - 1][0] = *(const v4u*)(gb + offl); nb[NA - 1][1] = *(const v4u*)(gb + offl + 128); }
            asm volatile("" : "+v"(off), "+v"(offl) :: "memory");
#pragma unroll
            for (int bj = 0; bj < 2; ++bj) { const v4u b = cb[bj]; const f32x4 a0 = acc[ai][bj][m][0] * sc, a1 = acc[ai][bj][m][1] * sc;
                v2u w8; w8.x = cvt4_fp8(a0[0] * bf_lo(b.x), a0[1] * bf_hi(b.x), a0[2] * bf_lo(b.y), a0[3] * bf_hi(b.y)); w8.y = cvt4_fp8(a1[0] * bf_lo(b.z), a1[1] * bf_hi(b.z), a1[2] * bf_lo(b.w), a1[3] * bf_hi(b.w));
                *(v2u*)(mix8 + offc + bj * 128) = w8; } }
    }
};

#ifndef EPI_RESID_AHEAD
#define EPI_RESID_AHEAD 3
#endif
struct EpiResid {
    static constexpr bool PERM = true, AFTER_DRAIN = false, HAS_MID = false; static constexpr int MID_T = 0;
    static constexpr int NA = EPI_RESID_AHEAD;
    const float* x; bf16* x1; float* ssq;
    __device__ __forceinline__ void operator()(EPI_ARGS) const {
        const int ct = u.pn * 256 + wc * 32 + 8 * fq; int row = u.pm * 256 + wr * 64 + fr;
        size_t off = (size_t)row * D + ct, offl = off;
        asm volatile("" : "+v"(off)); asm volatile("" : "+v"(offl));
#define EPI_LDX(dst) do { dst[0] = *(const f32x4*)(x + offl); dst[1] = *(const f32x4*)(x + offl + 4); dst[2] = *(const f32x4*)(x + offl + 128); dst[3] = *(const f32x4*)(x + offl + 132); } while (0)
        f32x4 nx[NA][4];
#pragma unroll
        for (int a = 0; a < NA; ++a) { if (a) EPI_ROWSTEP(offl, a - 1); EPI_LDX(nx[a]); }
#pragma unroll
        for (int aim = 0; aim < 8; ++aim) { const int ai = aim >> 2, m = aim & 3;
            const f32x4 cx[4] = {nx[0][0], nx[0][1], nx[0][2], nx[0][3]}; const size_t offc = off; const int rowc = row;
#pragma unroll
            for (int a = 0; a + 1 < NA; ++a)
#pragma unroll
                for (int q = 0; q < 4; ++q) nx[a][q] = nx[a + 1][q];
            EPI_ROWSTEP(off, aim); row += 16; if (m == 3) row += 64;
            if (aim + NA < 8) { EPI_ROWSTEP(offl, aim + NA - 1); EPI_LDX(nx[NA - 1]); }
            asm volatile("" : "+v"(off), "+v"(offl) :: "memory");
            float s = 0.f;
#pragma unroll
            for (int bj = 0; bj < 2; ++bj) {
                const f32x4 v0 = cx[2 * bj] + acc[ai][bj][m][0] * (1.0f / (MIX_SCALE * WO_SCALE)), v1 = cx[2 * bj + 1] + acc[ai][bj][m][1] * (1.0f / (MIX_SCALE * WO_SCALE));
                *(v4u*)(x1 + offc + bj * 128) = pack8(v0, v1);
                s += ((v0[0] * v0[0] + v0[1] * v0[1]) + (v0[2] * v0[2] + v0[3] * v0[3])) + ((v1[0] * v1[0] + v1[1] * v1[1]) + (v1[2] * v1[2] + v1[3] * v1[3]));
            }
            s += __shfl_xor(s, 16); s += __shfl_xor(s, 32);
            if (fq == 0) ssq[(size_t)rowc * 32 + u.pn * 4 + wc] = s; }
#undef EPI_LDX
    }
};

struct EpiQx {
    static constexpr bool PERM = true, AFTER_DRAIN = false, HAS_MID = false; static constexpr int MID_T = 0;
    bf16* qx; const float* ssq; float scale;
    __device__ __forceinline__ void operator()(EPI_ARGS) const {
        int row = u.pm * 256 + wr * 64 + fr; const int ct = u.pn * 256 + wc * 32 + 8 * fq;
        asm volatile("" : "+v"(row));
#pragma unroll
        for (int ai = 0; ai < 2; ++ai) {
#pragma unroll
            for (int m = 0; m < 4; ++m) {
                const f32x4 p0 = *(const f32x4*)(ssq + (size_t)row * 32 + fq * 8), p1 = *(const f32x4*)(ssq + (size_t)row * 32 + fq * 8 + 4);
                float s = ((p0[0] + p0[1]) + (p0[2] + p0[3])) + ((p1[0] + p1[1]) + (p1[2] + p1[3]));
                s += __shfl_xor(s, 16); s += __shfl_xor(s, 32);
                const float rs = scale / sqrtf(s * (1.0f / D) + EPS);
                bf16* rowp = qx + (size_t)row * XW + ct;
#pragma unroll
                for (int bj = 0; bj < 2; ++bj) *(v4u*)(rowp + bj * 128) = pack8(acc[ai][bj][m][0] * rs, acc[ai][bj][m][1] * rs);
                row += 16; asm volatile("" : "+v"(row) :: "memory"); }
            row += 64; }
    }
};

struct EpiBf {
    static constexpr bool PERM = true, AFTER_DRAIN = false, HAS_MID = false; static constexpr int MID_T = 0;
    bf16* out; int ldc; int tmod; float sc;
    __device__ __forceinline__ void operator()(EPI_ARGS) const {
        const int row0 = u.pm * 256 + wr * 64 + fr, ct = (u.pn % tmod) * 256 + wc * 32 + 8 * fq;
        EPI_FOR_AI_M { bf16* rowp = out + (size_t)(row0 + ai * 128 + m * 16) * ldc + ct;
#pragma unroll
            for (int bj = 0; bj < 2; ++bj) *(v4u*)(rowp + bj * 128) = pack8(acc[ai][bj][m][0] * sc, acc[ai][bj][m][1] * sc); }
    }
};

struct EpiF8 {
    static constexpr bool PERM = true, AFTER_DRAIN = false, HAS_MID = false; static constexpr int MID_T = 0;
    unsigned char* out; int ldc; int tmod; float sc;
    __device__ __forceinline__ void operator()(EPI_ARGS) const {
        const int row0 = u.pm * 256 + wr * 64 + fr, ct = (u.pn % tmod) * 256 + wc * 32 + 8 * fq;
        EPI_FOR_AI_M { unsigned char* rowp = out + (size_t)(row0 + ai * 128 + m * 16) * ldc + ct;
#pragma unroll
            for (int bj = 0; bj < 2; ++bj) { const f32x4 a0 = acc[ai][bj][m][0] * sc, a1 = acc[ai][bj][m][1] * sc; v2u w8; w8.x = cvt4_fp8(a0[0], a0[1], a0[2], a0[3]); w8.y = cvt4_fp8(a1[0], a1[1], a1[2], a1[3]);
                *(v2u*)(rowp + bj * 128) = w8; } }
    }
};

#ifndef EPI_RESID2_AHEAD
#define EPI_RESID2_AHEAD 1
#endif
struct EpiResid2 {
    static constexpr bool PERM = true, AFTER_DRAIN = false, HAS_MID = false; static constexpr int MID_T = 0;
    bf16* x1; unsigned char* hm; const float* gm; float* ssq;
    __device__ __forceinline__ void operator()(EPI_ARGS) const {
        const int ct = u.pn * 256 + wc * 32 + 8 * fq; int row = u.pm * 256 + wr * 64 + fr;
        size_t off = (size_t)row * D + ct;
        asm volatile("" : "+v"(off));
        const f32x4 gv[2][2] = {{*(const f32x4*)(gm + ct), *(const f32x4*)(gm + ct + 4)}, {*(const f32x4*)(gm + ct + 128), *(const f32x4*)(gm + ct + 132)}};
        v4u nt[2];
        nt[0] = *(const v4u*)(x1 + off); nt[1] = *(const v4u*)(x1 + off + 128);
#pragma unroll
        for (int aim = 0; aim < 8; ++aim) { const int ai = aim >> 2, m = aim & 3;
            const v4u ctv[2] = {nt[0], nt[1]}; const size_t offc = off; const int rowc = row;
            EPI_ROWSTEP(off, aim); row += 16; if (m == 3) row += 64;
            if (aim < 7) { nt[0] = *(const v4u*)(x1 + off); nt[1] = *(const v4u*)(x1 + off + 128); }
            asm volatile("" : "+v"(off) :: "memory");
            float s = 0.f;
#pragma unroll
            for (int bj = 0; bj < 2; ++bj) { const v4u t = ctv[bj]; const f32x4 a0 = acc[ai][bj][m][0], a1 = acc[ai][bj][m][1];
                const f32x4 o0 = {bf_lo(t.x) + a0[0], bf_hi(t.x) + a0[1], bf_lo(t.y) + a0[2], bf_hi(t.y) + a0[3]}, o1 = {bf_lo(t.z) + a1[0], bf_hi(t.z) + a1[1], bf_lo(t.w) + a1[2], bf_hi(t.w) + a1[3]};
                *(v4u*)(x1 + offc + bj * 128) = pack8(o0, o1);
                const f32x4 h0 = o0 * gv[bj][0], h1 = o1 * gv[bj][1];
                v2u w8; w8.x = cvt4_fp8(h0[0], h0[1], h0[2], h0[3]); w8.y = cvt4_fp8(h1[0], h1[1], h1[2], h1[3]);
                *(v2u*)(hm + offc + bj * 128) = w8;
                s += ((o0[0] * o0[0] + o0[1] * o0[1]) + (o0[2] * o0[2] + o0[3] * o0[3])) + ((o1[0] * o1[0] + o1[1] * o1[1]) + (o1[2] * o1[2] + o1[3] * o1[3])); }
            s += __shfl_xor(s, 16); s += __shfl_xor(s, 32);
            if (fq == 0) ssq[(size_t)rowc * 32 + u.pn * 4 + wc] = s; }
    }
};
struct EpiLogit {
    static constexpr bool PERM = true, AFTER_DRAIN = false, HAS_MID = false; static constexpr int MID_T = 0;
    float* part;
    __device__ __forceinline__ void operator()(EPI_ARGS) const {
        const int c0 = wc * 8 + 2 * fq;
        EPI_FOR_AI_M { const int row = u.pm * 256 + wr * 64 + fr + ai * 128 + m * 16;
            { const f32x4 a = acc[ai][0][m][0], b = acc[ai][0][m][1]; v2u st; st.x = __builtin_bit_cast(unsigned, (a[0] + a[1]) + (a[2] + a[3])); st.y = __builtin_bit_cast(unsigned, (b[0] + b[1]) + (b[2] + b[3]));
              *(v2u*)(part + (size_t)row * 36 + c0) = st; }
            if (wc == 0 && fq < 2) { const f32x4 a = acc[ai][1][m][0], b = acc[ai][1][m][1]; v2u st; st.x = __builtin_bit_cast(unsigned, (a[0] + a[1]) + (a[2] + a[3])); st.y = __builtin_bit_cast(unsigned, (b[0] + b[1]) + (b[2] + b[3]));
              *(v2u*)(part + (size_t)row * 36 + 32 + c0) = st; } }
    }
};

struct EpiF32 {
    static constexpr bool PERM = true, AFTER_DRAIN = false, HAS_MID = false; static constexpr int MID_T = 0;
    float* c; int ldc;
    __device__ __forceinline__ void operator()(EPI_ARGS) const {
        const int ct = u.pn * 256 + wc * 32 + 8 * fq;
        EPI_FOR_AI_M { float* rp = c + (size_t)(u.pm * 256 + wr * 64 + fr + ai * 128 + m * 16) * ldc + ct;
#pragma unroll
            for (int bj = 0; bj < 2; ++bj) { *(f32x4*)(rp + bj * 128) = acc[ai][bj][m][0]; *(f32x4*)(rp + bj * 128 + 4) = acc[ai][bj][m][1]; } }
    }
};
struct EpiSwiGLU {
    static constexpr bool PERM = true, AFTER_DRAIN = false, HAS_MID = false; static constexpr int MID_T = 0;
    unsigned char* act; const float* rsort;
    __device__ __forceinline__ void operator()(EPI_ARGS) const {
        const int row0 = u.pm * 256 + wr * 64 + fr, ct = (u.pn & 3) * 128 + wc * 16 + 4 * fq;
        EPI_FOR_AI_M { const int row = row0 + ai * 128 + m * 16; const float rs = rsort[row] * (1.0f / W13_SCALE); unsigned char* rowp = act + (size_t)row * DFF + ct;
#pragma unroll
            for (int bj = 0; bj < 2; ++bj) { const f32x4 a = acc[ai][bj][m][0] * rs, b = acc[ai][bj][m][1] * rs;
                const float o0 = a[0] * sigmoidf_fast(a[0]) * a[1], o1 = a[2] * sigmoidf_fast(a[2]) * a[3], o2 = b[0] * sigmoidf_fast(b[0]) * b[1], o3 = b[2] * sigmoidf_fast(b[2]) * b[3];
                *(unsigned*)(rowp + bj * 64) = cvt4_fp8(o0 * ACT_SCALE, o1 * ACT_SCALE, o2 * ACT_SCALE, o3 * ACT_SCALE); } }
    }
};

constexpr int ATT_TAB_OFF = 0;
constexpr int ATT_V_OFF = 8192;
constexpr int ATT_V_WAVE64 = 6144, ATT_V_WAVE128 = 10240;
constexpr int ATT_K_WAVE64 = 32 * 144, ATT_K_WAVE128 = 32 * 272;
constexpr int ATT_K_OFF64 = ATT_V_OFF + 8 * ATT_V_WAVE64, ATT_K_OFF128 = ATT_V_OFF + 8 * ATT_V_WAVE128;
constexpr int ATT_OB_OFF = ATT_K_OFF64 + 8 * ATT_K_WAVE64;
constexpr int ATT_LSE_OFF = ATT_OB_OFF + 65536;
static_assert(ATT_LSE_OFF + 2048 <= 161792 && ATT_K_OFF128 + 8 * ATT_K_WAVE128 <= 161792, "attention LDS map below the control words");

template <int DH> struct AttnGeom { static constexpr int KSTRIDE = 2 * DH + 16, VSTRIDE = (DH == 64) ? 192 : 320, CPR = DH / 8, RPI = 64 / CPR, NVI = 32 / RPI, NST = DH / 16, NDT = DH / 32; };


template <int VSTRIDE, int DT>
__device__ __forceinline__ void pv_step(unsigned tr_base, const s16x8 (&pf)[2], f32x16& Od) {
    s16x4 a0, a1, b0, b1;
    asm volatile("ds_read_b64_tr_b16 %0, %4 offset:%5\n\tds_read_b64_tr_b16 %1, %4 offset:%6\n\tds_read_b64_tr_b16 %2, %4 offset:%7\n\tds_read_b64_tr_b16 %3, %4 offset:%8\n\ts_waitcnt lgkmcnt(0)"
                 : "=&v"(a0), "=&v"(a1), "=&v"(b0), "=&v"(b1)
                 : "v"(tr_base), "i"(64 * DT), "i"(64 * DT + 8 * VSTRIDE), "i"(64 * DT + 16 * VSTRIDE), "i"(64 * DT + 24 * VSTRIDE) : "memory");
    const s16x8 vf0 = __builtin_shufflevector(a0, a1, 0, 1, 2, 3, 4, 5, 6, 7), vf1 = __builtin_shufflevector(b0, b1, 0, 1, 2, 3, 4, 5, 6, 7);
    Od = __builtin_amdgcn_mfma_f32_32x32x16_bf16(vf0, pf[0], Od, 0, 0, 0);
    Od = __builtin_amdgcn_mfma_f32_32x32x16_bf16(vf1, pf[1], Od, 0, 0, 0);
}

template <int VSTRIDE, int DT>
__device__ __forceinline__ void pv_step2(unsigned tr_base, const s16x8 (&pf)[2], f32x16& Od0, f32x16& Od1) {
    s16x4 a0, a1, b0, b1, c0, c1, d0, d1;
    asm volatile("ds_read_b64_tr_b16 %0, %8 offset:%9\n\tds_read_b64_tr_b16 %1, %8 offset:%10\n\tds_read_b64_tr_b16 %2, %8 offset:%11\n\tds_read_b64_tr_b16 %3, %8 offset:%12\n\t"
                 "ds_read_b64_tr_b16 %4, %8 offset:%13\n\tds_read_b64_tr_b16 %5, %8 offset:%14\n\tds_read_b64_tr_b16 %6, %8 offset:%15\n\tds_read_b64_tr_b16 %7, %8 offset:%16\n\ts_waitcnt lgkmcnt(0)"
                 : "=&v"(a0), "=&v"(a1), "=&v"(b0), "=&v"(b1), "=&v"(c0), "=&v"(c1), "=&v"(d0), "=&v"(d1)
                 : "v"(tr_base), "i"(64 * DT), "i"(64 * DT + 8 * VSTRIDE), "i"(64 * DT + 16 * VSTRIDE), "i"(64 * DT + 24 * VSTRIDE),
                   "i"(64 * DT + 64), "i"(64 * DT + 64 + 8 * VSTRIDE), "i"(64 * DT + 64 + 16 * VSTRIDE), "i"(64 * DT + 64 + 24 * VSTRIDE) : "memory");
    const s16x8 v00 = __builtin_shufflevector(a0, a1, 0, 1, 2, 3, 4, 5, 6, 7), v01 = __builtin_shufflevector(b0, b1, 0, 1, 2, 3, 4, 5, 6, 7);
    const s16x8 v10 = __builtin_shufflevector(c0, c1, 0, 1, 2, 3, 4, 5, 6, 7), v11 = __builtin_shufflevector(d0, d1, 0, 1, 2, 3, 4, 5, 6, 7);
    Od0 = __builtin_amdgcn_mfma_f32_32x32x16_bf16(v00, pf[0], Od0, 0, 0, 0);
    Od1 = __builtin_amdgcn_mfma_f32_32x32x16_bf16(v10, pf[0], Od1, 0, 0, 0);
    Od0 = __builtin_amdgcn_mfma_f32_32x32x16_bf16(v01, pf[1], Od0, 0, 0, 0);
    Od1 = __builtin_amdgcn_mfma_f32_32x32x16_bf16(v11, pf[1], Od1, 0, 0, 0);
}

struct AttnJob {
    const bf16* q; int ldq; long qrow0; int qstride; int qmask;
    const bf16* q2;
    const bf16* k; const bf16* v; int ldkv; long krow0; int kstride;
    int i0;
    int u_begin, ntiles;
    float m_init, l_init;
};

template <int DH> struct KVTile { v4u k[AttnGeom<DH>::NVI]; v4u v[AttnGeom<DH>::NVI]; };
template <int DH> struct KVPtr { const bf16* k[AttnGeom<DH>::NVI]; const bf16* v[AttnGeom<DH>::NVI]; long step; };
template <int DH> __device__ __forceinline__ void attn_ptr_init(const AttnJob& J, int lane, KVPtr<DH>& P) {
    typedef AttnGeom<DH> G;
    const int q = lane & 31, h = lane >> 5, vr = lane / G::CPR, vc = lane % G::CPR;
#pragma unroll
    for (int i = 0; i < G::NVI; ++i) P.k[i] = J.k + (size_t)(J.krow0 + (long)(J.u_begin + vr + G::RPI * i) * J.kstride) * J.ldkv + 8 * vc;
#pragma unroll
    for (int i = 0; i < G::NVI; ++i) P.v[i] = J.v + (size_t)(J.krow0 + (long)(J.u_begin + vr + G::RPI * i) * J.kstride) * J.ldkv + 8 * vc;
    P.step = (long)32 * J.kstride * J.ldkv;
}
template <int DH> __device__ __forceinline__ void attn_load_k(KVPtr<DH>& P, KVTile<DH>& T) {
    typedef AttnGeom<DH> G;
#pragma unroll
    for (int i = 0; i < G::NVI; ++i) T.k[i] = *(const v4u*)(P.k[i]);
#pragma unroll
    for (int i = 0; i < G::NVI; ++i) P.k[i] += P.step;
}
template <int DH> __device__ __forceinline__ void attn_load_v(KVPtr<DH>& P, KVTile<DH>& T) {
    typedef AttnGeom<DH> G;
#pragma unroll
    for (int i = 0; i < G::NVI; ++i) T.v[i] = *(const v4u*)(P.v[i]);
#pragma unroll
    for (int i = 0; i < G::NVI; ++i) P.v[i] += P.step;
}
template <int DH> __device__ __forceinline__ void attn_load_tile(KVPtr<DH>& P, KVTile<DH>& T) { attn_load_k<DH>(P, T); attn_load_v<DH>(P, T); }
constexpr float ATT_THR = 6.0f;

template <int DH, bool TAB>
__device__ __forceinline__ void attn_qk(const AttnJob& J, int u0, const KVTile<DH>& T, const s16x8 (&qf)[DH / 16], const LAS float* tab, LAS unsigned char* kst, int lane, float mrun, f32x16& S) {
    typedef AttnGeom<DH> G;
    const int q = lane & 31, h = lane >> 5, vr = lane / G::CPR, vc = lane % G::CPR;
#pragma unroll
    for (int i = 0; i < G::NVI; ++i) *(LAS v4u*)(kst + (vr + G::RPI * i) * G::KSTRIDE + 16 * vc) = T.k[i];
    const int dbase = (J.i0 - u0) + q - 4 * h + 32;
#pragma unroll
    for (int i = 0; i < 16; ++i) { const int cr = (i & 3) + 8 * (i >> 2); S[i] = (TAB ? tab[dbase - cr] : 0.f) - mrun; }
    s16x8 kf[G::NST];
#pragma unroll
    for (int st = 0; st < G::NST; ++st) kf[st] = *(const LAS s16x8*)(kst + q * G::KSTRIDE + 32 * st + 16 * h);
#pragma unroll
    for (int st = 0; st < G::NST; ++st) S = __builtin_amdgcn_mfma_f32_32x32x16_bf16(kf[st], qf[st], S, 0, 0, 0);
}
template <int DH>
__device__ __forceinline__ void attn_softmax_pv(const KVTile<DH>& T, f32x16& S, f32x16& Sn, bool has_next, LAS unsigned char* vst, unsigned tr_base, int lane,
                                                f32x16 (&O)[DH / 32], float& mrun, float& lrun) {
    typedef AttnGeom<DH> G;
    const int vr = lane / G::CPR, vc = lane % G::CPR;
#pragma unroll
    for (int i = 0; i < G::NVI; ++i) *(LAS v4u*)(vst + (vr + G::RPI * i) * G::VSTRIDE + 16 * vc) = T.v[i];
    float mx = S[0];
#pragma unroll
    for (int i = 1; i < 16; ++i) mx = fmaxf(mx, S[i]);
    if (!__all(mx <= ATT_THR)) {
        mx = fmaxf(mx, __shfl_xor(mx, 32));
        const float d = fmaxf(mx, 0.f), alpha = fast_exp2(-d);
        mrun += d; lrun *= alpha;
#pragma unroll
        for (int dt = 0; dt < G::NDT; ++dt)
#pragma unroll
            for (int i = 0; i < 16; ++i) O[dt][i] *= alpha;
#pragma unroll
        for (int i = 0; i < 16; ++i) S[i] -= d;
        if (has_next) {
#pragma unroll
            for (int i = 0; i < 16; ++i) Sn[i] -= d; }
    }
    float ps = 0.f;
#pragma unroll
    for (int i = 0; i < 16; ++i) { S[i] = fast_exp2(S[i]); ps += S[i]; }
    lrun += ps;
    s16x8 pf[2];
#pragma unroll
    for (int s = 0; s < 2; ++s) { unsigned w0 = pg8::cvt_pk_bf16(S[8 * s + 0], S[8 * s + 1]), w1 = pg8::cvt_pk_bf16(S[8 * s + 2], S[8 * s + 3]), w2 = pg8::cvt_pk_bf16(S[8 * s + 4], S[8 * s + 5]), w3 = pg8::cvt_pk_bf16(S[8 * s + 6], S[8 * s + 7]);
        v4u w = {w0, w1, w2, w3}; pf[s] = __builtin_bit_cast(s16x8, w); }
    LDS_WAIT();
    pv_step2<G::VSTRIDE, 0>(tr_base, pf, O[0], O[1]);
    if constexpr (G::NDT == 4) pv_step2<G::VSTRIDE, 2>(tr_base, pf, O[2], O[3]);
}

__device__ __forceinline__ void attn_fill_tab(LAS float* tab, const float* gtab, int maxoff, int lane) {
#pragma unroll
    for (int j = 0; j < 4; ++j) { const int idx = lane + 64 * j, d = idx - 32; tab[idx] = (d >= 0 && d <= maxoff) ? gtab[d] : NEGBIG; }
    LDS_WAIT();
}
template <int DH, bool TAB, bool PIPE, bool QSUM = false>
__device__ __forceinline__ void attn_job(const AttnJob& J, LAS float* tab, const float* gtab, int maxoff, LAS unsigned char* vst, LAS unsigned char* kst, int lane, f32x16 (&O)[DH / 32], float& m_out, float& l_out) {
    typedef AttnGeom<DH> G;
    const int q = lane & 31, h = lane >> 5;
    s16x8 qf[G::NST];
    { const bf16* qp = J.q + (size_t)(J.qrow0 + (long)(q & J.qmask) * J.qstride) * J.ldq + 8 * h;
#pragma unroll
      for (int st = 0; st < G::NST; ++st) qf[st] = *(const s16x8*)(qp + 16 * st);
      if constexpr (QSUM) { const bf16* qp2 = J.q2 + (size_t)(J.qrow0 + (long)(q & J.qmask) * J.qstride) * J.ldq + 8 * h;
#pragma unroll
          for (int st = 0; st < G::NST; ++st) { const v4u a = __builtin_bit_cast(v4u, qf[st]), b = *(const v4u*)(qp2 + 16 * st); v4u r;
              r.x = pg8::cvt_pk_bf16(bf_lo(a.x) + bf_lo(b.x), bf_hi(a.x) + bf_hi(b.x)); r.y = pg8::cvt_pk_bf16(bf_lo(a.y) + bf_lo(b.y), bf_hi(a.y) + bf_hi(b.y));
              r.z = pg8::cvt_pk_bf16(bf_lo(a.z) + bf_lo(b.z), bf_hi(a.z) + bf_hi(b.z)); r.w = pg8::cvt_pk_bf16(bf_lo(a.w) + bf_lo(b.w), bf_hi(a.w) + bf_hi(b.w));
              qf[st] = __builtin_bit_cast(s16x8, r); } } }
#pragma unroll
    for (int dt = 0; dt < G::NDT; ++dt)
#pragma unroll
        for (int i = 0; i < 16; ++i) O[dt][i] = 0.f;
    float mrun = J.m_init, lrun = (lane < 32) ? J.l_init : 0.f;
    const unsigned tr_base = (unsigned)(size_t)vst + (unsigned)((4 * h + ((lane & 15) >> 2)) * G::VSTRIDE + (16 * ((lane >> 4) & 1) + 4 * (lane & 3)) * 2);
    const int nt = J.ntiles, ub = J.u_begin;
    KVPtr<DH> P; attn_ptr_init<DH>(J, lane, P);
    if constexpr (PIPE) {
        KVTile<DH> A, B; f32x16 S0, S1;
        attn_load_tile<DH>(P, A);
        if constexpr (TAB) attn_fill_tab(tab, gtab, maxoff, lane);
        if (1 < nt) attn_load_tile<DH>(P, B);
        attn_qk<DH, TAB>(J, ub, A, qf, tab, kst, lane, mrun, S0);
        int t = 0;
        for (;;) {
            if (t + 2 < nt) attn_load_k<DH>(P, A);
            const bool n1 = t + 1 < nt;
            if (n1) attn_qk<DH, TAB>(J, ub + 32 * (t + 1), B, qf, tab, kst, lane, mrun, S1);
            attn_softmax_pv<DH>(A, S0, S1, n1, vst, tr_base, lane, O, mrun, lrun);
            if (t + 2 < nt) attn_load_v<DH>(P, A);
            if (++t >= nt) break;
            if (t + 2 < nt) attn_load_k<DH>(P, B);
            const bool n2 = t + 1 < nt;
            if (n2) attn_qk<DH, TAB>(J, ub + 32 * (t + 1), A, qf, tab, kst, lane, mrun, S0);
            attn_softmax_pv<DH>(B, S1, S0, n2, vst, tr_base, lane, O, mrun, lrun);
            if (t + 2 < nt) attn_load_v<DH>(P, B);
            if (++t >= nt) break;
        }
    } else {
        if constexpr (TAB) attn_fill_tab(tab, gtab, maxoff, lane);
        for (int t = 0; t < nt; ++t) { KVTile<DH> A; f32x16 S0, Sx; attn_load_tile<DH>(P, A); attn_qk<DH, TAB>(J, ub + 32 * t, A, qf, tab, kst, lane, mrun, S0); attn_softmax_pv<DH>(A, S0, Sx, false, vst, tr_base, lane, O, mrun, lrun); }
    }
    m_out = mrun; l_out = lrun + __shfl_xor(lrun, 32);
}


struct Frame {
    LAS unsigned char* lds;
    volatile LAS unsigned* MISC;
    gu32* ctl;
    unsigned char* ws;
    int tid, lane, wave, vcu, G;
    float* out;
};
__device__ __forceinline__ const float* frame_in(const Frame& F, int i) { const unsigned lo = __builtin_amdgcn_readfirstlane(F.MISC[16 + 2 * i]), hi = __builtin_amdgcn_readfirstlane(F.MISC[17 + 2 * i]); return (const float*)(((unsigned long long)hi << 32) | lo); }
#define FIN(i) frame_in(F, (i))
enum { I_X = 0, I_MEM, I_RELB, I_GMIX, I_WIN, I_SINK, I_WAOUT, I_WBOUT, I_WGATE, I_BGATE, I_WO, I_GX, I_GMEM, I_WXQ, I_WXK, I_WXV, I_WXO, I_GMOE, I_WRG, I_WRE, I_W1, I_W3, I_W2, I_GFIN };

__device__ __forceinline__ void p0_transpose_item(const float* W, int K, int N, bf16* WT, int row_off, int row_mul, LAS unsigned* scr, int item, int lane, const float* rowscale = nullptr) {
    const int nblk = N / 64, kb = item / nblk, nb = item % nblk, k0 = 64 * kb, n0 = 64 * nb;
    const int r4 = lane >> 4, c16 = lane & 15;
    f32x4 v[16];
    const float* src = W + (size_t)(k0 + 2 * r4) * N + n0 + 4 * c16;
#pragma unroll
    for (int i = 0; i < 8; ++i) { v[2 * i] = *(const f32x4*)(src + (size_t)(8 * i) * N); v[2 * i + 1] = *(const f32x4*)(src + (size_t)(8 * i + 1) * N); }
    if (rowscale) {
#pragma unroll
        for (int i = 0; i < 8; ++i) { v[2 * i] *= rowscale[k0 + 2 * r4 + 8 * i]; v[2 * i + 1] *= rowscale[k0 + 2 * r4 + 8 * i + 1]; } }
#pragma unroll
    for (int i = 0; i < 8; ++i)
#pragma unroll
        for (int j = 0; j < 4; ++j) scr[(4 * c16 + j) * 33 + 4 * i + r4] = pg8::cvt_pk_bf16(v[2 * i][j], v[2 * i + 1][j]);
    LDS_WAIT(); asm volatile("" ::: "memory");
    const int nr = lane >> 3, c = lane & 7;
#pragma unroll
    for (int jj = 0; jj < 8; ++jj) { const int n = nr + 8 * jj; const LAS unsigned* s = scr + n * 33 + 4 * c;
        v4u o; o.x = s[0]; o.y = s[1]; o.z = s[2]; o.w = s[3];
        *(v4u*)(WT + (size_t)(row_off + (n0 + n) * row_mul) * K + k0 + 8 * c) = o; }
    LDS_WAIT(); asm volatile("" ::: "memory");
}
template <bool DEEP = false>
__device__ __forceinline__ void p0_transpose_item_fp8(const float* W, int K, int N, unsigned char* WT, int row_off, int row_mul, float scale, LAS unsigned* scr, int item, int lane, int pitch = 0, int kbase = 0) {
    if (pitch == 0) pitch = K;
    const int nblk = N / 64, kb = item / nblk, nb = item % nblk, k0 = 128 * kb, n0 = 64 * nb;
    const int r4 = lane >> 4, c16 = lane & 15;
    if constexpr (DEEP) {
        f32x4 v[2][4][4];
#pragma unroll
        for (int pass = 0; pass < 2; ++pass) { const float* src = W + (size_t)(k0 + 64 * pass + 4 * r4) * N + n0 + 4 * c16;
#pragma unroll
            for (int i = 0; i < 4; ++i)
#pragma unroll
                for (int kk = 0; kk < 4; ++kk) v[pass][i][kk] = __builtin_nontemporal_load((const f32x4*)(src + (size_t)(16 * i + kk) * N)); }
#pragma unroll
        for (int pass = 0; pass < 2; ++pass)
#pragma unroll
            for (int i = 0; i < 4; ++i)
#pragma unroll
                for (int j = 0; j < 4; ++j) scr[(4 * c16 + j) * 33 + 16 * pass + 4 * i + r4] = cvt4_fp8(v[pass][i][0][j] * scale, v[pass][i][1][j] * scale, v[pass][i][2][j] * scale, v[pass][i][3][j] * scale);
    } else {
#pragma unroll
    for (int pass = 0; pass < 2; ++pass) {
        f32x4 v[4][4];
        const float* src = W + (size_t)(k0 + 64 * pass + 4 * r4) * N + n0 + 4 * c16;
#pragma unroll
        for (int i = 0; i < 4; ++i)
#pragma unroll
            for (int kk = 0; kk < 4; ++kk) v[i][kk] = *(const f32x4*)(src + (size_t)(16 * i + kk) * N);
#pragma unroll
        for (int i = 0; i < 4; ++i)
#pragma unroll
            for (int j = 0; j < 4; ++j) scr[(4 * c16 + j) * 33 + 16 * pass + 4 * i + r4] = cvt4_fp8(v[i][0][j] * scale, v[i][1][j] * scale, v[i][2][j] * scale, v[i][3][j] * scale);
    }
    }
    LDS_WAIT(); asm volatile("" ::: "memory");
    const int nr = lane >> 3, c = lane & 7;
#pragma unroll
    for (int jj = 0; jj < 8; ++jj) { const int n = nr + 8 * jj; const LAS unsigned* s = scr + n * 33 + 4 * c;
        v4u o; o.x = s[0]; o.y = s[1]; o.z = s[2]; o.w = s[3];
        *(v4u*)(WT + (size_t)(row_off + (n0 + n) * row_mul) * pitch + kbase + k0 + 16 * c) = o; }
    LDS_WAIT(); asm volatile("" ::: "memory");
}
__device__ __forceinline__ void rms_row_to_bf16(const float* xrow, const float* g, bf16* orow, int lane) {
    const f32x4* xr = (const f32x4*)xrow + lane; const f32x4* gr = (const f32x4*)g + lane;
    f32x4 v[8]; float s = 0.f;
#pragma unroll
    for (int j = 0; j < 8; ++j) { v[j] = xr[64 * j]; s += (v[j][0] * v[j][0] + v[j][1] * v[j][1]) + (v[j][2] * v[j][2] + v[j][3] * v[j][3]); }
    const float rstd = 1.0f / sqrtf(wave_sum(s) * (1.0f / D) + EPS);
    v2u* o8 = (v2u*)orow + lane;
#pragma unroll
    for (int j = 0; j < 8; ++j) { const f32x4 gg = gr[64 * j]; v2u w; w.x = pk2(v[j][0] * rstd * gg[0], v[j][1] * rstd * gg[1]); w.y = pk2(v[j][2] * rstd * gg[2], v[j][3] * rstd * gg[3]); o8[64 * j] = w; }
}
__device__ __forceinline__ void rms_row_to_fp8(const float* xrow, const float* g, unsigned char* orow, int lane) {
    const f32x4* xr = (const f32x4*)xrow + lane; const f32x4* gr = (const f32x4*)g + lane;
    f32x4 v[8]; float s = 0.f;
#pragma unroll
    for (int j = 0; j < 8; ++j) { v[j] = xr[64 * j]; s += (v[j][0] * v[j][0] + v[j][1] * v[j][1]) + (v[j][2] * v[j][2] + v[j][3] * v[j][3]); }
    const float rstd = 1.0f / sqrtf(wave_sum(s) * (1.0f / D) + EPS);
    unsigned* o4 = (unsigned*)orow + lane;
#pragma unroll
    for (int j = 0; j < 8; ++j) { const f32x4 gg = gr[64 * j]; o4[64 * j] = cvt4_fp8(v[j][0] * rstd * gg[0], v[j][1] * rstd * gg[1], v[j][2] * rstd * gg[2], v[j][3] * rstd * gg[3]); }
}
__device__ __forceinline__ int t5_bucket_dev(int d) {
    if (d < 16) return d;
    int large = 16 + (int)(log((double)d / 16.0) / log(128.0) * 16.0);
    return large < 31 ? large : 31;
}
constexpr int I_IN = 16 * 60, I_GT = 16 * 64, I_A = 8 * 32, I_B = 6 * 32, I_O = 16 * 32, I_Q = 32 * 8, I_XO = 8 * 32, I_E13 = 16 * 8, I_E2 = 4 * 32;
template <int PART> __device__ __forceinline__ void p0_convert_rest(Frame& F, int wgi, int nwg) {
    int lane_o = F.lane; asm volatile("" : "+v"(lane_o));
    LAS unsigned* scr = (LAS unsigned*)(F.lds + RING_OFF + F.wave * 16384);
    const int gw = wgi * NWAVES + F.wave, NGW = nwg * NWAVES;
    constexpr int NITEMS = PART == 0 ? I_A + I_B + I_O : (PART == 1 ? 2 * I_Q : I_Q + I_XO);
#pragma unroll 1
    for (int it = gw; it < NITEMS; it += NGW) {
        int r = it;
        if constexpr (PART == 0) {
            if (r < I_A) { p0_transpose_item_fp8(FIN(I_WAOUT), AW, D, F.ws + WS_WA, 0, 1, WAB_SCALE, scr, r, lane_o, AW + BW, 0); continue; } r -= I_A;
            if (r < I_B) { p0_transpose_item_fp8(FIN(I_WBOUT), BW, D, F.ws + WS_WA, 0, 1, WAB_SCALE, scr, r, lane_o, AW + BW, AW); continue; } r -= I_B;
            p0_transpose_item_fp8(FIN(I_WO), D, D, F.ws + WS_WO, 0, 1, WO_SCALE, scr, r, lane_o);
        } else if constexpr (PART == 1) {
            if (r < I_Q) { p0_transpose_item(FIN(I_WXK), D, XW, (bf16*)(F.ws + WS_WXKV), 0, 1, scr, r, lane_o); continue; } r -= I_Q;
            p0_transpose_item(FIN(I_WXV), D, XW, (bf16*)(F.ws + WS_WXKV), XW, 1, scr, r, lane_o);
        } else {
            if (r < I_Q) { p0_transpose_item(FIN(I_WXQ), D, XW, (bf16*)(F.ws + WS_WXQ), 0, 1, scr, r, lane_o, FIN(I_GX)); continue; } r -= I_Q;
            p0_transpose_item(FIN(I_WXO), XW, D, (bf16*)(F.ws + WS_WXO), 0, 1, scr, r, lane_o);
        }
    }
}
constexpr int N_W13 = 2 * NEXP * I_E13, N_WEXP = N_W13 + NEXP * I_E2;
template <bool DEEP = false> __device__ __forceinline__ void convert_w(Frame& F, int lo, int hi, int wsl, int nws) {
    int lane_o = F.lane; asm volatile("" : "+v"(lane_o));
    LAS unsigned* scr = (LAS unsigned*)(F.lds + RING_OFF + F.wave * 16384);
#pragma unroll 1
    for (int it = lo + wsl; it < hi; it += nws) {
        if (it < N_W13) { const int mat = it >= NEXP * I_E13 ? 1 : 0, r = it - mat * NEXP * I_E13, e = r / I_E13;
            p0_transpose_item_fp8<DEEP>(FIN(mat ? I_W3 : I_W1) + (size_t)e * D * DFF, D, DFF, F.ws + WS_W13, e * 1024 + mat, 2, W13_SCALE, scr, r % I_E13, lane_o); }
        else { const int r = it - N_W13, e = r / I_E2; p0_transpose_item_fp8<DEEP>(FIN(I_W2) + (size_t)e * DFF * D, DFF, D, F.ws + WS_W2, e * 2048, 1, W2_SCALE, scr, r % I_E2, lane_o); }
    }
}
__device__ __forceinline__ void p0_prologue(Frame& F) {
    LAS unsigned* scr = (LAS unsigned*)(F.lds + RING_OFF + F.wave * 16384);
    const int gw = F.vcu * NWAVES + F.wave, NGW = F.G * NWAVES;
    for (int it = gw; it < I_IN + I_GT; it += NGW) {
        if (it < I_IN) p0_transpose_item_fp8(FIN(I_WIN), D, NQKV, F.ws + WS_BT1, 0, 1, W1_SCALE, scr, it, F.lane);
        else p0_transpose_item_fp8(FIN(I_WGATE), D, NGATE, F.ws + WS_BT1, NQKV, 1, W1_SCALE, scr, it - I_IN, F.lane);
    }
    for (int m = gw; m < M + BATCH * MEML; m += NGW) {
        if (m < M) rms_row_to_fp8(FIN(I_X) + (size_t)m * D, FIN(I_GMIX), F.ws + WS_H + (size_t)m * D, F.lane);
        else rms_row_to_bf16(FIN(I_MEM) + (size_t)(m - M) * D, FIN(I_GMEM), (bf16*)(F.ws + WS_MEMN) + (size_t)(m - M) * D, F.lane);
    }
    { bf16* w3 = (bf16*)(F.ws + WS_W3); const float* wre = FIN(I_WRE); const float* wrg = FIN(I_WRG); const float* gmo = FIN(I_GMOE);
      for (int i = (F.vcu * NWAVES + F.wave) * 64 + F.lane; i < 4 * 256 * 512; i += F.G * NWAVES * 64) { const int kk = i & 511, n = (i >> 9) & 255, kq = i >> 17, k = kq * 512 + kk, c = n >> 2, sp = n & 3; unsigned v = 0u;
          if (c < 36 && sp < 3) { const float w = gmo[k] * (c < 32 ? wre[k * 32 + c] : wrg[k * 4 + (c - 32)]); const unsigned t0 = f2bf(w); const float r1 = w - __builtin_bit_cast(float, t0 << 16);
              const unsigned t1 = f2bf(r1); const float r2 = r1 - __builtin_bit_cast(float, t1 << 16); v = sp == 0 ? t0 : (sp == 1 ? t1 : f2bf(r2)); }
          w3[i] = (bf16)v; } }
    float* tabA = (float*)(F.ws + WS_TAB); float* tabB = tabA + 16 * TABW;
    const int gt = (F.vcu * NWAVES + F.wave) * 64 + F.lane, NGT = F.G * NWAVES * 64;
    for (int i = gt; i < 16 * TABW + 36 * TABW; i += NGT) {
        if (i < 16 * TABW) { const int hd = i / TABW, d = i % TABW; tabA[i] = (d <= 127) ? FIN(I_RELB)[t5_bucket_dev(d) * 28 + hd] * LOG2E : NEGBIG; }
        else { const int j = i - 16 * TABW, p = j / (12 * TABW), hd = (j / TABW) % 12, d = j % TABW; const int r = (p == 0) ? 1 : (p == 1 ? 4 : 16);
            tabB[j] = (d <= 128) ? FIN(I_RELB)[t5_bucket_dev(d * r) * 28 + 16 + hd] * LOG2E : NEGBIG; }
    }
}

__device__ __forceinline__ void fill_tab(LAS float* tab, const float* gtab, int maxoff, int lane) {
#pragma unroll
    for (int j = 0; j < 4; ++j) { const int idx = lane + 64 * j, d = idx - 32; tab[idx] = (d >= 0 && d <= maxoff) ? gtab[d] : NEGBIG; }
    LDS_WAIT();
}
template <int NDT> __device__ __forceinline__ void store_o_global_fp8(const f32x16 (&O)[NDT], float inv_l, unsigned char* rowp, int h) {
#pragma unroll
    for (int dt = 0; dt < NDT; ++dt)
#pragma unroll
        for (int g = 0; g < 4; ++g) *(unsigned*)(rowp + 32 * dt + 8 * g + 4 * h) = cvt4_fp8(O[dt][4 * g] * inv_l, O[dt][4 * g + 1] * inv_l, O[dt][4 * g + 2] * inv_l, O[dt][4 * g + 3] * inv_l);
}
template <int NDT> __device__ __forceinline__ void store_o_global(const f32x16 (&O)[NDT], float inv_l, bf16* rowp, int h) {
#pragma unroll
    for (int dt = 0; dt < NDT; ++dt)
#pragma unroll
        for (int g = 0; g < 4; ++g) { v2u w; w.x = pg8::cvt_pk_bf16(O[dt][4 * g] * inv_l, O[dt][4 * g + 1] * inv_l); w.y = pg8::cvt_pk_bf16(O[dt][4 * g + 2] * inv_l, O[dt][4 * g + 3] * inv_l);
            *(v2u*)(rowp + 32 * dt + 8 * g + 4 * h) = w; }
}
__device__ __forceinline__ void p2_attention(Frame& F) {
    const bf16* qkv = (const bf16*)(F.ws + WS_QKV);
    unsigned char* oab = F.ws + WS_OA;
    const float* tabA = (const float*)(F.ws + WS_TAB); const float* tabB = tabA + 16 * TABW;
    LAS float* tab = (LAS float*)(F.lds + ATT_TAB_OFF + F.wave * 1024);
    LAS unsigned char* vst = F.lds + ATT_V_OFF + F.wave * ATT_V_WAVE64; LAS unsigned char* kst = F.lds + ATT_K_OFF64 + F.wave * ATT_K_WAVE64;
    LAS unsigned char* OB = F.lds + ATT_OB_OFF; LAS float* LSE = (LAS float*)(F.lds + ATT_LSE_OFF);
    const int lane = F.lane, w = F.wave, q = lane & 31, h = lane >> 5;
    constexpr int NBU = BATCH * 12 * 32, NAU = BATCH * 64 * 4;
    for (int L = F.vcu; L < NBU + NAU; L += F.G) {
        const bool isB = L < NBU;
        int b, hd = 0, t0 = 0, qblk = 0, hk = 0;
        if (isB) { b = L / 384; hd = (L / 32) % 12; t0 = (L % 32) * 256; } else { const int LA = L - NBU; b = LA / 256; qblk = (LA / 4) % 64; hk = LA % 4; }
        const long brow = (long)b * SEQ;
        const int njobs = isB ? 4 : 2;
#pragma unroll 1
        for (int jj = 0; jj < njobs; ++jj) {
            AttnJob J; J.ldq = NQKV; J.ldkv = NQKV;
            int mode, p = 0, qs0 = 0, qsm = 0, nvalid = 32, maxoff = 128; const float* gtab;
            if (isB) {
                J.q = qkv + C_QB + hd * 64; J.k = qkv + C_KB + hd * 64; J.v = qkv + C_VB + hd * 64; J.m_init = 0.f; J.l_init = 0.f;
                if (jj == 0) { const int c = w >> 1, n = w & 1; mode = 1; p = 1; J.i0 = t0 / 4 + 32 * n; J.qrow0 = brow + t0 + c + 128 * n; J.qstride = 4; J.qmask = 31; J.krow0 = brow + c; J.kstride = 4;
                    J.u_begin = (J.i0 - 128) > 0 ? (J.i0 - 128) : 0; J.ntiles = (J.i0 + 32 - J.u_begin) / 32; qs0 = c + 128 * n; qsm = 4; }
                else if (jj < 3) { const int c = w + 8 * (jj - 1); mode = 1; p = 2; J.i0 = t0 / 16; J.qrow0 = brow + t0 + c; J.qstride = 16; J.qmask = 15; J.krow0 = brow + c; J.kstride = 16;
                    int ub = (J.i0 - 128) & ~31; if (ub < 0) ub = 0; J.u_begin = ub; J.ntiles = (((J.i0 + 15) & ~31) - ub) / 32 + 1; qs0 = c; qsm = 16; nvalid = 16; }
                else { __syncthreads(); mode = 2; p = 0; J.i0 = t0 + 32 * w; J.qrow0 = brow + J.i0; J.qstride = 1; J.qmask = 31; J.krow0 = brow; J.kstride = 1;
                    J.u_begin = (J.i0 - 128) > 0 ? (J.i0 - 128) : 0; J.ntiles = (J.i0 + 32 - J.u_begin) / 32; }
                gtab = tabB + (p * 12 + hd) * TABW;
            } else {
                const int jid = w + 8 * jj, g = jid >> 2, qt = jid & 3; hd = hk * 4 + g; mode = 0; maxoff = 127;
                J.q = qkv + C_QA + hd * 64; J.k = qkv + C_KA + hk * 64; J.v = qkv + C_VA + hk * 64; J.m_init = FIN(I_SINK)[hd] * LOG2E; J.l_init = 1.0f;
                J.i0 = qblk * 128 + 32 * qt; J.qrow0 = brow + J.i0; J.qstride = 1; J.qmask = 31; J.krow0 = brow; J.kstride = 1;
                J.u_begin = (J.i0 - 128) > 0 ? (J.i0 - 128) : 0; J.ntiles = (J.i0 + 32 - J.u_begin) / 32;
                gtab = tabA + hd * TABW;
            }
            f32x16 O[2]; float mm, ll;
            attn_job<64, true, true>(J, tab, gtab, maxoff, vst, kst, lane, O, mm, ll);
            if (mode == 0) {
                store_o_global_fp8<2>(O, OAB_SCALE / ll, oab + (size_t)(brow + J.i0 + q) * (AW + BW) + hd * 64, h);
            } else if (mode == 1) {
                if (q < nvalid) {
                    const float inv_l = 1.0f / ll; const int qs = qs0 + qsm * q;
                    LAS unsigned char* op = OB + ((p - 1) * 256 + qs) * 128;
#pragma unroll
                    for (int dt = 0; dt < 2; ++dt)
#pragma unroll
                        for (int g = 0; g < 4; ++g) { v2u wv; wv.x = pg8::cvt_pk_bf16(O[dt][4 * g] * inv_l, O[dt][4 * g + 1] * inv_l); wv.y = pg8::cvt_pk_bf16(O[dt][4 * g + 2] * inv_l, O[dt][4 * g + 3] * inv_l);
                            *(LAS v2u*)(op + (32 * dt + 8 * g + 4 * h) * 2) = wv; }
                    if (h == 0) LSE[(p - 1) * 256 + qs] = mm + __builtin_amdgcn_logf(ll);
                }
            } else {
                const int qs = 32 * w + q;
                const float l0 = mm + __builtin_amdgcn_logf(ll), l1 = LSE[qs], l2 = LSE[256 + qs];
                const float mx = fmaxf(l0, fmaxf(l1, l2)), w0 = fast_exp2(l0 - mx), w1 = fast_exp2(l1 - mx), w2 = fast_exp2(l2 - mx), inv = 1.0f / (w0 + w1 + w2);
                const float c0 = w0 * inv / ll * OAB_SCALE, c1 = w1 * inv * OAB_SCALE, c2 = w2 * inv * OAB_SCALE;
                unsigned char* rowp = oab + (size_t)(brow + J.i0 + q) * (AW + BW) + AW + hd * 64;
#pragma unroll
                for (int dt = 0; dt < 2; ++dt)
#pragma unroll
                    for (int g = 0; g < 4; ++g) { const int d = 32 * dt + 8 * g + 4 * h;
                        const v2u a = *(const LAS v2u*)(OB + (qs) * 128 + d * 2), c = *(const LAS v2u*)(OB + (256 + qs) * 128 + d * 2);
                        const float r0 = c0 * O[dt][4 * g] + c1 * bf_lo(a.x) + c2 * bf_lo(c.x), r1 = c0 * O[dt][4 * g + 1] + c1 * bf_hi(a.x) + c2 * bf_hi(c.x);
                        const float r2 = c0 * O[dt][4 * g + 2] + c1 * bf_lo(a.y) + c2 * bf_lo(c.y), r3 = c0 * O[dt][4 * g + 3] + c1 * bf_hi(a.y) + c2 * bf_hi(c.y);
                        *(unsigned*)(rowp + d) = cvt4_fp8(r0, r1, r2, r3); }
            }
        }
        if (isB) __syncthreads();
    }
}

__device__ __forceinline__ void p6_cross_attention(Frame& F) {
    const bf16* qx = (const bf16*)(F.ws + WS_QX); const bf16* kvx = (const bf16*)(F.ws + WS_KVX); bf16* ox = (bf16*)(F.ws + WS_OX);
    LAS unsigned char* vst = F.lds + ATT_V_OFF + F.wave * ATT_V_WAVE128; LAS unsigned char* kst = F.lds + ATT_K_OFF128 + F.wave * ATT_K_WAVE128;
    const int lane = F.lane, q = lane & 31, h = lane >> 5;
    for (int jid = F.vcu * NWAVES + F.wave; jid < BATCH * 4 * 256; jid += F.G * NWAVES) {
        const int b = jid / 1024, hd = (jid / 256) % 4, qt = jid % 256;
        AttnJob J; J.q = qx + hd * 128; J.q2 = (const bf16*)(F.ws + WS_QX2) + hd * 128; J.ldq = XW; J.qrow0 = (long)b * SEQ + 32 * qt; J.qstride = 1; J.qmask = 31;
        J.k = kvx + hd * 128; J.v = kvx + XW + hd * 128; J.ldkv = 2 * XW; J.krow0 = (long)b * MEML; J.kstride = 1; J.i0 = 0; J.u_begin = 0; J.ntiles = MEML / 32; J.m_init = 0.f; J.l_init = 0.f;
        f32x16 O[4]; float mm, ll;
        attn_job<128, false, false, true>(J, nullptr, nullptr, 0, vst, kst, lane, O, mm, ll);
        store_o_global<4>(O, 1.0f / ll, ox + (size_t)(J.qrow0 + q) * XW + hd * 128, h);
    }
}

constexpr int RT_XS_STRIDE = 260, RT_XS_BUF = 64 * 260;
constexpr int RT_EP_OFF = 0, RT_GP_OFF = 32768, RT_SS_OFF = 36864, RT_CNT_OFF = 37120;
constexpr int RT_WG_OFF = 2 * RT_XS_BUF * 4;
constexpr size_t TAB_WRE2 = 65536;
__device__ __forceinline__ void p8_topk(Frame& F) {
    const float* part = (const float*)(F.ws + WS_PART); const float* ssq = (const float*)(F.ws + WS_SSQ);
    int* tok_e = (int*)(F.ws + WS_ROUTE + RT_E); float* tok_w = (float*)(F.ws + WS_ROUTE + RT_W); int* tok_slot = (int*)(F.ws + WS_ROUTE + RT_SLOT); float* rstd2 = (float*)(F.ws + WS_ROUTE + RT_RSTD);
    unsigned* gcnt = (unsigned*)(F.ctl + CW_CNT);
    LAS int* cnt = (LAS int*)(F.lds + RT_CNT_OFF); LAS int* cbase = cnt + 32;
    const int tid = F.tid, w = F.wave, lane = F.lane;
    { int* row_tok = (int*)(F.ws + WS_ROUTE + RT_ROWTOK); for (int i = (F.vcu * NWAVES + w) * 64 + lane; i < MAXPANEL * 256; i += F.G * NWAVES * 64) row_tok[i] = 0; }
    constexpr size_t QS = (size_t)M * 36;
    for (int blk = F.vcu; blk < M / 64; blk += F.G) {
        const int r0 = blk * 64;
        __syncthreads();
        if (tid < 32) cnt[tid] = 0;
        __syncthreads();
        int e0 = 0, e1 = 0; float gw0 = 0.f, gw1 = 0.f;
        if (tid < 64) {
            const int t = r0 + tid; float s = 0.f;
#pragma unroll
            for (int j = 0; j < 8; ++j) { const f32x4 p = *(const f32x4*)(ssq + (size_t)t * 32 + 4 * j); s += (p[0] + p[1]) + (p[2] + p[3]); }
            const float rs = 1.0f / sqrtf(s * (1.0f / D) + EPS);
            const float* pt = part + (size_t)t * 36;
            f32x4 g4 = *(const f32x4*)(pt + 32);
#pragma unroll
            for (int q = 1; q < 4; ++q) g4 += *(const f32x4*)(pt + q * QS + 32);
            float gl[4] = {g4[0] * rs, g4[1] * rs, g4[2] * rs, g4[3] * rs};
            int gi = 0; float gmx = gl[0];
#pragma unroll
            for (int j = 1; j < 4; ++j) if (gl[j] > gmx) { gmx = gl[j]; gi = j; }
            float gden = 0.f;
#pragma unroll
            for (int j = 0; j < 4; ++j) gden += expf(gl[j] - gmx);
            const float ggate = 1.0f / gden;
            f32x4 ea = *(const f32x4*)(pt + gi * 8), eb = *(const f32x4*)(pt + gi * 8 + 4);
#pragma unroll
            for (int q = 1; q < 4; ++q) { ea += *(const f32x4*)(pt + q * QS + gi * 8); eb += *(const f32x4*)(pt + q * QS + gi * 8 + 4); }
            const float el[8] = {ea[0] * rs, ea[1] * rs, ea[2] * rs, ea[3] * rs, eb[0] * rs, eb[1] * rs, eb[2] * rs, eb[3] * rs};
            int i0 = 0; float v0 = el[0];
#pragma unroll
            for (int j = 1; j < 8; ++j) if (el[j] > v0) { v0 = el[j]; i0 = j; }
            int i1 = -1; float v1 = -3.0e38f;
#pragma unroll
            for (int j = 0; j < 8; ++j) if (j != i0 && el[j] > v1) { v1 = el[j]; i1 = j; }
            const float p1 = expf(v1 - v0), den = 1.0f + p1;
            gw0 = ggate / den; gw1 = ggate * p1 / den; e0 = gi * 8 + i0; e1 = gi * 8 + i1;
            rstd2[t] = rs;
        }
        int s0 = 0, s1 = 0;
        if (tid < 64) { s0 = __hip_atomic_fetch_add(&cnt[e0], 1, __ATOMIC_RELAXED, __HIP_MEMORY_SCOPE_WORKGROUP); s1 = __hip_atomic_fetch_add(&cnt[e1], 1, __ATOMIC_RELAXED, __HIP_MEMORY_SCOPE_WORKGROUP); }
        __syncthreads();
        if (tid < 32) cbase[tid] = (int)__hip_atomic_fetch_add(&gcnt[tid], (unsigned)cnt[tid], __ATOMIC_RELAXED, __HIP_MEMORY_SCOPE_AGENT);
        __syncthreads();
        if (tid < 64) { const int t = r0 + tid;
            tok_e[2 * t] = e0; tok_e[2 * t + 1] = e1; tok_w[2 * t] = gw0; tok_w[2 * t + 1] = gw1; tok_slot[2 * t] = cbase[e0] + s0; tok_slot[2 * t + 1] = cbase[e1] + s1; }
    }
}
struct OneUnit {
    int pm, pn;
    __device__ __forceinline__ bool next(int i, pg8::Unit& u) const { if (i) return false; u.pm = pm; u.pn = pn; return true; }
    __device__ __forceinline__ void a_ready(const pg8::Unit&) const {}
    __device__ __forceinline__ void done(const pg8::Unit&) const {}
};

__device__ __forceinline__ int build_panels(Frame& F, LAS int* pexp, LAS int* pstart) {
    LAS int* cnts = pstart + 64;
    if (F.tid < NEXP) cnts[F.tid] = (int)__hip_atomic_load((const unsigned*)(F.ctl + CW_CNT) + F.tid, __ATOMIC_RELAXED, __HIP_MEMORY_SCOPE_AGENT);
    __syncthreads();
    if (F.tid == 0) {
        int row = 0, np = 0;
        for (int e = 0; e < NEXP; ++e) { const int c = cnts[e]; pstart[e] = row; const int npan = (c + 255) / 256;
            for (int j = 0; j < npan; ++j) pexp[np + j] = e; np += npan; row += npan * 256; }
        pstart[NEXP] = np;
    }
    __syncthreads();
    return pstart[NEXP];
}

__device__ __forceinline__ void p9_rowmap(Frame& F) {
    LAS int* pexp = (LAS int*)(F.lds + PEXP_OFF); LAS int* pstart = pexp + MAXPANEL;
    build_panels(F, pexp, pstart);
    const int* tok_e = (const int*)(F.ws + WS_ROUTE + RT_E); const int* tok_slot = (const int*)(F.ws + WS_ROUTE + RT_SLOT); int* tok_dest = (int*)(F.ws + WS_ROUTE + RT_DEST);
    const float* rstd2 = (const float*)(F.ws + WS_ROUTE + RT_RSTD); float* rsort = (float*)(F.ws + WS_ROUTE + RT_RSORT); int* row_tok = (int*)(F.ws + WS_ROUTE + RT_ROWTOK);
    for (int a = (F.vcu * NWAVES + F.wave) * 64 + F.lane; a < 2 * M; a += F.G * NWAVES * 64) {
        const int t = a >> 1, dest = pstart[tok_e[a]] + tok_slot[a];
        tok_dest[a] = dest; row_tok[dest] = t; rsort[dest] = rstd2[t];
    }
}

struct MoeOrder {
    int npanel, ntile, G, c; const LAS int* pexp;
    __device__ __forceinline__ bool next(int i, pg8::Unit& u) const { const long L = (long)i * G + c; if (L >= (long)npanel * ntile) return false; const int pm = (int)(L / ntile), j = (int)(L % ntile); u.pm = pm; u.pn = pexp[pm] * ntile + j; return true; }
    __device__ __forceinline__ void a_ready(const pg8::Unit&) const {}
    __device__ __forceinline__ void done(const pg8::Unit&) const {}
};

__device__ __forceinline__ float fp8_to_f32(unsigned b) { const float v = __builtin_bit_cast(float, (b & 0x7Fu) << 20) * 1.329227995784916e36f; return (b & 0x80u) ? -v : v; }
__device__ __forceinline__ f32x4 fp8x4_to_f32(unsigned w) { return (f32x4){fp8_to_f32(w & 0xFFu), fp8_to_f32((w >> 8) & 0xFFu), fp8_to_f32((w >> 16) & 0xFFu), fp8_to_f32(w >> 24)}; }
template <bool MOE, bool XBF = false> __device__ __forceinline__ void p12_final(Frame& F, const float* x2, const bf16* tap = nullptr, int tap_ld = 0, int tap_cols = 0) { const bf16* y = (const bf16*)(F.ws + WS_Y);
    const int* tok_dest = (const int*)(F.ws + WS_ROUTE + RT_DEST); const float* tok_w = (const float*)(F.ws + WS_ROUTE + RT_W);
    const float* gf = FIN(I_GFIN);
    for (int t = F.vcu * NWAVES + F.wave; t < M; t += F.G * NWAVES) {
        int d0 = 0, d1 = 0; float w0 = 0.f, w1 = 0.f; if (MOE) { d0 = tok_dest[2 * t]; d1 = tok_dest[2 * t + 1]; w0 = tok_w[2 * t]; w1 = tok_w[2 * t + 1]; }
        const f32x4* xr = (const f32x4*)(x2 + (size_t)t * D) + F.lane; const v2u* y0 = (const v2u*)(y + (size_t)d0 * D) + F.lane; const v2u* y1 = (const v2u*)(y + (size_t)d1 * D) + F.lane;
        f32x4 v[8]; float s = 0.f;
#pragma unroll
        for (int j = 0; j < 8; ++j) { f32x4 xv; if (XBF) { const v2u xb = ((const v2u*)((const bf16*)x2 + (size_t)t * D) + F.lane)[64 * j]; xv = (f32x4){bf_lo(xb.x), bf_hi(xb.x), bf_lo(xb.y), bf_hi(xb.y)}; } else xv = xr[64 * j]; if (MOE) {
#ifdef MK_NT12
            const v2u a = __builtin_nontemporal_load(y0 + 64 * j), b = __builtin_nontemporal_load(y1 + 64 * j);
#else
            const v2u a = y0[64 * j], b = y1[64 * j];
#endif

            xv[0] += w0 * bf_lo(a.x) + w1 * bf_lo(b.x); xv[1] += w0 * bf_hi(a.x) + w1 * bf_hi(b.x); xv[2] += w0 * bf_lo(a.y) + w1 * bf_lo(b.y); xv[3] += w0 * bf_hi(a.y) + w1 * bf_hi(b.y); }
            if (tap) { const int col = 4 * (F.lane + 64 * j); if (col < tap_cols) { const v2u a = *(const v2u*)(tap + (size_t)t * tap_ld + col); xv[0] += bf_lo(a.x); xv[1] += bf_hi(a.x); xv[2] += bf_lo(a.y); xv[3] += bf_hi(a.y); } }
            v[j] = xv; s += (xv[0] * xv[0] + xv[1] * xv[1]) + (xv[2] * xv[2] + xv[3] * xv[3]); }
        const float rstd = 1.0f / sqrtf(wave_sum(s) * (1.0f / D) + EPS);
        f32x4* orow = (f32x4*)(F.out + (size_t)t * D) + F.lane; const f32x4* gr = (const f32x4*)gf + F.lane;
#pragma unroll
        for (int j = 0; j < 8; ++j) {
#ifdef MK_NT12
            __builtin_nontemporal_store(v[j] * rstd * gr[64 * j], orow + 64 * j);
#else
            orow[64 * j] = v[j] * rstd * gr[64 * j];
#endif
        }
    }
}

#ifndef MK_PER_PHASE
#define MK_PER_PHASE 0
#endif
#ifndef MK_STOP_AFTER
#define MK_STOP_AFTER 11
#endif
#ifndef MK_REPEAT_MASK
#define MK_REPEAT_MASK 0
#endif
#ifndef MK_RT_PROBE
#define MK_RT_PROBE 0
#endif
#if MK_RT_PROBE
#define MK_REPS(k) (1 + ((rep_mask >> (k)) & 1))
#else
#define MK_REPS(k) (1 + ((MK_REPEAT_MASK >> (k)) & 1))
#endif
#ifndef MK_STAMP_BASE
#define MK_STAMP_BASE 0
#endif
#ifndef MK_NG1
#define MK_NG1 248
#endif
constexpr int NG1 = MK_NG1;
constexpr int NPHASE = 13;
#ifndef MK_DEEPS
#define MK_DEEPS true
#endif
#ifndef MK_DEEP10
#define MK_DEEP10 true
#endif
#ifndef MK_C1
#define MK_C1 0
#define MK_C3 4096
#define MK_C4 4096
#define MK_C5 0
#define MK_C7 0
#endif
constexpr int CV_1 = MK_C1, CV_3 = CV_1 + MK_C3, CV_4 = CV_3 + MK_C4, CV_5 = CV_4 + MK_C5, CV_7 = CV_5 + MK_C7;
static_assert(CV_7 >= N_W13 && CV_7 <= N_WEXP, "w1 / w3 are complete before P10");


__global__ void __launch_bounds__(NWAVES * 64, 2) mega_fwd(Args args) {
    extern __shared__ __attribute__((aligned(16))) unsigned char lds[];
    Frame F;
    F.lds = (LAS unsigned char*)lds;
    F.MISC = (volatile LAS unsigned*)(F.lds + MISC_OFF);
    F.tid = threadIdx.x; F.lane = F.tid & 63; F.wave = __builtin_amdgcn_readfirstlane(F.tid >> 6);
    F.G = gridDim.x; { const int bx = blockIdx.x; F.vcu = (F.G % 8 == 0) ? (bx % 8) * (F.G / 8) + bx / 8 : bx; }
    F.ws = args.ws; F.ctl = (gu32*)(args.ws + WS_CTL); F.out = args.out;
    if (F.tid < 16) F.MISC[F.tid] = 0u;
    if (F.tid == 0) {
#pragma unroll
        for (int i = 0; i < 24; ++i) { const unsigned long long pv = (unsigned long long)args.in[i]; F.MISC[16 + 2 * i] = (unsigned)pv; F.MISC[17 + 2 * i] = (unsigned)(pv >> 32); } }
    __syncthreads();
    const int lo = args.ph_lo, hi = args.ph_hi; const int rep_mask = __builtin_amdgcn_readfirstlane(args.rep_mask); (void)rep_mask;
    XcdBarrier bar; bar.bar = (unsigned*)(F.ctl + CW_BAR); bar.x = 0; bar.st = nullptr;
    if (hi - lo > 1) bar = xcd_barrier_post((unsigned*)(F.ctl + CW_BAR), F.MISC + 8);
#define IN(k) (lo <= (k) && (k) < hi && ((k) <= MK_STOP_AFTER || (k) == 12))
#define INR(k) (lo <= (k) && (k) < hi)
#ifdef MK_STAMP_PHASE
    unsigned long long st_t0 = __builtin_amdgcn_s_memrealtime(), st_tk = 0;
#define SEAM(k) do { if (INR(k) && INR((k) + 1) && (k) <= MK_STOP_AFTER) xcd_barrier(bar); if ((k) == MK_STAMP_PHASE - 1 && MK_STAMP_PHASE != 13) st_t0 = __builtin_amdgcn_s_memrealtime(); if ((k) == MK_STAMP_PHASE) st_tk = __builtin_amdgcn_s_memrealtime(); } while (0)
#else
#define SEAM(k) do { if (INR(k) && INR((k) + 1) && (k) <= MK_STOP_AFTER) xcd_barrier(bar); } while (0)
#endif
    LAS unsigned char* ring = F.lds + RING_OFF;
    LAS int* pexp = (LAS int*)(F.lds + PEXP_OFF); LAS int* pstart = pexp + MAXPANEL;

    for (int rep_ = 0; rep_ < MK_REPS(0); ++rep_) { if (rep_) xcd_barrier(bar); if (IN(0)) { p0_prologue(F); } } SEAM(0);

    for (int rep_ = 0; rep_ < MK_REPS(1); ++rep_) { if (rep_) xcd_barrier(bar); if (IN(1)) {
        const int G1 = F.G > NG1 ? NG1 : F.G / 2;
        if ((int)blockIdx.x < G1) {
            pg8::Gemm g{(const bf16*)(F.ws + WS_H), (const bf16*)(F.ws + WS_BT1), M, NB1, D / 2}; pg8::StaticOrder S; S.init(M, NB1, G1, (int)blockIdx.x);
            EpiQKVG E{(bf16*)(F.ws + WS_QKV), (bf16*)(F.ws + WS_GA), (bf16*)(F.ws + WS_GB), FIN(I_BGATE)};
            pg8::gemm_phase<EpiQKVG, pg8::StaticOrder, true, true, 2, true>(ring, g, S, E);
        } else { p0_convert_rest<0>(F, (int)blockIdx.x - G1, F.G - G1); p0_convert_rest<1>(F, (int)blockIdx.x - G1, F.G - G1); convert_w(F, 0, CV_1, ((int)blockIdx.x - G1) * NWAVES + F.wave, (F.G - G1) * NWAVES); }
    } } SEAM(1);

    for (int rep_ = 0; rep_ < MK_REPS(2); ++rep_) { if (rep_) xcd_barrier(bar); if (IN(2)) { p2_attention(F); } } SEAM(2);

    for (int rep_ = 0; rep_ < MK_REPS(3); ++rep_) { if (rep_) xcd_barrier(bar); if (IN(3)) {
        pg8::Gemm g{(const bf16*)(F.ws + WS_OA), (const bf16*)(F.ws + WS_WA), M, D, (AW + BW) / 2}; pg8::StaticOrder S; S.init(M, D, F.G, (int)blockIdx.x);
        EpiMix E{(const bf16*)(F.ws + WS_GA), (const bf16*)(F.ws + WS_GB), F.ws + WS_MIX8};
        const int grp = ((int)blockIdx.x >> 3) & 1, wsl = ((((int)blockIdx.x >> 4) << 3) + ((int)blockIdx.x & 7)) * NWAVES + F.wave, nws = (F.G >> 1) * NWAVES;
        if (grp) { convert_w<MK_DEEPS>(F, CV_1, CV_3, wsl, nws); __syncthreads(); }
        pg8::gemm_phase<EpiMix, pg8::StaticOrder, true, true, 2, true>(ring, g, S, E);
    } } SEAM(3);

    for (int rep_ = 0; rep_ < MK_REPS(4); ++rep_) { if (rep_) xcd_barrier(bar); if (IN(4)) {
#ifdef MK_STAG4
        if (((int)blockIdx.x >> 3) & 1) { const unsigned long long t0_ = __builtin_amdgcn_s_memrealtime(); while (__builtin_amdgcn_s_memrealtime() - t0_ < (unsigned long long)(MK_STAG4) * 100ull) __builtin_amdgcn_s_sleep(8); }
#endif
        pg8::Gemm g{(const bf16*)(F.ws + WS_MIX8), (const bf16*)(F.ws + WS_WO), M, D, D / 2}; pg8::StaticOrder S; S.init(M, D, F.G, (int)blockIdx.x);
        EpiResid E{FIN(I_X), (bf16*)(F.ws + WS_X1), (float*)(F.ws + WS_SSQ)};
        const int grp = ((int)blockIdx.x >> 3) & 1, wsl = ((((int)blockIdx.x >> 4) << 3) + ((int)blockIdx.x & 7)) * NWAVES + F.wave, nws = (F.G >> 1) * NWAVES;
        if (grp) { convert_w<MK_DEEPS>(F, CV_3, CV_4, wsl, nws); __syncthreads(); }
        pg8::gemm_phase<EpiResid, pg8::StaticOrder, true, true, 2, true>(ring, g, S, E);
        if (!grp) {
            const int wgi = (((int)blockIdx.x >> 4) << 3) + ((int)blockIdx.x & 7);
            if (wgi < 32) { __syncthreads(); const int kq = wgi & 3, tl = wgi >> 2;
                pg8::Gemm gk{(const bf16*)(F.ws + WS_MEMN) + kq * 512, (const bf16*)(F.ws + WS_WXKV) + kq * 512, BATCH * MEML, 2 * XW, 512}; OneUnit Sk{tl >> 2, tl & 3};
                EpiF32 Ek{(float*)(F.ws + WS_KVP) + (size_t)kq * (BATCH * MEML) * (2 * XW), 2 * XW};
                pg8::gemm_phase<EpiF32, OneUnit, true, true, 0, false, D, D>(ring, gk, Sk, Ek); }
            else { __syncthreads(); p0_convert_rest<2>(F, wgi - 32, (F.G >> 1) - 32); } }
    } } SEAM(4);

    for (int rep_ = 0; rep_ < MK_REPS(5); ++rep_) { if (rep_) xcd_barrier(bar); if (IN(5)) {
        { const float* kvp = (const float*)(F.ws + WS_KVP); bf16* kvx = (bf16*)(F.ws + WS_KVX); constexpr int NKV = BATCH * MEML * 2 * XW;
          for (int i = ((int)blockIdx.x * (NWAVES * 64) + F.tid) * 4; i < NKV; i += F.G * NWAVES * 64 * 4) {
              const f32x4 s4 = (*(const f32x4*)(kvp + i) + *(const f32x4*)(kvp + NKV + i)) + (*(const f32x4*)(kvp + 2 * NKV + i) + *(const f32x4*)(kvp + 3 * NKV + i));
              v2u o; o.x = pg8::cvt_pk_bf16(s4[0], s4[1]); o.y = pg8::cvt_pk_bf16(s4[2], s4[3]); *(v2u*)(kvx + i) = o; } }
#pragma unroll 1
        for (int L = (int)blockIdx.x; L < 2 * (M / 256) * (XW / 256); L += F.G) { const int half = L / ((M / 256) * (XW / 256));
            pg8::StaticOrder So; So.init(M, XW, (M / 256) * (XW / 256), L % ((M / 256) * (XW / 256))); pg8::Unit u0; So.next(0, u0);
            pg8::Gemm g{(const bf16*)(F.ws + WS_X1) + half * (D / 2), (const bf16*)(F.ws + WS_WXQ) + half * (D / 2), M, XW, D / 2}; OneUnit S{u0.pm, u0.pn};
            EpiQx E{(bf16*)(F.ws + (half ? WS_QX2 : WS_QX)), (const float*)(F.ws + WS_SSQ), 0.08838834764831845f * LOG2E};
            pg8::gemm_phase<EpiQx, OneUnit, true, true, 0, false, D, D>(ring, g, S, E); }
    } } SEAM(5);

    for (int rep_ = 0; rep_ < MK_REPS(6); ++rep_) { if (rep_) xcd_barrier(bar); if (IN(6)) { p6_cross_attention(F); } } SEAM(6);

    for (int rep_ = 0; rep_ < MK_REPS(7); ++rep_) { if (rep_) xcd_barrier(bar); if (IN(7)) {
        pg8::Gemm g{(const bf16*)(F.ws + WS_OX), (const bf16*)(F.ws + WS_WXO), M, D, XW}; pg8::StaticOrder S; S.init(M, D, F.G, (int)blockIdx.x);
        EpiResid2 E{(bf16*)(F.ws + WS_X1), F.ws + WS_HM, FIN(I_GMOE), (float*)(F.ws + WS_SSQ)};
        const int grp = ((int)blockIdx.x >> 3) & 1, wsl = ((((int)blockIdx.x >> 4) << 3) + ((int)blockIdx.x & 7)) * NWAVES + F.wave, nws = (F.G >> 1) * NWAVES;
        if (grp) { convert_w<MK_DEEPS>(F, CV_5, CV_7, wsl, nws); __syncthreads(); }
        pg8::gemm_phase<EpiResid2, pg8::StaticOrder, true, true>(ring, g, S, E);
    } } SEAM(7);

    for (int rep_ = 0; rep_ < MK_REPS(8); ++rep_) { if (rep_) xcd_barrier(bar); if (IN(8)) {
#pragma unroll 1
        for (int L = (int)blockIdx.x; L < 4 * (M / 256); L += F.G) { const int pm = L >> 2, kq = L & 3;
            pg8::Gemm g{(const bf16*)(F.ws + WS_X1) + kq * 512, (const bf16*)(F.ws + WS_W3), M, 256, 512}; OneUnit S{pm, kq};
            EpiLogit E{(float*)(F.ws + WS_PART) + (size_t)kq * M * 36};
            pg8::gemm_phase<EpiLogit, OneUnit, true, true, 0, false, D>(ring, g, S, E); }
        xcd_barrier(bar);
        p8_topk(F);
    } } SEAM(8);
    for (int rep_ = 0; rep_ < MK_REPS(9); ++rep_) { if (rep_) xcd_barrier(bar); if (IN(9)) { p9_rowmap(F); } } SEAM(9);

    for (int rep_ = 0; rep_ < MK_REPS(10); ++rep_) { if (rep_) xcd_barrier(bar); if (IN(10)) {
        const int np = build_panels(F, pexp, pstart);
        {
            const int ntot = np * 4, R = (ntot + F.G - 1) / F.G, hv = ntot - (R - 1) * F.G, nl = F.G - hv;
            int wsl = F.vcu * NWAVES + F.wave, nws = F.G * NWAVES, hi = N_WEXP;
            if (nl * NWAVES * 4 >= N_WEXP - CV_7) { nws = nl * NWAVES; if (F.vcu >= hv) wsl = (F.vcu - hv) * NWAVES + F.wave; else { wsl = 0; hi = CV_7; } }
            convert_w<MK_DEEP10>(F, CV_7, hi, wsl, nws); __syncthreads();
        }
        pg8::Gemm g{(const bf16*)(F.ws + WS_HM), (const bf16*)(F.ws + WS_W13), MAXPANEL * 256, NEXP * 1024, D / 2}; MoeOrder S{np, 4, F.G, F.vcu, pexp};
        EpiSwiGLU E{F.ws + WS_ACT, (const float*)(F.ws + WS_ROUTE + RT_RSORT)};
        pg8::gemm_phase<EpiSwiGLU, MoeOrder, true, true, 1, true>(ring, g, S, E, (const int*)(F.ws + WS_ROUTE + RT_ROWTOK));
    } } SEAM(10);

    for (int rep_ = 0; rep_ < MK_REPS(11); ++rep_) { if (rep_) xcd_barrier(bar); if (IN(11)) {
        const int np = build_panels(F, pexp, pstart);
#ifdef MK_STAG11
        { const int ntot = np * 8, R = (ntot + F.G - 1) / F.G, hv = ntot - (R - 1) * F.G;
          if (F.vcu >= hv) { const unsigned long long t0_ = __builtin_amdgcn_s_memrealtime(); while (__builtin_amdgcn_s_memrealtime() - t0_ < (unsigned long long)(MK_STAG11) * 100ull) __builtin_amdgcn_s_sleep(8); } }
#endif
        int k2 = DFF / 2; asm volatile("" : "+s"(k2));
        pg8::Gemm g{(const bf16*)(F.ws + WS_ACT), (const bf16*)(F.ws + WS_W2), MAXPANEL * 256, NEXP * 2048, k2}; MoeOrder S{np, 8, F.G, F.vcu, pexp};
        EpiBf E{(bf16*)(F.ws + WS_Y), D, 8, 1.0f / (ACT_SCALE * W2_SCALE)};
        pg8::gemm_phase<EpiBf, MoeOrder, true, true, 2, true>(ring, g, S, E);
    } } SEAM(11);

#ifdef MK_TAP
    for (int rep_ = 0; rep_ < MK_REPS(12); ++rep_) { if (rep_) xcd_barrier(bar); if (IN(12)) { p12_final<false>(F, FIN(I_X), (const bf16*)(F.ws + (MK_TAP_OFF)), MK_TAP_LD, MK_TAP_COLS); } }
#else
    for (int rep_ = 0; rep_ < MK_REPS(12); ++rep_) { if (rep_) xcd_barrier(bar); if (IN(12)) { p12_final<(MK_STOP_AFTER >= 11), (MK_STOP_AFTER >= 4)>(F, (MK_STOP_AFTER >= 4) ? (const float*)(F.ws + WS_X1) : FIN(I_X)); } }
#endif
#ifdef MK_STAMP_PHASE
    xcd_barrier(bar);
    if (MK_STAMP_PHASE == 12) st_tk = __builtin_amdgcn_s_memrealtime();
    if (MK_STAMP_PHASE == 13) { st_tk = __builtin_amdgcn_s_memrealtime(); }
    if (blockIdx.x == 0) { for (int i = F.tid; i < 48 * D; i += NWAVES * 64) F.out[D + i] += 1.0f; }
    if (blockIdx.x == 0 && F.tid == 0) F.out[0] = MK_STAMP_BASE > 0 ? ((float)(st_tk - st_t0) * 0.01f - (float)MK_STAMP_BASE) * 0.125f : (float)(st_tk - st_t0) * (MK_STAMP_PHASE == 13 ? 0.0003125f : 0.00125f);
#endif
#undef IN
#undef INR
#undef SEAM
}

extern "C" void kernel_launch(void* const* d_in, const int* in_sizes, int n_in, void* d_out, int out_size, void* d_ws, size_t ws_size, hipStream_t stream) {
    static int grid = 0;
    if (grid == 0) {
        if (n_in != 24 || in_sizes[0] != M * D || out_size != M * D || ws_size < WS_END) { fprintf(stderr, "kernel_launch: unexpected shapes or workspace (%d inputs, ws %zu, need %zu); nothing launched\n", n_in, ws_size, (size_t)WS_END); grid = -1; return; }
        int dev = 0, cus = 0, per_cu = 0;
        if (hipGetDevice(&dev) != hipSuccess || hipDeviceGetAttribute(&cus, hipDeviceAttributeMultiprocessorCount, dev) != hipSuccess) { grid = -1; return; }
        if (hipFuncSetAttribute((const void*)mega_fwd, hipFuncAttributeMaxDynamicSharedMemorySize, LDS_BYTES) != hipSuccess) { fprintf(stderr, "kernel_launch: hipFuncSetAttribute failed\n"); grid = -1; return; }
        if (hipOccupancyMaxActiveBlocksPerMultiprocessor(&per_cu, (const void*)mega_fwd, NWAVES * 64, LDS_BYTES) != hipSuccess || per_cu < 1) { fprintf(stderr, "kernel_launch: occupancy query reports %d workgroups per CU\n", per_cu); }
        (void)hipGetLastError();
        grid = cus - cus % 16;
        if (grid < 144) { fprintf(stderr, "kernel_launch: %d CUs are too few for this kernel's phase layout\n", cus); grid = -1; return; }
    }
    if (grid < 0) return;
    if (hipMemsetAsync((char*)d_ws + WS_CTL, 0, CTL_ZERO_BYTES, stream) != hipSuccess) return;
    Args a{};
    for (int i = 0; i < 24; ++i) a.in[i] = (const float*)d_in[i];
    a.out = (float*)d_out; a.ws = (unsigned char*)d_ws; a.rep_mask = MK_REPEAT_MASK; a.pad = 0;
#if MK_PER_PHASE
    for (int p = 0; p < NPHASE; ++p) { if (p > MK_STOP_AFTER && p != 12) continue; a.ph_lo = p; a.ph_hi = p + 1; hipLaunchKernelGGL(mega_fwd, dim3(grid), dim3(NWAVES * 64), LDS_BYTES, stream, a); }
#else
    a.ph_lo = 0; a.ph_hi = NPHASE;
    hipLaunchKernelGGL(mega_fwd, dim3(grid), dim3(NWAVES * 64), LDS_BYTES, stream, a);
#endif
}
```
